# Optimizing an MI355X kernel written in HIP

```python
import math
import jax, jax.numpy as jnp
from jax import lax
import numpy as np

D_MODEL = 1024
BATCH = 16
SEQ = 2048
DEPTH = 1

GLA_HEADS = 4
GLA_DK = D_MODEL // 8
GLA_DV = D_MODEL // 4
GLA_LOWRANK = 16
GLA_GATE_NORM = 16.0
GLA_CHUNK = 64
MOBA_HEADS = 8
MOBA_HD = D_MODEL // 8
MOBA_BLOCK = 256
MOBA_TOPK = 3
MOBA_Q_CHUNK = 16
ROPE_THETA = 500000.0
ROPE_DIM = MOBA_HD // 4
PEER_HEADS = 8
PEER_NKEYS = 128
PEER_N_EXPERTS = PEER_NKEYS * PEER_NKEYS
PEER_DKEY = 256
PEER_TOPK = 16
PEER_TOKEN_CHUNK = 128
DEEPNORM_ALPHA = (2.0 * DEPTH) ** 0.25
DEEPNORM_BETA = (8.0 * DEPTH) ** -0.25
LN_EPS = 1e-5
RMS_EPS = 1e-6
NEG_INF = -1e30

GLA_QK_W = GLA_HEADS * GLA_DK
GLA_V_W = GLA_HEADS * GLA_DV
MOBA_W = MOBA_HEADS * MOBA_HD
IN_SPLITS = (GLA_QK_W, GLA_QK_W, GLA_V_W, GLA_V_W, GLA_LOWRANK, MOBA_W, MOBA_W, MOBA_W, D_MODEL, D_MODEL)
IN_IS_VALUE = (False, False, True, False, False, False, False, True, False, False)
IN_WIDTH = sum(IN_SPLITS)
IN_SPLIT_POINTS = tuple(int(v) for v in np.cumsum(IN_SPLITS)[:-1])

kernel_name = "hybrid_gla_moba_peer_deepnorm"


def layer_norm(x, g, b):
    xf = x.astype(jnp.float32)
    mu = xf.mean(-1, keepdims=True)
    var = jnp.square(xf - mu).mean(-1, keepdims=True)
    return ((xf - mu) * lax.rsqrt(var + LN_EPS) * g.astype(jnp.float32) + b.astype(jnp.float32)).astype(x.dtype)


def rms_norm(x, g):
    xf = x.astype(jnp.float32)
    return xf * lax.rsqrt(jnp.mean(xf * xf, -1, keepdims=True) + RMS_EPS) * g.astype(jnp.float32)


def partial_rope(x):
    T = x.shape[1]
    half = ROPE_DIM // 2
    inv_freq = jnp.power(ROPE_THETA, -jnp.arange(half, dtype=jnp.float32) * 2.0 / ROPE_DIM)
    ang = jnp.arange(T, dtype=jnp.float32)[:, None] * inv_freq[None, :]
    cos = jnp.cos(ang)[None, :, None, :]
    sin = jnp.sin(ang)[None, :, None, :]
    xf = x.astype(jnp.float32)
    x1, x2, rest = xf[..., :half], xf[..., half:ROPE_DIM], xf[..., ROPE_DIM:]
    out = jnp.concatenate([x1 * cos - x2 * sin, x1 * sin + x2 * cos, rest], axis=-1)
    return out.astype(x.dtype)


def gla_chunked(q, k, v, log_decay):
    B, H, T, dk = q.shape
    dv = v.shape[-1]
    C = GLA_CHUNK
    nc = T // C
    q = q.reshape(B, H, nc, C, dk)
    k = k.reshape(B, H, nc, C, dk)
    v = v.reshape(B, H, nc, C, dv)
    b = jnp.cumsum(log_decay.reshape(B, H, nc, C, dk), axis=3)
    ref = b[:, :, :, C // 2 - 1:C // 2, :]
    a = jnp.einsum('bhncd,bhnsd->bhncs', q * jnp.exp(b - ref), k * jnp.exp(ref - b))
    causal = jnp.tril(jnp.ones((C, C), dtype=bool))
    o_intra = jnp.einsum('bhncs,bhnsv->bhncv', jnp.where(causal, a, 0.0), v)
    b_last = b[:, :, :, -1, :]
    q_inter = q * jnp.exp(b)
    k_state = k * jnp.exp(b_last[:, :, :, None, :] - b)
    decay_last = jnp.exp(b_last)

    def step(S, inp):
        qn, kn, vn, dn = inp
        o = jnp.einsum('bhcd,bhdv->bhcv', qn, S)
        S = dn[..., None] * S + jnp.einsum('bhcd,bhcv->bhdv', kn, vn)
        return S, o

    xs = (jnp.moveaxis(q_inter, 2, 0), jnp.moveaxis(k_state, 2, 0),
          jnp.moveaxis(v, 2, 0), jnp.moveaxis(decay_last, 2, 0))
    S0 = jnp.zeros((B, H, dk, dv), jnp.float32)
    _, o_inter = lax.scan(step, S0, xs)
    o = o_intra + jnp.moveaxis(o_inter, 0, 2)
    return o.reshape(B, H, T, dv)


def moba_attention(q, k, v):
    B, H, T, hd = q.shape
    nb = -(-T // MOBA_BLOCK)
    T_pad = nb * MOBA_BLOCK
    n_sel = min(MOBA_TOPK, nb)
    scale = hd ** -0.5
    pad = ((0, 0), (0, 0), (0, T_pad - T), (0, 0))
    k_pad = jnp.pad(k, pad)
    v_pad = jnp.pad(v, pad)
    kb = k_pad.reshape(B, H, nb, MOBA_BLOCK, hd)
    vb = v_pad.reshape(B, H, nb, MOBA_BLOCK, hd)
    k_mean = kb.astype(jnp.float32).mean(axis=3)
    gate = jnp.einsum('bhtd,bhnd->bhtn', q.astype(jnp.float32), k_mean)
    q_blk = jnp.arange(T) // MOBA_BLOCK
    past = jnp.arange(nb)[None, :] < q_blk[:, None]
    gate = jnp.where(past, gate, NEG_INF)
    _, sel = lax.top_k(gate, n_sel)
    sel_valid = sel < q_blk[:, None]
    bi = jnp.arange(B)[:, None, None, None]
    hi = jnp.arange(H)[None, :, None, None]
    Q = MOBA_Q_CHUNK

    def chunk(c):
        t0 = c * Q
        qc = lax.dynamic_slice_in_dim(q, t0, Q, axis=2)
        sc = lax.dynamic_slice_in_dim(sel, t0, Q, axis=2)
        okc = lax.dynamic_slice_in_dim(sel_valid, t0, Q, axis=2)
        k_sel = kb[bi, hi, sc]
        v_sel = vb[bi, hi, sc]
        blk0 = (t0 // MOBA_BLOCK) * MOBA_BLOCK
        k_own = lax.dynamic_slice_in_dim(k_pad, blk0, MOBA_BLOCK, axis=2)
        v_own = lax.dynamic_slice_in_dim(v_pad, blk0, MOBA_BLOCK, axis=2)
        qpos = t0 + jnp.arange(Q)
        kpos = blk0 + jnp.arange(MOBA_BLOCK)
        s_sel = jnp.einsum('bhqd,bhqskd->bhqsk', qc, k_sel).astype(jnp.float32) * scale
        s_sel = jnp.where(okc[..., None], s_sel, NEG_INF).reshape(B, H, Q, n_sel * MOBA_BLOCK)
        s_own = jnp.einsum('bhqd,bhkd->bhqk', qc, k_own).astype(jnp.float32) * scale
        s_own = jnp.where(kpos[None, :] <= qpos[:, None], s_own, NEG_INF)
        p = jax.nn.softmax(jnp.concatenate([s_sel, s_own], axis=-1), axis=-1).astype(v.dtype)
        p_sel = p[..., :n_sel * MOBA_BLOCK].reshape(B, H, Q, n_sel, MOBA_BLOCK)
        p_own = p[..., n_sel * MOBA_BLOCK:]
        return (jnp.einsum('bhqsk,bhqskd->bhqd', p_sel, v_sel)
                + jnp.einsum('bhqk,bhkd->bhqd', p_own, v_own))

    out = lax.map(chunk, jnp.arange(T // Q))
    return jnp.moveaxis(out, 0, 2).reshape(B, H, T, hd)


def hybrid_token_mixer(x, w_in, gla_w_decay, gla_b_decay, gla_norm_g, w_out):
    B, T, _ = x.shape
    proj = x @ w_in
    (q_a, k_a, v_a, r_a, lr_a, q_b, k_b, v_b, gate_a, gate_b) = jnp.split(proj, IN_SPLIT_POINTS, axis=-1)

    def heads(t, h):
        return t.reshape(B, T, h, -1).transpose(0, 2, 1, 3).astype(jnp.float32)

    log_decay = jax.nn.log_sigmoid((lr_a @ gla_w_decay + gla_b_decay).astype(jnp.float32)) / GLA_GATE_NORM
    o_a = gla_chunked(heads(q_a, GLA_HEADS) * (GLA_DK ** -0.5), heads(k_a, GLA_HEADS),
                      heads(v_a, GLA_HEADS), heads(log_decay, GLA_HEADS))
    o_a = o_a.transpose(0, 2, 1, 3)
    o_a = rms_norm(o_a, gla_norm_g) * jax.nn.silu(r_a.reshape(B, T, GLA_HEADS, GLA_DV).astype(jnp.float32))
    y_a = o_a.reshape(B, T, GLA_V_W).astype(x.dtype)

    qb = partial_rope(q_b.reshape(B, T, MOBA_HEADS, MOBA_HD)).transpose(0, 2, 1, 3)
    kb = partial_rope(k_b.reshape(B, T, MOBA_HEADS, MOBA_HD)).transpose(0, 2, 1, 3)
    vb = v_b.reshape(B, T, MOBA_HEADS, MOBA_HD).transpose(0, 2, 1, 3)
    o_b = moba_attention(qb, kb, vb)
    y_b = o_b.transpose(0, 2, 1, 3).reshape(B, T, MOBA_W).astype(x.dtype)

    y = jax.nn.sigmoid(gate_a) * y_a + jax.nn.sigmoid(gate_b) * y_b
    return y @ w_out


def peer_ffn(x, w_q, sub_keys, u_tab, v_tab):
    B, T, D = x.shape
    N = B * T
    K = PEER_TOPK
    xt = x.reshape(N, D)
    qry = (xt @ w_q).reshape(N, PEER_HEADS, 2, PEER_DKEY // 2).astype(jnp.float32)
    s = jnp.einsum('nhpd,pkd->nhpk', qry, sub_keys.astype(jnp.float32))
    s_top, i_top = lax.top_k(s, K)
    cand = (s_top[:, :, 0, :, None] + s_top[:, :, 1, None, :]).reshape(N, PEER_HEADS, K * K)
    cand_id = (i_top[:, :, 0, :, None] * PEER_NKEYS + i_top[:, :, 1, None, :]).reshape(N, PEER_HEADS, K * K)
    best, pos = lax.top_k(cand, K)
    expert = jnp.take_along_axis(cand_id, pos, axis=-1)
    gate = jax.nn.softmax(best, axis=-1)
    nchunk = N // PEER_TOKEN_CHUNK

    def chunk(args):
        xc, ec, gc = args
        u = u_tab[ec]
        hid = jax.nn.gelu(jnp.einsum('cd,chkd->chk', xc, u).astype(jnp.float32), approximate=False)
        w = (gc * hid).astype(x.dtype)
        return jnp.einsum('chk,chkd->cd', w, v_tab[ec])

    out = lax.map(chunk, (xt.reshape(nchunk, PEER_TOKEN_CHUNK, D),
                          expert.reshape(nchunk, PEER_TOKEN_CHUNK, PEER_HEADS, K),
                          gate.reshape(nchunk, PEER_TOKEN_CHUNK, PEER_HEADS, K)))
    return out.reshape(B, T, D)


def setup_inputs(seed: int = 0) -> dict:
    key = jax.random.key(seed)
    ks = jax.random.split(key, 16)
    f32 = jnp.float32

    def nrm(k, shape, s):
        return jax.random.normal(k, shape, f32) * s

    col_scale = jnp.concatenate([jnp.full((w,), DEEPNORM_BETA if is_v else 1.0, f32)
                                 for w, is_v in zip(IN_SPLITS, IN_IS_VALUE)])
    return {
        "x": nrm(ks[0], (BATCH, SEQ, D_MODEL), 1.0),
        "w_in": nrm(ks[1], (DEPTH, D_MODEL, IN_WIDTH), D_MODEL ** -0.5) * col_scale,
        "gla_w_decay": nrm(ks[2], (DEPTH, GLA_LOWRANK, GLA_QK_W), GLA_LOWRANK ** -0.5),
        "gla_b_decay": nrm(ks[3], (DEPTH, GLA_QK_W), 0.1),
        "gla_norm_g": 1.0 + nrm(ks[4], (DEPTH, GLA_DV), 0.02),
        "w_out": nrm(ks[5], (DEPTH, D_MODEL, D_MODEL), D_MODEL ** -0.5 * DEEPNORM_BETA),
        "ln1_g": 1.0 + nrm(ks[6], (DEPTH, D_MODEL), 0.02),
        "ln1_b": nrm(ks[7], (DEPTH, D_MODEL), 0.02),
        "peer_w_q": nrm(ks[8], (DEPTH, D_MODEL, PEER_HEADS * PEER_DKEY), D_MODEL ** -0.5),
        "peer_sub_keys": nrm(ks[9], (DEPTH, 2, PEER_NKEYS, PEER_DKEY // 2), (PEER_DKEY // 2) ** -0.5),
        "peer_u": nrm(ks[10], (DEPTH, PEER_N_EXPERTS, D_MODEL), D_MODEL ** -0.5),
        "peer_v": nrm(ks[11], (DEPTH, PEER_N_EXPERTS, D_MODEL), DEEPNORM_BETA),
        "ln2_g": 1.0 + nrm(ks[12], (DEPTH, D_MODEL), 0.02),
        "ln2_b": nrm(ks[13], (DEPTH, D_MODEL), 0.02),
    }


def reference(x, w_in, gla_w_decay, gla_b_decay, gla_norm_g, w_out, ln1_g, ln1_b,
              peer_w_q, peer_sub_keys, peer_u, peer_v, ln2_g, ln2_b):
    for l in range(DEPTH):
        h = hybrid_token_mixer(x, w_in[l], gla_w_decay[l], gla_b_decay[l], gla_norm_g[l], w_out[l])
        x = layer_norm(DEEPNORM_ALPHA * x + h, ln1_g[l], ln1_b[l])
        h = peer_ffn(x, peer_w_q[l], peer_sub_keys[l], peer_u[l], peer_v[l])
        x = layer_norm(DEEPNORM_ALPHA * x + h, ln2_g[l], ln2_b[l])
    return x
```

```cpp
#include <hip/hip_runtime.h>
#include <hip/hip_cooperative_groups.h>
#include <math.h>
#include <stdint.h>
#include <stdio.h>

namespace cg = cooperative_groups;

#ifndef MODE_COOP
#define MODE_COOP 1
#endif

#define D_MODEL 1024
#define SEQ 2048
#define NTOK 32768
#define IN_WIDTH 8208
#define OFF_QA 0
#define OFF_KA 512
#define OFF_VA 1024
#define OFF_RA 2048
#define OFF_LR 3072
#define OFF_QB 3088
#define OFF_KB 4112
#define OFF_VB 5136
#define OFF_GA 6160
#define OFF_GB 7184
#define CHUNK_SEQS 4
#define CHUNK_TOK (CHUNK_SEQS * SEQ)
#define NCHUNK (NTOK / CHUNK_TOK)
#define DN_ALPHA 1.189207115002721f

struct Params {
    const float *x, *w_in, *gla_wd, *gla_bd, *gla_ng, *w_out, *ln1_g, *ln1_b, *w_q, *sub_keys, *pu, *pv, *ln2_g, *ln2_b;
    float* out;
    float* proj;
    float* dec;
    float* oa;
    float* ob;
    float* kmean;
    float* x1;
};

__device__ __forceinline__ float wave_sum(float v) {
#pragma unroll
    for (int o = 32; o > 0; o >>= 1) v += __shfl_xor(v, o, 64);
    return v;
}
__device__ __forceinline__ void wave_argmax(float& v, int& i) {
#pragma unroll
    for (int o = 32; o > 0; o >>= 1) {
        float ov = __shfl_xor(v, o, 64);
        int oi = __shfl_xor(i, o, 64);
        bool take = (ov > v) || (ov == v && oi < i);
        v = take ? ov : v;
        i = take ? oi : i;
    }
}
__device__ __forceinline__ float block_sum(float v, float* red) {
    v = wave_sum(v);
    __syncthreads();
    if ((threadIdx.x & 63) == 0) red[threadIdx.x >> 6] = v;
    __syncthreads();
    return red[0] + red[1] + red[2] + red[3];
}

__device__ void sgemm_tile(const float* __restrict__ A, int lda, const float* __restrict__ B, int ldb, float* __restrict__ C, int ldc,
                           int N, int K, int tm, int tn, float* smem) {
    float* As = smem;
    float* Bs = smem + 16 * 64;
    const int tid = threadIdx.x, tx = tid & 15, ty = tid >> 4;
    const int m0 = tm * 64, n0 = tn * 64;
    float acc[4][4];
#pragma unroll
    for (int i = 0; i < 4; ++i)
#pragma unroll
        for (int j = 0; j < 4; ++j) acc[i][j] = 0.f;
    const int ar = tid >> 2, akq = (tid & 3) * 4;
    const int bk = tid >> 4, bnq = (tid & 15) * 4;
    for (int k0 = 0; k0 < K; k0 += 16) {
        float4 av = *(const float4*)(A + (size_t)(m0 + ar) * lda + k0 + akq);
        float4 bv = make_float4(0.f, 0.f, 0.f, 0.f);
        if (n0 + bnq < N) bv = *(const float4*)(B + (size_t)(k0 + bk) * ldb + n0 + bnq);
        __syncthreads();
        As[(akq + 0) * 64 + ar] = av.x;
        As[(akq + 1) * 64 + ar] = av.y;
        As[(akq + 2) * 64 + ar] = av.z;
        As[(akq + 3) * 64 + ar] = av.w;
        *(float4*)(Bs + bk * 64 + bnq) = bv;
        __syncthreads();
#pragma unroll
        for (int kk = 0; kk < 16; ++kk) {
            float4 a = *(const float4*)(As + kk * 64 + ty * 4);
            float4 b = *(const float4*)(Bs + kk * 64 + tx * 4);
            float aa[4] = {a.x, a.y, a.z, a.w}, bb[4] = {b.x, b.y, b.z, b.w};
#pragma unroll
            for (int i = 0; i < 4; ++i)
#pragma unroll
                for (int j = 0; j < 4; ++j) acc[i][j] += aa[i] * bb[j];
        }
    }
    if (n0 + tx * 4 < N) {
#pragma unroll
        for (int i = 0; i < 4; ++i)
            *(float4*)(C + (size_t)(m0 + ty * 4 + i) * ldc + n0 + tx * 4) = make_float4(acc[i][0], acc[i][1], acc[i][2], acc[i][3]);
    }
}

__device__ void phase_decay_rope(const Params& p, int vb, float* smem) {
    const int tl = vb, tid = threadIdx.x;
    float* row = p.proj + (size_t)tl * IN_WIDTH;
    float* lr = smem;
    if (tid < 16) lr[tid] = row[OFF_LR + tid];
    __syncthreads();
    for (int j = tid; j < 512; j += 256) {
        float z = p.gla_bd[j];
#pragma unroll
        for (int r = 0; r < 16; ++r) z += lr[r] * p.gla_wd[r * 512 + j];
        float ls = fminf(z, 0.f) - log1pf(expf(-fabsf(z)));
        p.dec[(size_t)tl * 512 + j] = expf(ls * (1.0f / 16.0f));
    }
    {
        const int which = tid >> 7, h = (tid >> 4) & 7, i = tid & 15;
        const int pos = tl & (SEQ - 1);
        const float inv_freq = (float)pow(500000.0, -(double)i / 16.0);
        const float ang = (float)pos * inv_freq;
        const float c = (float)cos((double)ang), s = (float)sin((double)ang);
        float* base = row + (which ? OFF_KB : OFF_QB) + h * 128;
        const float x1 = base[i], x2 = base[i + 16];
        base[i] = x1 * c - x2 * s;
        base[i + 16] = x1 * s + x2 * c;
    }
}

__device__ void phase_kmean(const Params& p, int vb, float* smem) {
    const int s = vb >> 6, h = (vb >> 3) & 7, n = vb & 7, tid = threadIdx.x;
    const int d = tid & 127, half = tid >> 7;
    float acc = 0.f;
    const float* base = p.proj + (size_t)(s * SEQ + n * 256 + half * 128) * IN_WIDTH + OFF_KB + h * 128 + d;
    for (int j = 0; j < 128; ++j) acc += base[(size_t)j * IN_WIDTH];
    smem[tid] = acc;
    __syncthreads();
    if (tid < 128) p.kmean[((s * 8 + h) * 8 + n) * 128 + d] = (smem[tid] + smem[tid + 128]) * (1.0f / 256.0f);
}

__device__ void phase_gla(const Params& p, int vb, float* smem) {
    const int TB = 8;
    const int s = vb >> 4, h = (vb >> 2) & 3, vs = vb & 3;
    float* qs = smem;
    float* ks = qs + TB * 128;
    float* ds = ks + TB * 128;
    float* vv = ds + TB * 128;
    float* red = vv + TB * 64;
    const int tid = threadIdx.x, v = tid & 63, dg = tid >> 6;
    float S[32];
#pragma unroll
    for (int i = 0; i < 32; ++i) S[i] = 0.f;
    const float scale = 0.08838834764831845f;
    for (int t0 = 0; t0 < SEQ; t0 += TB) {
        __syncthreads();
        for (int i = tid; i < TB * 128; i += 256) {
            const int tt = i >> 7, d = i & 127;
            const size_t row = (size_t)(s * SEQ + t0 + tt);
            qs[i] = p.proj[row * IN_WIDTH + OFF_QA + h * 128 + d] * scale;
            ks[i] = p.proj[row * IN_WIDTH + OFF_KA + h * 128 + d];
            ds[i] = p.dec[row * 512 + h * 128 + d];
        }
        for (int i = tid; i < TB * 64; i += 256) {
            const int tt = i >> 6, c = i & 63;
            const size_t row = (size_t)(s * SEQ + t0 + tt);
            vv[i] = p.proj[row * IN_WIDTH + OFF_VA + h * 256 + vs * 64 + c];
        }
        __syncthreads();
        for (int tt = 0; tt < TB; ++tt) {
            const float vval = vv[tt * 64 + v];
            float acc = 0.f;
#pragma unroll
            for (int i = 0; i < 32; ++i) {
                const int d = dg * 32 + i;
                S[i] = S[i] * ds[tt * 128 + d] + ks[tt * 128 + d] * vval;
                acc += qs[tt * 128 + d] * S[i];
            }
            red[(tt * 4 + dg) * 64 + v] = acc;
        }
        __syncthreads();
        for (int i = tid; i < TB * 64; i += 256) {
            const int tt = i >> 6, c = i & 63;
            const float o = red[(tt * 4 + 0) * 64 + c] + red[(tt * 4 + 1) * 64 + c] + red[(tt * 4 + 2) * 64 + c] + red[(tt * 4 + 3) * 64 + c];
            p.oa[(size_t)(s * SEQ + t0 + tt) * 1024 + h * 256 + vs * 64 + c] = o;
        }
    }
}

__device__ void phase_moba(const Params& p, int vb, float* smem) {
    const int wave = threadIdx.x >> 6, lane = threadIdx.x & 63;
    const int item = vb * 4 + wave;
    const int tl = item >> 3, h = item & 7;
    const int s = tl >> 11, pos = tl & (SEQ - 1), qblk = pos >> 8;
    const float* P = p.proj;
    const float2 q = *(const float2*)(P + (size_t)tl * IN_WIDTH + OFF_QB + h * 128 + 2 * lane);
    float g[7];
#pragma unroll
    for (int n = 0; n < 7; ++n) {
        const float2 km = *(const float2*)(p.kmean + ((s * 8 + h) * 8 + n) * 128 + 2 * lane);
        const float d = wave_sum(q.x * km.x + q.y * km.y);
        g[n] = (n < qblk) ? d : -INFINITY;
    }
    unsigned selmask = 0;
    if (qblk <= 3) {
        selmask = (1u << qblk) - 1u;
    } else {
#pragma unroll
        for (int r = 0; r < 3; ++r) {
            float best = -INFINITY;
            int bi = 0;
#pragma unroll
            for (int n = 0; n < 7; ++n) {
                const bool ok = (n < qblk) && !((selmask >> n) & 1u) && (g[n] > best);
                best = ok ? g[n] : best;
                bi = ok ? n : bi;
            }
            selmask |= 1u << bi;
        }
    }
    const float scale = 0.08838834764831845f;
    float m = -INFINITY, l = 0.f;
    float2 acc = make_float2(0.f, 0.f);
    for (int n = 0; n <= qblk; ++n) {
        int nk;
        if (n == qblk) nk = (pos & 255) + 1;
        else if ((selmask >> n) & 1u) nk = 256;
        else continue;
        const float* kb = P + (size_t)(s * SEQ + n * 256) * IN_WIDTH + OFF_KB + h * 128 + 2 * lane;
        const float* vb_ = P + (size_t)(s * SEQ + n * 256) * IN_WIDTH + OFF_VB + h * 128 + 2 * lane;
        for (int j = 0; j < nk; ++j) {
            const float2 k2 = *(const float2*)(kb + (size_t)j * IN_WIDTH);
            const float2 v2 = *(const float2*)(vb_ + (size_t)j * IN_WIDTH);
            const float sc = wave_sum(q.x * k2.x + q.y * k2.y) * scale;
            const float mn = fmaxf(m, sc);
            const float corr = expf(m - mn);
            const float pe = expf(sc - mn);
            l = l * corr + pe;
            acc.x = acc.x * corr + pe * v2.x;
            acc.y = acc.y * corr + pe * v2.y;
            m = mn;
        }
    }
    const float inv = 1.0f / l;
    *(float2*)(p.ob + (size_t)tl * 1024 + h * 128 + 2 * lane) = make_float2(acc.x * inv, acc.y * inv);
}

__device__ void phase_merge(const Params& p, int vb, float* smem) {
    const int tl = vb, tid = threadIdx.x;
    const float* row = p.proj + (size_t)tl * IN_WIDTH;
    float o[4], ss[4];
#pragma unroll
    for (int j = 0; j < 4; ++j) {
        o[j] = p.oa[(size_t)tl * 1024 + j * 256 + tid];
        ss[j] = block_sum(o[j] * o[j], smem);
    }
    const float ng = p.gla_ng[tid];
#pragma unroll
    for (int j = 0; j < 4; ++j) {
        const int c = j * 256 + tid;
        const float rs = rsqrtf(ss[j] * (1.0f / 256.0f) + 1e-6f);
        const float r = row[OFF_RA + c];
        const float ya = o[j] * rs * ng * (r / (1.0f + expf(-r)));
        const float ga = row[OFF_GA + c], gb = row[OFF_GB + c];
        const float yb = p.ob[(size_t)tl * 1024 + c];
        p.oa[(size_t)tl * 1024 + c] = ya / (1.0f + expf(-ga)) + yb / (1.0f + expf(-gb));
    }
}

__device__ void ln_row(const float* a, const float* b, const float* g, const float* be, float* out, float* smem) {
    const int tid = threadIdx.x;
    float v[4];
    float sum = 0.f;
#pragma unroll
    for (int j = 0; j < 4; ++j) {
        v[j] = DN_ALPHA * a[j * 256 + tid] + b[j * 256 + tid];
        sum += v[j];
    }
    const float mu = block_sum(sum, smem) * (1.0f / 1024.0f);
    float sq = 0.f;
#pragma unroll
    for (int j = 0; j < 4; ++j) {
        const float d = v[j] - mu;
        sq += d * d;
    }
    const float var = block_sum(sq, smem) * (1.0f / 1024.0f);
    const float rs = rsqrtf(var + 1e-5f);
#pragma unroll
    for (int j = 0; j < 4; ++j) out[j * 256 + tid] = (v[j] - mu) * rs * g[j * 256 + tid] + be[j * 256 + tid];
}

__device__ void phase_peer_select(const Params& p, int vb, float* smem) {
    const int wave = threadIdx.x >> 6, lane = threadIdx.x & 63;
    const int item = vb * 4 + wave;
    const int n = item >> 3, h = item & 7;
    float* qs = smem + wave * 256;
    float* st = smem + 1024 + wave * 32;
    int* it = (int*)(smem + 1024 + 128) + wave * 32;
    float* bs = smem + 1024 + 256 + wave * 16;
    int* bc = (int*)(smem + 1024 + 256 + 64) + wave * 16;
    const float* q = p.proj + (size_t)n * 2048 + h * 256;
    __syncthreads();
    for (int i = lane; i < 256; i += 64) qs[i] = q[i];
    __syncthreads();
    for (int pp = 0; pp < 2; ++pp) {
        const float* r0 = p.sub_keys + (size_t)pp * 128 * 128 + lane * 128;
        const float* r1 = r0 + 64 * 128;
        float v0 = 0.f, v1 = 0.f;
        for (int d = 0; d < 128; d += 4) {
            const float4 a = *(const float4*)(r0 + d);
            const float4 b = *(const float4*)(r1 + d);
            const float4 qq = *(const float4*)(qs + pp * 128 + d);
            v0 += a.x * qq.x + a.y * qq.y + a.z * qq.z + a.w * qq.w;
            v1 += b.x * qq.x + b.y * qq.y + b.z * qq.z + b.w * qq.w;
        }
        for (int r = 0; r < 16; ++r) {
            float bv;
            int bi;
            if (v0 >= v1) { bv = v0; bi = lane; } else { bv = v1; bi = lane + 64; }
            wave_argmax(bv, bi);
            if (lane == 0) { st[pp * 16 + r] = bv; it[pp * 16 + r] = bi; }
            if (bi == lane) v0 = -INFINITY;
            if (bi == lane + 64) v1 = -INFINITY;
        }
    }
    __syncthreads();
    float cv[4];
#pragma unroll
    for (int j = 0; j < 4; ++j) {
        const int c = lane + 64 * j;
        cv[j] = st[c >> 4] + st[16 + (c & 15)];
    }
    for (int r = 0; r < 16; ++r) {
        float bv = cv[0];
        int bi = lane;
#pragma unroll
        for (int j = 1; j < 4; ++j)
            if (cv[j] > bv) { bv = cv[j]; bi = lane + 64 * j; }
        wave_argmax(bv, bi);
        if (lane == 0) { bs[r] = bv; bc[r] = bi; }
#pragma unroll
        for (int j = 0; j < 4; ++j)
            if (bi == lane + 64 * j) cv[j] = -INFINITY;
    }
    __syncthreads();
    {
        float e = 0.f;
        int c = 0;
        if (lane < 16) { e = expf(bs[lane] - bs[0]); c = bc[lane]; }
        const float sum = wave_sum(e);
        if (lane < 16) {
            const int ex = it[c >> 4] * 128 + it[16 + (c & 15)];
            ((int*)p.dec)[(size_t)n * 128 + h * 16 + lane] = ex;
            p.oa[(size_t)n * 128 + h * 16 + lane] = e / sum;
        }
    }
}

__device__ void phase_peer_apply(const Params& p, int vb, float* smem) {
    const int n = vb, tid = threadIdx.x, wave = tid >> 6, lane = tid & 63;
    const int* sel_e = (const int*)p.dec;
    const float* sel_g = p.oa;
    float4 xv[4], acc[4];
#pragma unroll
    for (int j = 0; j < 4; ++j) {
        xv[j] = *(const float4*)(p.x1 + (size_t)n * 1024 + j * 256 + lane * 4);
        acc[j] = make_float4(0.f, 0.f, 0.f, 0.f);
    }
    for (int kk = 0; kk < 32; ++kk) {
        const int idx = n * 128 + wave * 32 + kk;
        const int e = sel_e[idx];
        const float g = sel_g[idx];
        const float* ur = p.pu + (size_t)e * 1024 + lane * 4;
        float d = 0.f;
#pragma unroll
        for (int j = 0; j < 4; ++j) {
            const float4 u = *(const float4*)(ur + j * 256);
            d += u.x * xv[j].x + u.y * xv[j].y + u.z * xv[j].z + u.w * xv[j].w;
        }
        d = wave_sum(d);
        const float w = g * 0.5f * d * (1.0f + erff(d * 0.7071067811865476f));
        const float* vr = p.pv + (size_t)e * 1024 + lane * 4;
#pragma unroll
        for (int j = 0; j < 4; ++j) {
            const float4 vv = *(const float4*)(vr + j * 256);
            acc[j].x += w * vv.x;
            acc[j].y += w * vv.y;
            acc[j].z += w * vv.z;
            acc[j].w += w * vv.w;
        }
    }
    __syncthreads();
#pragma unroll
    for (int j = 0; j < 4; ++j) *(float4*)(smem + wave * 1024 + j * 256 + lane * 4) = acc[j];
    __syncthreads();
    float* hrow = smem + 4096;
    for (int c = tid; c < 1024; c += 256) hrow[c] = smem[c] + smem[1024 + c] + smem[2048 + c] + smem[3072 + c];
    __syncthreads();
    ln_row(p.x1 + (size_t)n * 1024, hrow, p.ln2_g, p.ln2_b, p.out + (size_t)n * 1024, smem + 4096 + 1024);
}

enum { PH_INPROJ = 0, PH_DECAY_ROPE, PH_KMEAN, PH_GLA_MOBA, PH_MERGE, PH_OUTPROJ, PH_LN1, PH_QRY, PH_SELECT, PH_APPLY };

__device__ __forceinline__ int phase_nvb(int ph) {
    switch (ph) {
        case PH_INPROJ: return (CHUNK_TOK / 64) * ((IN_WIDTH + 63) / 64);
        case PH_DECAY_ROPE: return CHUNK_TOK;
        case PH_KMEAN: return CHUNK_SEQS * 64;
        case PH_GLA_MOBA: return 64 + CHUNK_TOK * 2;
        case PH_MERGE: return CHUNK_TOK;
        case PH_OUTPROJ: return (CHUNK_TOK / 64) * 16;
        case PH_LN1: return CHUNK_TOK;
        case PH_QRY: return (NTOK / 64) * 32;
        case PH_SELECT: return NTOK * 2;
        case PH_APPLY: return NTOK;
    }
    return 0;
}

__device__ void do_phase(const Params& p, int ph, int chunk, int bid, int nb, float* smem) {
    const int nvb = phase_nvb(ph);
    for (int vb = bid; vb < nvb; vb += nb) {
        __syncthreads();
        switch (ph) {
            case PH_INPROJ: {
                const int ntn = (IN_WIDTH + 63) / 64;
                sgemm_tile(p.x + (size_t)chunk * CHUNK_TOK * 1024, 1024, p.w_in, IN_WIDTH, p.proj, IN_WIDTH, IN_WIDTH, 1024, vb / ntn, vb % ntn, smem);
            } break;
            case PH_DECAY_ROPE: phase_decay_rope(p, vb, smem); break;
            case PH_KMEAN: phase_kmean(p, vb, smem); break;
            case PH_GLA_MOBA:
                if (vb < 64) phase_gla(p, vb, smem);
                else phase_moba(p, vb - 64, smem);
                break;
            case PH_MERGE: phase_merge(p, vb, smem); break;
            case PH_OUTPROJ: sgemm_tile(p.oa, 1024, p.w_out, 1024, p.ob, 1024, 1024, 1024, vb / 16, vb % 16, smem); break;
            case PH_LN1:
                ln_row(p.x + ((size_t)chunk * CHUNK_TOK + vb) * 1024, p.ob + (size_t)vb * 1024, p.ln1_g, p.ln1_b,
                       p.x1 + ((size_t)chunk * CHUNK_TOK + vb) * 1024, smem);
                break;
            case PH_QRY: sgemm_tile(p.x1, 1024, p.w_q, 2048, p.proj, 2048, 2048, 1024, vb / 32, vb % 32, smem); break;
            case PH_SELECT: phase_peer_select(p, vb, smem); break;
            case PH_APPLY: phase_peer_apply(p, vb, smem); break;
        }
    }
}

#define SMEM_FLOATS 8192

__global__ void __launch_bounds__(256) mega_kernel(Params p) {
    __shared__ float smem[SMEM_FLOATS];
    cg::grid_group grid = cg::this_grid();
    const int bid = blockIdx.x, nb = gridDim.x;
    const int nsteps = NCHUNK * 7 + 3;
    for (int step = 0; step < nsteps; ++step) {
        int ph, chunk;
        if (step < NCHUNK * 7) { chunk = step / 7; ph = step % 7; } else { chunk = 0; ph = 7 + (step - NCHUNK * 7); }
        do_phase(p, ph, chunk, bid, nb, smem);
        if (step + 1 < nsteps) grid.sync();
    }
}

__global__ void __launch_bounds__(256) phase_kernel(Params p, int ph, int chunk) {
    __shared__ float smem[SMEM_FLOATS];
    do_phase(p, ph, chunk, blockIdx.x, gridDim.x, smem);
}

extern "C" void kernel_launch(void* const* d_in, const int* in_sizes, int n_in, void* d_out, int out_size, void* d_ws, size_t ws_size,
                              hipStream_t stream) {
    Params p{};
    p.x = (const float*)d_in[0];
    p.w_in = (const float*)d_in[1];
    p.gla_wd = (const float*)d_in[2];
    p.gla_bd = (const float*)d_in[3];
    p.gla_ng = (const float*)d_in[4];
    p.w_out = (const float*)d_in[5];
    p.ln1_g = (const float*)d_in[6];
    p.ln1_b = (const float*)d_in[7];
    p.w_q = (const float*)d_in[8];
    p.sub_keys = (const float*)d_in[9];
    p.pu = (const float*)d_in[10];
    p.pv = (const float*)d_in[11];
    p.ln2_g = (const float*)d_in[12];
    p.ln2_b = (const float*)d_in[13];
    p.out = (float*)d_out;
    char* ws = (char*)d_ws;
    size_t off = 0;
    auto take = [&](size_t bytes) { char* r = ws + off; off += (bytes + 255) & ~(size_t)255; return r; };
    p.proj = (float*)take((size_t)CHUNK_TOK * IN_WIDTH * 4);
    p.dec = (float*)take((size_t)CHUNK_TOK * 512 * 4);
    p.oa = (float*)take((size_t)CHUNK_TOK * 1024 * 4);
    p.ob = (float*)take((size_t)CHUNK_TOK * 1024 * 4);
    p.kmean = (float*)take((size_t)CHUNK_SEQS * 8 * 8 * 128 * 4);
    p.x1 = (float*)take((size_t)NTOK * 1024 * 4);
    if (off > ws_size) { fprintf(stderr, "workspace too small: need %zu have %zu\n", off, ws_size); return; }
#if MODE_COOP
    static int grid_blocks = 0;
    if (!grid_blocks) {
        int dev = 0, cus = 0, per_cu = 0;
        hipGetDevice(&dev);
        hipDeviceGetAttribute(&cus, hipDeviceAttributeMultiprocessorCount, dev);
        hipOccupancyMaxActiveBlocksPerMultiprocessor(&per_cu, mega_kernel, 256, 0);
        if (per_cu > 4) per_cu = 4;
        if (per_cu < 1) per_cu = 1;
        grid_blocks = cus * per_cu;
    }
    void* args[] = {&p};
    hipError_t e = hipLaunchCooperativeKernel((const void*)mega_kernel, dim3(grid_blocks), dim3(256), args, 0, stream);
    if (e != hipSuccess) fprintf(stderr, "cooperative launch failed: %s (grid %d)\n", hipGetErrorString(e), grid_blocks);
#else
    const int G = 2048;
    for (int chunk = 0; chunk < NCHUNK; ++chunk) {
        for (int ph = PH_INPROJ; ph <= PH_LN1; ++ph) phase_kernel<<<G, 256, 0, stream>>>(p, ph, chunk);
    }
    for (int ph = PH_QRY; ph <= PH_APPLY; ++ph) phase_kernel<<<G, 256, 0, stream>>>(p, ph, 0);
#endif
}
```

```cpp
#include <hip/hip_runtime.h>
#include <hip/hip_cooperative_groups.h>
#include <math.h>
#include <stdint.h>
#include <stdio.h>

namespace cg = cooperative_groups;

#define D_MODEL 1024
#define SEQ 2048
#define NTOK 32768
#define IN_WIDTH 8208
#define OFF_LR 3072
#define CHUNK_SEQS 8
#define CT (CHUNK_SEQS * SEQ)
#define NCHUNK (NTOK / CT)
#define DN_ALPHA 1.189207115002721f
#define NTHREADS 512
#define LDS_BYTES 147456

namespace pg8 {
#define PG8_LAS __attribute__((address_space(3)))
typedef unsigned short bf16_t;
typedef short bf16x8 __attribute__((ext_vector_type(8)));
typedef float f32x4 __attribute__((ext_vector_type(4)));
typedef unsigned u32x4 __attribute__((ext_vector_type(4)));
constexpr int BM = 256, BK = 64, HALF = 128, HTB = HALF * BK * 2  , STAGE_BYTES = 8 * HTB, NXCD = 8, WGM = 8;

__host__ __device__ __forceinline__ int lds_byte(int r, int c) { const int st = (r >> 4) * 2 + (c >> 5), rr = r & 15, cc = c & 31, ob = rr * 64 + cc * 2; return st * 1024 + (ob ^ (((ob >> 9) & 1) << 5)); }
__host__ __device__ __forceinline__ void stage_rc(int b, int& R, int& C) { const int st = b / 1024, sb = b % 1024, swz = sb ^ (((sb >> 9) & 1) << 5); R = (st >> 1) * 16 + swz / 64; C = (st & 1) * 32 + (swz % 64) / 2; }
__host__ __device__ __forceinline__ int perm32(int rho) { const int n = rho >> 4, i = rho & 15; return 8 * (i >> 2) + 4 * n + (i & 3); }

struct Unit { int pm, pn; };
struct Gemm { const bf16_t* A; const bf16_t* Bt; int M, N, K; };

struct StaticOrder {
    int nM, nN, nwg, G, c;
    __host__ __device__ void init(int M, int N, int G_, int c_) { nM = M / BM; nN = N / BM; nwg = nM * nN; G = G_; c = c_; }
    __host__ __device__ bool next(int i, Unit& u) const {
        const long L = (long)i * G + c; if (L >= nwg) return false;
        int wgid = (int)L; { const int q = nwg / NXCD, r = nwg % NXCD, xcd = wgid % NXCD, off = wgid / NXCD; wgid = (xcd < r ? xcd * (q + 1) : r * (q + 1) + (xcd - r) * q) + off; }
        const int nig = WGM * nN, gid = wgid / nig, fm = gid * WGM, gsz = (nM - fm) < WGM ? (nM - fm) : WGM;
        u.pm = fm + ((wgid % nig) % gsz); u.pn = (wgid % nig) / gsz; return true;
    }
    __device__ __forceinline__ void a_ready(const Unit&) const {}
    __device__ __forceinline__ void done(const Unit&) const {}
};
__device__ __forceinline__ unsigned cvt_pk_bf16(float lo, float hi) { unsigned r; asm volatile("v_cvt_pk_bf16_f32 %0, %1, %2" : "=v"(r) : "v"(lo), "v"(hi)); return r; }
template <class Epi, class Sched, bool ALIGN_EPI = false, bool SP2 = false>
__device__ __forceinline__ void gemm_phase(PG8_LAS unsigned char* lds, const Gemm g, const Sched& S, const Epi& E, const int tid) {
    const int wid = __builtin_amdgcn_readfirstlane(tid >> 6), lane = tid & 63, wr = wid >> 2, wc = wid & 3, fr = lane & 15, fq = lane >> 4;
    const int K = g.K, nt = K / BK;
    unsigned voffA[2], voffB[2];
#pragma unroll
    for (int i = 0; i < 2; ++i) { int R, C; stage_rc(tid * 16 + i * 8192, R, C); const int Rb = Epi::PERM ? ((R & ~31) + perm32(R & 31)) : R;
        voffA[i] = (unsigned)(R * K + C) * 2u; voffB[i] = (unsigned)(Rb * K + C) * 2u; }
    const size_t kstep = (size_t)(BK * 2);
    const size_t hstep = (size_t)HALF * K * 2;
    const size_t tstep = 2 * hstep;
    const unsigned ldsw = (unsigned)wid * 1024u;
    const int aoff = lds_byte(wr * 64 + fr, fq * 8), boff = lds_byte(wc * 32 + fr, fq * 8);
#define PG8_SA(b, h) (((b) * 2 + (h)) * HTB)
#define PG8_SB(b, h) ((4 + (b) * 2 + (h)) * HTB)
#define PG8_STAGE(bufoff, gbase, voff) do { _Pragma("unroll") for (int _i = 0; _i < 2; ++_i) \
        __builtin_amdgcn_global_load_lds((const unsigned*)((const char*)(gbase) + (voff)[_i]), (PG8_LAS unsigned*)(lds + (bufoff) + ldsw + _i * 8192), 16, 0, 0); } while (0)
#define PG8_LDA(dst, b, h) do { _Pragma("unroll") for (int m = 0; m < 4; ++m) _Pragma("unroll") for (int k = 0; k < 2; ++k) dst[m][k] = *(const PG8_LAS bf16x8*)(lds + PG8_SA(b, h) + aoff + m * 2048 + k * 1024); } while (0)
#define PG8_LDB(dst, b, h) do { _Pragma("unroll") for (int n = 0; n < 2; ++n) _Pragma("unroll") for (int k = 0; k < 2; ++k) dst[n][k] = *(const PG8_LAS bf16x8*)(lds + PG8_SB(b, h) + boff + n * 2048 + k * 1024); } while (0)
#define PG8_MMA(ai, bj, At, Bt) do { __builtin_amdgcn_s_setprio(1); _Pragma("unroll") for (int m = 0; m < 4; ++m) _Pragma("unroll") for (int n = 0; n < 2; ++n) _Pragma("unroll") for (int k = 0; k < 2; ++k) \
        acc[ai][bj][m][n] = __builtin_amdgcn_mfma_f32_16x16x32_bf16(Bt[n][k], At[m][k], acc[ai][bj][m][n], 0, 0, 0); __builtin_amdgcn_s_setprio(0); } while (0)
#define PG8_WAIT_V(n) asm volatile("s_waitcnt vmcnt(" #n ")" ::: "memory")
#define PG8_WAIT_L(n) asm volatile("s_waitcnt lgkmcnt(" #n ")" ::: "memory")
#define PG8_BAR __builtin_amdgcn_s_barrier()
#define PG8_SCHED __builtin_amdgcn_sched_barrier(0)
    Unit cur, nxt; int ui = 0;
    if (!S.next(0, cur)) return;
    f32x4 acc[2][2][4][2];
#pragma unroll
    for (int a = 0; a < 2; ++a)
#pragma unroll
        for (int b = 0; b < 2; ++b)
#pragma unroll
            for (int m = 0; m < 4; ++m)
#pragma unroll
                for (int n = 0; n < 2; ++n) acc[a][b][m][n] = (f32x4){0.f, 0.f, 0.f, 0.f};
    bf16x8 At[4][2], B0[2][2], B1[2][2];
    const char* cA = (const char*)g.A + (size_t)cur.pm * tstep; const char* cB = (const char*)g.Bt + (size_t)cur.pn * tstep;
    S.a_ready(cur);
    if constexpr (SP2) {
        PG8_STAGE(PG8_SB(0, 0), cB, voffB); PG8_STAGE(PG8_SB(0, 1), cB + hstep, voffB); PG8_STAGE(PG8_SA(0, 0), cA, voffA); PG8_STAGE(PG8_SA(0, 1), cA + hstep, voffA);
        if (wr == 1) PG8_BAR;
        PG8_WAIT_V(2); PG8_BAR;
        PG8_STAGE(PG8_SB(1, 0), cB + kstep, voffB); PG8_STAGE(PG8_SA(1, 0), cA + kstep, voffA); PG8_STAGE(PG8_SB(1, 1), cB + hstep + kstep, voffB);
        PG8_WAIT_V(6); PG8_BAR;
    } else {
        PG8_STAGE(PG8_SB(0, 0), cB, voffB); PG8_STAGE(PG8_SA(0, 0), cA, voffA); PG8_STAGE(PG8_SB(0, 1), cB + hstep, voffB); PG8_STAGE(PG8_SA(0, 1), cA + hstep, voffA);
        if (wr == 1) PG8_BAR;
        PG8_WAIT_V(4); PG8_BAR;
        PG8_STAGE(PG8_SB(1, 0), cB + kstep, voffB); PG8_STAGE(PG8_SA(1, 0), cA + kstep, voffA); PG8_STAGE(PG8_SB(1, 1), cB + hstep + kstep, voffB);
        PG8_WAIT_V(6); PG8_BAR;
    }
    for (;;) {
        const bool has_next = S.next(ui + 1, nxt);
        const char* nA = has_next ? (const char*)g.A + (size_t)nxt.pm * tstep : cA; const char* nB = has_next ? (const char*)g.Bt + (size_t)nxt.pn * tstep : cB;
        for (int t = 0; t < nt; t += 2) {
            const bool last = (t == nt - 2);
            const char* a1 = cA + (size_t)(t + 1) * kstep;
            const char* a2 = last ? nA : cA + (size_t)(t + 2) * kstep; const char* b2 = last ? nB : cB + (size_t)(t + 2) * kstep;
            const char* a3 = a2 + kstep; const char* b3 = b2 + kstep;
            if (last && has_next) S.a_ready(nxt);
            if constexpr (SP2) {
            PG8_LDB(B0, 0, 0); PG8_LDB(B1, 0, 1); PG8_SCHED; PG8_LDA(At, 0, 0); PG8_STAGE(PG8_SA(1, 1), a1 + hstep, voffA);
            PG8_WAIT_V(8); PG8_WAIT_L(0); PG8_BAR; PG8_MMA(0, 0, At, B0); PG8_MMA(0, 1, At, B1); PG8_BAR; PG8_SCHED;
            PG8_LDA(At, 0, 1); PG8_STAGE(PG8_SB(0, 0), b2, voffB); PG8_STAGE(PG8_SB(0, 1), b2 + hstep, voffB); PG8_STAGE(PG8_SA(0, 0), a2, voffA);
            PG8_WAIT_V(8); PG8_WAIT_L(0); PG8_BAR; PG8_MMA(1, 0, At, B0); PG8_MMA(1, 1, At, B1); PG8_BAR; PG8_SCHED;
            PG8_LDB(B0, 1, 0); PG8_LDB(B1, 1, 1); PG8_SCHED; PG8_LDA(At, 1, 0); PG8_STAGE(PG8_SA(0, 1), a2 + hstep, voffA);
            PG8_WAIT_V(8); PG8_WAIT_L(0); PG8_BAR; PG8_MMA(0, 0, At, B0); PG8_MMA(0, 1, At, B1); PG8_BAR; PG8_SCHED;
            PG8_LDA(At, 1, 1); PG8_STAGE(PG8_SB(1, 0), b3, voffB); PG8_STAGE(PG8_SB(1, 1), b3 + hstep, voffB); PG8_STAGE(PG8_SA(1, 0), a3, voffA);
            PG8_WAIT_V(8); PG8_WAIT_L(0); PG8_BAR; PG8_MMA(1, 0, At, B0); PG8_MMA(1, 1, At, B1); PG8_BAR; PG8_SCHED;
            } else {
            PG8_LDB(B0, 0, 0); PG8_SCHED; PG8_LDA(At, 0, 0); PG8_STAGE(PG8_SA(1, 1), a1 + hstep, voffA);
            PG8_WAIT_L(8); PG8_BAR; PG8_WAIT_L(0); PG8_MMA(0, 0, At, B0); PG8_BAR; PG8_SCHED;
            PG8_LDB(B1, 0, 1); PG8_STAGE(PG8_SB(0, 0), b2, voffB);
            PG8_BAR; PG8_WAIT_L(0); PG8_MMA(0, 1, At, B1); PG8_BAR;
            PG8_LDA(At, 0, 1); PG8_STAGE(PG8_SA(0, 0), a2, voffA);
            PG8_BAR; PG8_WAIT_L(0); PG8_MMA(1, 0, At, B0); PG8_BAR; PG8_SCHED;
            PG8_STAGE(PG8_SB(0, 1), b2 + hstep, voffB);
            PG8_WAIT_V(6); PG8_BAR; PG8_MMA(1, 1, At, B1); PG8_BAR;
            PG8_LDB(B0, 1, 0); PG8_SCHED; PG8_LDA(At, 1, 0); PG8_STAGE(PG8_SA(0, 1), a2 + hstep, voffA);
            PG8_WAIT_L(8); PG8_BAR; PG8_WAIT_L(0); PG8_MMA(0, 0, At, B0); PG8_BAR; PG8_SCHED;
            PG8_LDB(B1, 1, 1); PG8_STAGE(PG8_SB(1, 0), b3, voffB);
            PG8_BAR; PG8_WAIT_L(0); PG8_MMA(0, 1, At, B1); PG8_BAR;
            PG8_LDA(At, 1, 1); PG8_STAGE(PG8_SA(1, 0), a3, voffA);
            PG8_BAR; PG8_WAIT_L(0); PG8_MMA(1, 0, At, B0); PG8_BAR; PG8_SCHED;
            PG8_STAGE(PG8_SB(1, 1), b3 + hstep, voffB);
            PG8_WAIT_V(6); PG8_BAR; PG8_MMA(1, 1, At, B1); PG8_BAR;
            }
        }
        if constexpr (ALIGN_EPI) { if (wr == 0) PG8_BAR; }
        if constexpr (!Epi::AFTER_DRAIN) { E(acc, cur, wr, wc, fr, fq); S.done(cur); }
        if (!has_next) break;
#pragma unroll
        for (int a = 0; a < 2; ++a)
#pragma unroll
            for (int b = 0; b < 2; ++b)
#pragma unroll
                for (int m = 0; m < 4; ++m)
#pragma unroll
                    for (int n = 0; n < 2; ++n) acc[a][b][m][n] = (f32x4){0.f, 0.f, 0.f, 0.f};
        cur = nxt; cA = nA; cB = nB; ++ui;
        if constexpr (ALIGN_EPI) { if (wr == 1) PG8_BAR; }
    }
    PG8_WAIT_V(0);
    if constexpr (!ALIGN_EPI) { if (wr == 0) PG8_BAR; }
    PG8_BAR;
    if constexpr (Epi::AFTER_DRAIN) { E.fused(acc, cur, wr, wc, fr, fq, lds, wid, lane); S.done(cur); }
#undef PG8_SA
#undef PG8_SB
#undef PG8_STAGE
#undef PG8_LDA
#undef PG8_LDB
#undef PG8_MMA
#undef PG8_WAIT_V
#undef PG8_WAIT_L
#undef PG8_BAR
#undef PG8_SCHED
}
}
typedef unsigned short bf16_t;
typedef unsigned u32x4 __attribute__((ext_vector_type(4)));
typedef float f32x4 __attribute__((ext_vector_type(4)));

struct Params {
    const float *x, *w_in, *gla_wd, *gla_bd, *gla_ng, *w_out, *ln1_g, *ln1_b, *w_q, *sub_keys, *pu, *pv, *ln2_g, *ln2_b;
    float* out;
    char* ws;
#define WSP(T, name, off_bytes) __host__ __device__ __forceinline__ T* name() const { return (T*)(ws + (size_t)(off_bytes)); }
    WSP(bf16_t, winT, 0)
    WSP(bf16_t, woutT, 16u << 20)
    WSP(bf16_t, wqT, 18u << 20)
    WSP(float, rope_cos, 22u << 20)
    WSP(float, rope_sin, (22u << 20) + 131072)
    WSP(float, kmean, (22u << 20) + 262144)
    WSP(bf16_t, y, 23u << 20)
    WSP(bf16_t, x1b, 23u << 20)
    WSP(bf16_t, xbc, 87u << 20)
    WSP(float, g, 119u << 20)
    WSP(bf16_t, qa, 151u << 20)
    WSP(bf16_t, ka, 167u << 20)
    WSP(bf16_t, va, 183u << 20)
    WSP(bf16_t, ra, 215u << 20)
    WSP(bf16_t, ga, 247u << 20)
    WSP(bf16_t, gb, 279u << 20)
    WSP(bf16_t, qb, 311u << 20)
    WSP(bf16_t, kb, 343u << 20)
    WSP(bf16_t, vb, 375u << 20)
    WSP(float, x1, 87u << 20)
    WSP(bf16_t, qry, 215u << 20)
    WSP(int, sel_e, 471u << 20)
    WSP(float, sel_g, 487u << 20)
    WSP(unsigned char, u8, 343u << 20)
    WSP(unsigned char, v8, 359u << 20)
    WSP(bf16_t, part, 87u << 20)
    WSP(bf16_t, h2, 87u << 20)
    WSP(unsigned, qctr, (22u << 20) + 524288)
    WSP(bf16_t, oi, 407u << 20)
    WSP(bf16_t, oe, 439u << 20)
    WSP(float, dl, 471u << 20)
#undef WSP
};

__device__ __forceinline__ unsigned pack_bf16(float lo, float hi) { unsigned r; asm("v_cvt_pk_bf16_f32 %0, %1, %2" : "=v"(r) : "v"(lo), "v"(hi)); return r; }
__device__ __forceinline__ bf16_t f2bf(float f) { return (bf16_t)(pack_bf16(f, f) & 0xffffu); }
__device__ __forceinline__ float bf2f(bf16_t h) { return __uint_as_float((unsigned)h << 16); }

__device__ __forceinline__ float wave_sum(float v) {
#define WS_DPP(ctrl, rmask) v += __int_as_float(__builtin_amdgcn_update_dpp(0, __float_as_int(v), ctrl, rmask, 0xf, true))
    WS_DPP(0xB1, 0xf);
    WS_DPP(0x4E, 0xf);
    WS_DPP(0x141, 0xf);
    WS_DPP(0x140, 0xf);
    WS_DPP(0x142, 0xa);
    WS_DPP(0x143, 0xc);
#undef WS_DPP
    return __int_as_float(__builtin_amdgcn_readlane(__float_as_int(v), 63));
}
__device__ __forceinline__ float block_sum(float v, float* red, int tid) {
    v = wave_sum(v);
    __syncthreads();
    if ((tid & 63) == 0) red[tid >> 6] = v;
    __syncthreads();
    return red[0] + red[1] + red[2] + red[3];
}

struct EpiF32 {
    static constexpr bool PERM = false, AFTER_DRAIN = false;
    float* C; int ldc;
    __device__ __forceinline__ void operator()(const f32x4 (&acc)[2][2][4][2], const pg8::Unit& u, int wr, int wc, int fr, int fq) const {
        const int row0 = u.pm * 256 + wr * 64 + fr, col0 = u.pn * 256 + wc * 32 + 4 * fq;
#pragma unroll
        for (int ai = 0; ai < 2; ++ai)
#pragma unroll
            for (int m = 0; m < 4; ++m) { float* rowp = C + (size_t)(row0 + ai * 128 + m * 16) * ldc + col0;
#pragma unroll
                for (int bj = 0; bj < 2; ++bj)
#pragma unroll
                    for (int n = 0; n < 2; ++n) *(f32x4*)(rowp + bj * 128 + n * 16) = acc[ai][bj][m][n]; }
    }
};
struct EpiBf16 {
    static constexpr bool PERM = true, AFTER_DRAIN = false;
    bf16_t* O; int ldc;
    __device__ __forceinline__ void operator()(const f32x4 (&acc)[2][2][4][2], const pg8::Unit& u, int wr, int wc, int fr, int fq) const {
        const int row0 = u.pm * 256 + wr * 64 + fr, col0 = u.pn * 256 + wc * 32 + 8 * fq;
#pragma unroll
        for (int ai = 0; ai < 2; ++ai)
#pragma unroll
            for (int m = 0; m < 4; ++m) { bf16_t* rowp = O + (size_t)(row0 + ai * 128 + m * 16) * ldc + col0;
#pragma unroll
                for (int bj = 0; bj < 2; ++bj) { const f32x4 v0 = acc[ai][bj][m][0], v1 = acc[ai][bj][m][1];
                    u32x4 w; w.x = pg8::cvt_pk_bf16(v0[0], v0[1]); w.y = pg8::cvt_pk_bf16(v0[2], v0[3]); w.z = pg8::cvt_pk_bf16(v1[0], v1[1]); w.w = pg8::cvt_pk_bf16(v1[2], v1[3]);
                    __builtin_nontemporal_store(w, (u32x4*)(rowp + bj * 128)); } }
    }
};
struct EpiResid {
    static constexpr bool PERM = false, AFTER_DRAIN = false;
    float* C; const float* X;
    __device__ __forceinline__ void operator()(const f32x4 (&acc)[2][2][4][2], const pg8::Unit& u, int wr, int wc, int fr, int fq) const {
        const int row0 = u.pm * 256 + wr * 64 + fr, col0 = u.pn * 256 + wc * 32 + 4 * fq;
#pragma unroll
        for (int ai = 0; ai < 2; ++ai)
#pragma unroll
            for (int m = 0; m < 4; ++m) { const size_t ro = (size_t)(row0 + ai * 128 + m * 16) * 1024 + col0;
#pragma unroll
                for (int bj = 0; bj < 2; ++bj)
#pragma unroll
                    for (int n = 0; n < 2; ++n) { const f32x4 xv = *(const f32x4*)(X + ro + bj * 128 + n * 16);
                        __builtin_nontemporal_store(acc[ai][bj][m][n] + xv * DN_ALPHA, (f32x4*)(C + ro + bj * 128 + n * 16)); } }
    }
};
struct InProjPtrs { char* pc; float *kmean; const float *rope_cos, *rope_sin; };
struct EpiInProj {
    static constexpr bool PERM = true, AFTER_DRAIN = false;
    InProjPtrs p;
    __device__ __forceinline__ void operator()(const f32x4 (&acc)[2][2][4][2], const pg8::Unit& u, int wr, int wc, int fr, int fq) const {
        const int pn = u.pn;
        const int row0 = u.pm * 256 + wr * 64 + fr;
        const int cin = wc * 32 + 8 * fq;
        if (pn >= 12 && pn < 24) {
            const int which = (pn - 12) >> 2;
            bf16_t* T = (bf16_t*)(p.pc + ((size_t)(160 + 32 * which) << 20));
            const int seq = u.pm >> 3, t0 = (u.pm & 7) * 256 + wr * 64 + fr;
            const bool rope = (which < 2) && (wc == 0);
            float ksum[2][8];
#pragma unroll
            for (int bj = 0; bj < 2; ++bj)
#pragma unroll
                for (int e = 0; e < 8; ++e) ksum[bj][e] = 0.f;
#pragma unroll
            for (int ai = 0; ai < 2; ++ai)
#pragma unroll
                for (int m = 0; m < 4; ++m) {
                    int t = t0 + ai * 128 + m * 16;
                    asm volatile("" : "+v"(t) :: "memory");
                    f32x4 c0 = {1.f, 1.f, 1.f, 1.f}, c1 = c0, s0 = {0.f, 0.f, 0.f, 0.f}, s1 = s0;
                    if (rope) {
                        const float* cp = p.rope_cos + t * 16 + 8 * (fq & 1);
                        const float* sp = p.rope_sin + t * 16 + 8 * (fq & 1);
                        c0 = *(const f32x4*)cp; c1 = *(const f32x4*)(cp + 4); s0 = *(const f32x4*)sp; s1 = *(const f32x4*)(sp + 4);
                        if (fq < 2) { s0 = -s0; s1 = -s1; }
                    }
#pragma unroll
                    for (int bj = 0; bj < 2; ++bj) {
                        f32x4 v0 = acc[ai][bj][m][0], v1 = acc[ai][bj][m][1];
                        if (rope) {
                            f32x4 o0, o1;
#pragma unroll
                            for (int j = 0; j < 4; ++j) {
                                const auto r0 = __builtin_amdgcn_permlane32_swap(__float_as_uint(v0[j]), __float_as_uint(v0[j]), false, false);
                                const auto r1 = __builtin_amdgcn_permlane32_swap(__float_as_uint(v1[j]), __float_as_uint(v1[j]), false, false);
                                o0[j] = __uint_as_float(fq < 2 ? r0[1] : r0[0]); o1[j] = __uint_as_float(fq < 2 ? r1[1] : r1[0]);
                            }
                            v0 = v0 * c0 + o0 * s0; v1 = v1 * c1 + o1 * s1;
                        }
                        if (which == 1) {
#pragma unroll
                            for (int j = 0; j < 4; ++j) { ksum[bj][j] += v0[j]; ksum[bj][4 + j] += v1[j]; }
                        }
                        const int head = ((pn - 12) & 3) * 2 + bj;
                        u32x4 w; w.x = pg8::cvt_pk_bf16(v0[0], v0[1]); w.y = pg8::cvt_pk_bf16(v0[2], v0[3]); w.z = pg8::cvt_pk_bf16(v1[0], v1[1]); w.w = pg8::cvt_pk_bf16(v1[2], v1[3]);
                        __builtin_nontemporal_store(w, (u32x4*)(T + ((size_t)(seq * 8 + head) * SEQ + t) * 128 + cin));
                    }
                }
            if (which == 1) {
#pragma unroll
                for (int bj = 0; bj < 2; ++bj)
#pragma unroll
                    for (int e = 0; e < 8; ++e) {
                        float s = ksum[bj][e];
                        s += __int_as_float(__builtin_amdgcn_update_dpp(0, __float_as_int(s), 0xB1, 0xf, 0xf, true));
                        s += __int_as_float(__builtin_amdgcn_update_dpp(0, __float_as_int(s), 0x4E, 0xf, 0xf, true));
                        s += __int_as_float(__builtin_amdgcn_update_dpp(0, __float_as_int(s), 0x141, 0xf, 0xf, true));
                        s += __int_as_float(__builtin_amdgcn_update_dpp(0, __float_as_int(s), 0x140, 0xf, 0xf, true));
                        if (fr == 0) {
                            const int head = ((pn - 12) & 3) * 2 + bj;
                            atomicAdd(p.kmean + ((size_t)((u.pm >> 3) * 8 + head) * 8 + (u.pm & 7)) * 128 + cin + e, s * (1.0f / 256.0f));
                        }
                    }
            }
            return;
        }
        int ld, cbase, mode, offm;
        if (pn < 4) { ld = 512; cbase = (pn & 1) * 256; offm = (pn >> 1) * 16; mode = (pn < 2) ? 1 : 0; }
        else { ld = 1024; cbase = (pn & 3) * 256; const int idx = (pn < 12) ? ((pn - 4) >> 2) : (((pn - 24) >> 2) + 2); offm = 32 + 32 * idx; mode = (idx == 0) ? 0 : (idx == 1 ? 2 : 3); }
        bf16_t* T = (bf16_t*)(p.pc + ((size_t)offm << 20));
#pragma unroll
        for (int ai = 0; ai < 2; ++ai)
#pragma unroll
            for (int m = 0; m < 4; ++m) {
                bf16_t* rowp = T + (size_t)(row0 + ai * 128 + m * 16) * ld + cbase + cin;
#pragma unroll
                for (int bj = 0; bj < 2; ++bj) {
                    f32x4 v0 = acc[ai][bj][m][0], v1 = acc[ai][bj][m][1];
                    if (mode == 1) { v0 = v0 * 0.08838834764831845f; v1 = v1 * 0.08838834764831845f; }
                    else if (mode >= 2) {
#pragma unroll
                        for (int j = 0; j < 4; ++j) {
                            const float g0 = __builtin_amdgcn_rcpf(1.0f + __expf(-v0[j])), g1 = __builtin_amdgcn_rcpf(1.0f + __expf(-v1[j]));
                            v0[j] = (mode == 2) ? v0[j] * g0 : g0; v1[j] = (mode == 2) ? v1[j] * g1 : g1;
                        }
                    }
                    u32x4 w; w.x = pg8::cvt_pk_bf16(v0[0], v0[1]); w.y = pg8::cvt_pk_bf16(v0[2], v0[3]); w.z = pg8::cvt_pk_bf16(v1[0], v1[1]); w.w = pg8::cvt_pk_bf16(v1[2], v1[3]);
                    __builtin_nontemporal_store(w, (u32x4*)(rowp + bj * 128));
                }
            }
    }
};

__device__ __forceinline__ void transpose_tile(const float* __restrict__ src, int ld, bf16_t* __restrict__ dst, int gap_at, int gap, int tk, int tn, float* smem, int tid) {
    const int k0 = tk * 64, n0 = tn * 64;
    int c0 = n0; if (c0 >= gap_at) c0 += gap;
    {
        const int r = tid >> 3, cq = (tid & 7) * 8;
        const float4 a = *(const float4*)(src + (size_t)(k0 + r) * ld + c0 + cq);
        const float4 b = *(const float4*)(src + (size_t)(k0 + r) * ld + c0 + cq + 4);
        float* d = smem + r * 65 + cq;
        d[0] = a.x; d[1] = a.y; d[2] = a.z; d[3] = a.w; d[4] = b.x; d[5] = b.y; d[6] = b.z; d[7] = b.w;
    }
    __syncthreads();
    {
        const int n = tid >> 3, kq = (tid & 7) * 8;
        unsigned w[4];
#pragma unroll
        for (int j = 0; j < 4; ++j) w[j] = pack_bf16(smem[(kq + 2 * j) * 65 + n], smem[(kq + 2 * j + 1) * 65 + n]);
        *(u32x4*)(dst + (size_t)(n0 + n) * 1024 + k0 + kq) = (u32x4){w[0], w[1], w[2], w[3]};
    }
    __syncthreads();
}

__device__ __forceinline__ void phase_xconv(const Params& p, int chunk, float* smem, const int t) {
    const int wave = t >> 6, lane = t & 63;
    float* wlr = smem;
    float* wd = smem + 16 * 1024;
#pragma unroll 1
    for (int i = t; i < 16 * 1024; i += NTHREADS) { const int k = i >> 4, r = i & 15; wlr[r * 1024 + k] = p.w_in[(size_t)k * IN_WIDTH + OFF_LR + r]; }
#pragma unroll 1
    for (int i = t; i < 16 * 512; i += NTHREADS) wd[i] = p.gla_wd[i];
    __syncthreads();
    f32x4 bd0 = *(const f32x4*)(p.gla_bd + lane * 8), bd1 = *(const f32x4*)(p.gla_bd + lane * 8 + 4);
#pragma unroll 1
    for (int tl = blockIdx.x * 8 + wave; tl < CT; tl += gridDim.x * 8) {
        const float* xr = p.x + ((size_t)chunk * CT + tl) * 1024;
        f32x4 xv[4];
#pragma unroll
        for (int j = 0; j < 4; ++j) xv[j] = *(const f32x4*)(xr + j * 256 + lane * 4);
#pragma unroll
        for (int j = 0; j < 4; ++j) {
            uint2 w; w.x = pack_bf16(xv[j][0], xv[j][1]); w.y = pack_bf16(xv[j][2], xv[j][3]);
            *(uint2*)(p.xbc() + (size_t)tl * 1024 + j * 256 + lane * 4) = w;
        }
        f32x4 z0 = bd0, z1 = bd1;
#pragma unroll 1
        for (int r = 0; r < 16; ++r) {
            float d = 0.f;
#pragma unroll
            for (int j = 0; j < 4; ++j) { const f32x4 wv = *(const f32x4*)(wlr + r * 1024 + j * 256 + lane * 4); d += (wv[0] * xv[j][0] + wv[1] * xv[j][1]) + (wv[2] * xv[j][2] + wv[3] * xv[j][3]); }
            const float lr = wave_sum(d);
            const f32x4 w0 = *(const f32x4*)(wd + r * 512 + lane * 8), w1 = *(const f32x4*)(wd + r * 512 + lane * 8 + 4);
            z0 += w0 * lr; z1 += w1 * lr;
        }
        f32x4 g0, g1;
#pragma unroll
        for (int j = 0; j < 4; ++j) {
            g0[j] = (fminf(z0[j], 0.f) - __logf(1.0f + __expf(-fabsf(z0[j])))) * (1.0f / 16.0f);
            g1[j] = (fminf(z1[j], 0.f) - __logf(1.0f + __expf(-fabsf(z1[j])))) * (1.0f / 16.0f);
        }
        *(f32x4*)(p.g() + (size_t)tl * 512 + lane * 8) = g0;
        *(f32x4*)(p.g() + (size_t)tl * 512 + lane * 8 + 4) = g1;
    }
    __syncthreads();
}

namespace moba {
constexpr int D = 128;
constexpr float THR = 8.f;
constexpr bool WSKIP = false;
constexpr float SCALE = 0.08838834764831845f;
constexpr int NW = 8, QBLK = 32, KVBLK = 64, QB = NW * QBLK;
constexpr int SHM_V = KVBLK * D * 2, SHM_K = KVBLK * D * 2;
constexpr int LDS_ATTN = 2 * SHM_V + 2 * SHM_K + NW * 64 * 4;
typedef short bf16x8 __attribute__((ext_vector_type(8)));
typedef short s16x4 __attribute__((ext_vector_type(4)));
typedef float f32x16 __attribute__((ext_vector_type(16)));
template <class A, class Bt> struct same_t { static constexpr bool v = false; };
template <class A> struct same_t<A, A> { static constexpr bool v = true; };
#define KSWZ(row, colB) ((row) * 256 + ((colB) ^ (((row) & 7) << 4)))
#define SBAR() __builtin_amdgcn_sched_barrier(0)
__device__ __forceinline__ int v_st(int k, int c) { const int kk = (k & ~0xC) | ((k & 4) << 1) | ((k & 8) >> 1); return ((kk >> 3) * 4 + (c >> 5)) * 512 + ((kk & 7) * 32 + (c & 31)) * 2; }
__device__ __forceinline__ int v_rd_base(int lane) { return ((lane & 3) << 3) | (((lane >> 2) & 3) << 6) | (((lane >> 4) & 1) << 5) | (((lane >> 5) & 1) << 8); }
constexpr int v_rd_off(int d0, int ks, int half) { return d0 * 512 + ks * 4096 + half * 2048; }
__device__ __forceinline__ int crow(int r, int hi) { return (r & 3) + 8 * (r >> 2) + 4 * hi; }
__device__ __forceinline__ unsigned cvtpk(float lo, float hi) {
    unsigned r; asm volatile("v_cvt_pk_bf16_f32 %0, %1, %2" : "=v"(r) : "v"(lo), "v"(hi)); return r;
}
__device__ __forceinline__ bf16x8 pack8(f32x4 a, f32x4 b) {
    u32x4 w = {cvtpk(a[0], a[1]), cvtpk(a[2], a[3]), cvtpk(b[0], b[1]), cvtpk(b[2], b[3])};
    return *reinterpret_cast<bf16x8*>(&w);
}
template <class T> __device__ __forceinline__ bf16x8 load8(const T* p) {
    if constexpr (same_t<T, float>::v) { return pack8(*(const f32x4*)p, *(const f32x4*)(p + 4)); }
    else { return *reinterpret_cast<const bf16x8*>(p); }
}
__device__ __forceinline__ void mask_tile(f32x16& p0, f32x16& p1, int dq, unsigned W) {
    const float NEG = -__builtin_inff();
#pragma unroll
    for (int r = 0; r < 16; ++r) {
        const int c = (r & 3) + 8 * (r >> 2);
        if ((unsigned)(dq - c) >= W) p0[r] = NEG;
        if ((unsigned)(dq - c - 32) >= W) p1[r] = NEG;
    }
}
__device__ __forceinline__ void partialSM(f32x16& p0, f32x16& p1, float& m_reg, float& mn, float& alpha) {
    float pmax = p0[0]; for (int r = 1; r < 16; ++r) pmax = fmaxf(pmax, p0[r]); for (int r = 0; r < 16; ++r) pmax = fmaxf(pmax, p1[r]);
    { auto rr = __builtin_amdgcn_permlane32_swap(__float_as_uint(pmax), __float_as_uint(pmax), false, false);
      pmax = fmaxf(__uint_as_float(rr[0]), __uint_as_float(rr[1])); }
    constexpr float C2 = 1.4426950408889634f * SCALE;
    if (__builtin_expect(__all((pmax - m_reg) * SCALE <= THR), 1)) { mn = m_reg; alpha = 1.f; }
    else { mn = fmaxf(m_reg, pmax); alpha = __builtin_amdgcn_exp2f((m_reg - mn) * C2); m_reg = mn; }
    const float mnL = -mn * C2;
    for (int r = 0; r < 16; ++r) p0[r] = fmaf(p0[r], C2, mnL); for (int r = 0; r < 16; ++r) p1[r] = fmaf(p1[r], C2, mnL);
    for (int r = 0; r < 16; ++r) p0[r] = __builtin_amdgcn_exp2f(p0[r]);
}
__device__ __forceinline__ void finishSM(f32x16& p0, f32x16& p1, float alpha, float& l_reg, bf16x8& pa0, bf16x8& pa1, bf16x8& pa2, bf16x8& pa3) {
    for (int r = 0; r < 16; ++r) p1[r] = __builtin_amdgcn_exp2f(p1[r]);
    float ps = 0; for (int r = 0; r < 16; ++r) ps += p0[r]; for (int r = 0; r < 16; ++r) ps += p1[r];
    { auto rr = __builtin_amdgcn_permlane32_swap(__float_as_uint(ps), __float_as_uint(ps), false, false);
      ps = __uint_as_float(rr[0]) + __uint_as_float(rr[1]); }
    l_reg = l_reg * alpha + ps;
#define PK4(P, B_, OUT) do { unsigned a0 = cvtpk(P[B_+0], P[B_+1]), a1 = cvtpk(P[B_+2], P[B_+3]);                          \
        unsigned b0 = cvtpk(P[B_+4], P[B_+5]), b1 = cvtpk(P[B_+6], P[B_+7]);                                             \
        auto r0 = __builtin_amdgcn_permlane32_swap(a0, b0, false, false); auto r1 = __builtin_amdgcn_permlane32_swap(a1, b1, false, false); \
        u32x4 w = {r0[0], r1[0], r0[1], r1[1]}; OUT = *reinterpret_cast<bf16x8*>(&w); } while (0)
    PK4(p0, 0, pa0); PK4(p0, 8, pa1); PK4(p1, 0, pa2); PK4(p1, 8, pa3);
#undef PK4
}
template <int KB, bool SK>
__device__ __forceinline__ void qkt(f32x16& p0, f32x16& p1, const char* K_lds, int r32, int hi, const bf16x8* qr, bool act) {
    if (SK && !act) { const float NEG = -__builtin_inff();
#pragma unroll
        for (int r = 0; r < 16; ++r) { p0[r] = NEG; p1[r] = NEG; } return; }
    p0 = f32x16{}; p1 = f32x16{};
    const char* kb[4];
#pragma unroll
    for (int dd = 0; dd < 4; ++dd) kb[dd] = K_lds + KB * SHM_K + KSWZ(r32, (dd * 16 + hi * 8) * 2);
#pragma unroll
    for (int d0 = 0; d0 < 8; ++d0) { const char* a = kb[d0 & 3] + (d0 >> 2) * 128;
        bf16x8 b0 = *reinterpret_cast<const bf16x8*>(a);
        bf16x8 b1 = *reinterpret_cast<const bf16x8*>(a + 32 * 256);
        p0 = __builtin_amdgcn_mfma_f32_32x32x16_bf16(b0, qr[d0], p0, 0, 0, 0);
        p1 = __builtin_amdgcn_mfma_f32_32x32x16_bf16(b1, qr[d0], p1, 0, 0, 0); }
}
template <int VB, bool SK>
__device__ __forceinline__ void pv_tile(f32x16* o, int vb0, bf16x8 pa0, bf16x8 pa1, bf16x8 pa2, bf16x8 pa3, bool act) {
    if (SK && !act) return;
#define TRRD(dst, off) asm volatile("ds_read_b64_tr_b16 %0, %1 offset:%2" : "=&v"(dst) : "v"(vb0), "i"(off) : "memory")
#define PV_D0(d0) do { s16x4 l0, l1, l2, l3, h0, h1, h2, h3; constexpr int b_ = VB * SHM_V + v_rd_off(d0, 0, 0);     \
        TRRD(l0, b_); TRRD(h0, b_ + 2048); TRRD(l1, b_ + 4096); TRRD(h1, b_ + 6144); TRRD(l2, b_ + 8192); TRRD(h2, b_ + 10240); TRRD(l3, b_ + 12288); TRRD(h3, b_ + 14336); \
        asm volatile("s_waitcnt lgkmcnt(0)" ::: "memory"); SBAR();                 \
        o[d0] = __builtin_amdgcn_mfma_f32_32x32x16_bf16(pa0, (bf16x8){l0[0], l0[1], l0[2], l0[3], h0[0], h0[1], h0[2], h0[3]}, o[d0], 0, 0, 0);   \
        o[d0] = __builtin_amdgcn_mfma_f32_32x32x16_bf16(pa1, (bf16x8){l1[0], l1[1], l1[2], l1[3], h1[0], h1[1], h1[2], h1[3]}, o[d0], 0, 0, 0);   \
        o[d0] = __builtin_amdgcn_mfma_f32_32x32x16_bf16(pa2, (bf16x8){l2[0], l2[1], l2[2], l2[3], h2[0], h2[1], h2[2], h2[3]}, o[d0], 0, 0, 0);   \
        o[d0] = __builtin_amdgcn_mfma_f32_32x32x16_bf16(pa3, (bf16x8){l3[0], l3[1], l3[2], l3[3], h3[0], h3[1], h3[2], h3[3]}, o[d0], 0, 0, 0); } while (0)
    PV_D0(0); PV_D0(1); PV_D0(2); PV_D0(3);
#undef PV_D0
#undef TRRD
}

template <class TIn, class TOut> struct BlockRef { const TIn* Q; const TIn* K; const TIn* V; TOut* O; int P0; };
template <class TIn> struct Seam {
    bf16x8 qr[8];
    bf16x8 st_v0, st_v1, st_k0, st_k1; f32x4 sf0, sf1, sf2, sf3;
    f32x4 tq[16];
};
__device__ __forceinline__ int swa_jlo(int P0, int W) { const int lowk = P0 - W + 1; return lowk > 0 ? lowk / KVBLK : 0; }
#define ROW(p, k0, rr) ((p) + (size_t)((k0) + (rr)) * D + sc)
#define VMW() asm volatile("s_waitcnt vmcnt(0)" ::: "memory")
#define VMWN(n) asm volatile("s_waitcnt vmcnt(%0)" :: "i"(n) : "memory")
#define SLOAD_H(Kp, Vp, k0) do { S.st_v0 = load8<TIn>(ROW(Vp, k0, sr)); S.st_v1 = load8<TIn>(ROW(Vp, k0, 32 + sr));              \
                         S.st_k0 = load8<TIn>(ROW(Kp, k0, sr)); S.st_k1 = load8<TIn>(ROW(Kp, k0, 32 + sr)); } while (0)
#define SWRITE_HK(bf) do { *(bf16x8*)(K_lds + (bf) * SHM_K + kws) = S.st_k0; *(bf16x8*)(K_lds + (bf) * SHM_K + kws + 32 * 256) = S.st_k1; } while (0)
#define SWRITE_HV(bf) do { *(bf16x8*)(V_lds + (bf) * SHM_V + vst0) = S.st_v0; *(bf16x8*)(V_lds + (bf) * SHM_V + vst1) = S.st_v1; } while (0)
#define SWRITE_H(bf) do { SWRITE_HV(bf); SWRITE_HK(bf); } while (0)
#define SLOAD_F(p, k0) do { S.sf0 = *(const f32x4*)ROW(p, k0, sr); S.sf1 = *(const f32x4*)(ROW(p, k0, sr) + 4);                \
                            S.sf2 = *(const f32x4*)ROW(p, k0, 32 + sr); S.sf3 = *(const f32x4*)(ROW(p, k0, 32 + sr) + 4); } while (0)
#define SWRITE_KF(bf) do { *(bf16x8*)(K_lds + (bf) * SHM_K + kws) = pack8(S.sf0, S.sf1); *(bf16x8*)(K_lds + (bf) * SHM_K + kws + 32 * 256) = pack8(S.sf2, S.sf3); } while (0)
#define SWRITE_VF(bf) do { *(bf16x8*)(V_lds + (bf) * SHM_V + vst0) = pack8(S.sf0, S.sf1); *(bf16x8*)(V_lds + (bf) * SHM_V + vst1) = pack8(S.sf2, S.sf3); } while (0)
template <class TIn, class TOut>
__device__ __forceinline__ void causal_swa_prime(const BlockRef<TIn, TOut>& cur, int W, char* lds, Seam<TIn>& S, const int tid) {
    constexpr bool F32 = same_t<TIn, float>::v;
    const int wid = __builtin_amdgcn_readfirstlane(tid >> 6), lane = tid & 63, r32 = lane & 31, hi = lane >> 5;
    const int sr = tid >> 4, sc = (tid & 15) * 8, kws = KSWZ(sr, sc * 2); char* K_lds = lds + 2 * SHM_V;
    const int kb0 = swa_jlo(cur.P0, W) * KVBLK;
    for (int d0 = 0; d0 < 8; ++d0) S.qr[d0] = load8<TIn>(cur.Q + (size_t)(wid * QBLK + r32) * D + d0 * 16 + hi * 8);
    if constexpr (F32) { SLOAD_F((const float*)cur.K, kb0); VMW(); SWRITE_KF(0); SBAR(); SLOAD_F((const float*)cur.V, kb0); }
    else { SLOAD_H(cur.K, cur.V, kb0); VMW(); SWRITE_HK(0); }
    __syncthreads();
}
template <class TIn, class TOut>
__device__ __forceinline__ void causal_swa_block(const BlockRef<TIn, TOut>& cur, const BlockRef<TIn, TOut>& nxt, int skv, int W, char* lds, Seam<TIn>& S, const int tid, const unsigned selmask) {
    constexpr bool F32 = same_t<TIn, float>::v;
    const int wid = __builtin_amdgcn_readfirstlane(tid >> 6), lane = tid & 63, r32 = lane & 31, hi = lane >> 5;
    const int j_lo = swa_jlo(cur.P0, W);
    int j_hi = (cur.P0 + QB - 1) / KVBLK + 1; if (j_hi > skv / KVBLK) j_hi = skv / KVBLK;
    const int NT = j_hi - j_lo;
    const int kbn = swa_jlo(nxt.P0, W) * KVBLK;
    const int qlo = cur.P0 + wid * QBLK, qm = qlo + r32 - 4 * hi;
    char* V_lds = lds; char* K_lds = lds + 2 * SHM_V;
    float* ws = (float*)(lds + 2 * SHM_V + 2 * SHM_K) + wid * 64; float* li_l = ws, * al_l = ws + 32;
    float m_reg = -1e30f, l_reg = 0; f32x16 o[4] = {};
    const int sr = tid >> 4, sc = (tid & 15) * 8, vst0 = v_st(sr, sc), vst1 = v_st(32 + sr, sc), kws = KSWZ(sr, sc * 2);
    const int vb0 = (int)(uintptr_t)V_lds + v_rd_base(lane);
    const TIn* Kh = cur.K; const TIn* Vh = cur.V;
    const int qb = cur.P0 >> 8;
#define RESC(a) do { if (__any((a) < 1.f)) { if (hi == 0) al_l[r32] = (a); asm volatile("s_waitcnt lgkmcnt(0)" ::: "memory");              \
                     for (int d_ = 0; d_ < 4; ++d_) for (int r = 0; r < 16; ++r) o[d_][r] *= al_l[crow(r, hi)]; } } while (0)
#define KBASE(t) ((j_lo + (t)) * KVBLK)
#define ACT(t) (KBASE(t) <= qlo + QBLK - 1 && KBASE(t) + KVBLK - 1 >= qlo - W + 1)
#define MASKT(P0_, P1_, t) do { const int kb_ = KBASE(t); if (kb_ + KVBLK - 1 > qlo) mask_tile(P0_, P1_, qm - kb_, (unsigned)W);                  \
        else if (qb >= 4 && kb_ < cur.P0) { const bool keep_ = (selmask >> (kb_ >> 8)) & 1u; const float NEG_ = -__builtin_inff();          \
            _Pragma("unroll") for (int r_ = 0; r_ < 16; ++r_) { P0_[r_] = keep_ ? P0_[r_] : NEG_; P1_[r_] = keep_ ? P1_[r_] : NEG_; } } } while (0)
    constexpr int NQL = F32 ? 16 : 8;
    constexpr bool SK = WSKIP && !F32;
#define SEAM_K0() do { VMWN(NQL); if constexpr (F32) { SWRITE_KF(0); SBAR(); SLOAD_F((const float*)nxt.V, kbn); } else { SWRITE_HK(0); } SBAR(); } while (0)
    f32x16 pA0, pA1, pB0, pB1; float mnA, mnB, alA, alB; bf16x8 pa0, pa1, pa2, pa3;
    if constexpr (F32) { VMW(); SWRITE_VF(0); SBAR(); } else { SWRITE_HV(0); SBAR(); }
    if (NT > 1) { if constexpr (F32) SLOAD_F((const float*)Kh, KBASE(1)); else SLOAD_H(Kh, Vh, KBASE(1)); }
    SBAR(); qkt<0, SK>(pA0, pA1, K_lds, r32, hi, S.qr, ACT(0));
    if constexpr (F32) { if (NT > 1) { VMW(); SWRITE_KF(1); SBAR(); SLOAD_F((const float*)Vh, KBASE(1)); } }
    MASKT(pA0, pA1, 0); partialSM(pA0, pA1, m_reg, mnA, alA);
    if (NT > 1) { VMW(); if constexpr (F32) { SWRITE_VF(1); SBAR(); if (NT > 2) SLOAD_F((const float*)Kh, KBASE(2)); } else SWRITE_H(1); }
    __syncthreads();
#define HALF_STEP(PX0, PX1, mnX, alX, PY0, PY1, alY, t, KB, VB, SB) do {                                                      \
        SBAR(); qkt<KB, SK>(PX0, PX1, K_lds, r32, hi, S.qr, ACT(t));                                             \
        finishSM(PY0, PY1, alY, l_reg, pa0, pa1, pa2, pa3); SBAR();                                                           \
        if ((t) + 1 < NT) { if constexpr (F32) { VMW(); SWRITE_KF(SB); SBAR(); SLOAD_F((const float*)Vh, KBASE((t) + 1)); }  \
                            else { SLOAD_H(Kh, Vh, KBASE((t) + 1)); } SBAR(); }                                               \
        pv_tile<VB, SK>(o, vb0, pa0, pa1, pa2, pa3, ACT((t) - 1)); MASKT(PX0, PX1, (t)); partialSM(PX0, PX1, m_reg, mnX, alX);                                        \
        __syncthreads();                                                                                                      \
        if ((t) + 1 < NT) { VMW(); if constexpr (F32) { SWRITE_VF(SB); SBAR(); if ((t) + 2 < NT) SLOAD_F((const float*)Kh, KBASE((t) + 2)); } \
                            else { SWRITE_H(SB); } }                                                                          \
        RESC(alX); __syncthreads(); } while (0)
    for (int t = 1; t + 1 < NT; t += 2) {
        HALF_STEP(pB0, pB1, mnB, alB, pA0, pA1, alA, t, 1, 0, 0);
        HALF_STEP(pA0, pA1, mnA, alA, pB0, pB1, alB, t + 1, 0, 1, 1);
    }
    const bool even = (NT & 1) == 0;
    if (even) { SBAR(); qkt<1, SK>(pB0, pB1, K_lds, r32, hi, S.qr, ACT(NT - 1)); SBAR(); }
#define QROW(e) (nxt.Q + (size_t)(wid * QBLK + r32) * D + ((e) >> 1) * 16 + hi * 8 + ((e) & 1) * 4)
    if constexpr (F32) { SLOAD_F((const float*)nxt.K, kbn); SBAR();
#pragma unroll
        for (int e = 0; e < 8; ++e) S.tq[e] = *(const f32x4*)QROW(e); }
    else { SLOAD_H(nxt.K, nxt.V, kbn); SBAR();
#pragma unroll
        for (int d0 = 0; d0 < 8; ++d0) S.qr[d0] = load8<TIn>(nxt.Q + (size_t)(wid * QBLK + r32) * D + d0 * 16 + hi * 8); }
    SBAR();
    finishSM(pA0, pA1, alA, l_reg, pa0, pa1, pa2, pa3); SBAR();
    if constexpr (F32) {
#pragma unroll
        for (int e = 8; e < 16; ++e) S.tq[e] = *(const f32x4*)QROW(e); SBAR(); }
#undef QROW
    pv_tile<0, SK>(o, vb0, pa0, pa1, pa2, pa3, ACT(even ? NT - 2 : NT - 1));
    if (even) { MASKT(pB0, pB1, NT - 1); partialSM(pB0, pB1, m_reg, mnB, alB); __syncthreads(); RESC(alB);
        finishSM(pB0, pB1, alB, l_reg, pa0, pa1, pa2, pa3); SBAR(); pv_tile<1, SK>(o, vb0, pa0, pa1, pa2, pa3, ACT(NT - 1)); }
    SBAR(); SEAM_K0();
    if (hi == 0) li_l[r32] = l_reg; asm volatile("s_waitcnt lgkmcnt(0)" ::: "memory");
    float rli[16];
#pragma unroll
    for (int r = 0; r < 16; ++r) rli[r] = __builtin_amdgcn_rcpf(li_l[crow(r, hi)]);
    TOut* Ow = cur.O + (size_t)(wid * QBLK) * D;
#pragma unroll
    for (int r = 0; r < 16; ++r) { const int orow = crow(r, hi);
#pragma unroll
        for (int d0 = 0; d0 < 4; ++d0) { const float v = o[d0][r] * rli[r];
            if constexpr (same_t<TOut, float>::v) { Ow[(size_t)orow * D + d0 * 32 + r32] = v; }
            else { const float vn = __int_as_float(__builtin_amdgcn_update_dpp(0, __float_as_int(v), 0xB1, 0xf, 0xf, true));
                   if ((r32 & 1) == 0) *(unsigned*)(Ow + (size_t)orow * D + d0 * 32 + r32) = cvtpk(v, vn); } } }
    if constexpr (F32) {
#pragma unroll
        for (int d0 = 0; d0 < 8; ++d0) S.qr[d0] = pack8(S.tq[2 * d0], S.tq[2 * d0 + 1]); }
    __syncthreads();
#undef RESC
#undef KBASE
#undef ACT
#undef MASKT
#undef SEAM_K0
#undef HALF_STEP
}
#undef ROW
#undef VMW
#undef VMWN
#undef SLOAD_H
#undef SWRITE_HK
#undef SWRITE_HV
#undef SWRITE_H
#undef SLOAD_F
#undef SWRITE_KF
#undef SWRITE_VF


__device__ __forceinline__ unsigned moba_gate(const bf16x8 (&qr)[8], const float* kmean, int qb, int hi) {
    float v1 = -__builtin_inff(), v2 = v1, v3 = v1; int i1 = 0, i2 = 0, i3 = 0;
#pragma unroll 1
    for (int n = 0; n < qb; ++n) {
        const float* km = kmean + n * 128 + hi * 8;
        float g = 0.f;
#pragma unroll
        for (int d0 = 0; d0 < 8; ++d0) {
            const f32x4 k0 = *(const f32x4*)(km + d0 * 16), k1 = *(const f32x4*)(km + d0 * 16 + 4);
#pragma unroll
            for (int j = 0; j < 4; ++j) {
                g += __uint_as_float((unsigned)(unsigned short)qr[d0][j] << 16) * k0[j];
                g += __uint_as_float((unsigned)(unsigned short)qr[d0][4 + j] << 16) * k1[j];
            }
        }
        { auto rr = __builtin_amdgcn_permlane32_swap(__float_as_uint(g), __float_as_uint(g), false, false); g = __uint_as_float(rr[0]) + __uint_as_float(rr[1]); }
        if (g > v1) { v3 = v2; i3 = i2; v2 = v1; i2 = i1; v1 = g; i1 = n; }
        else if (g > v2) { v3 = v2; i3 = i2; v2 = g; i2 = n; }
        else if (g > v3) { v3 = g; i3 = n; }
    }
    return (1u << i1) | (1u << i2) | (1u << i3);
}
}

namespace gla {
using moba::bf16x8; using moba::s16x4; using moba::f32x16;
#define GLA_KSWZ(row, colB) ((row) * 256 + ((colB) ^ (((row) & 7) << 4)))
__device__ __forceinline__ float bfu(bf16_t h) { return __uint_as_float((unsigned)h << 16); }

__device__ __forceinline__ void pack_p(const f32x16& p0, const f32x16& p1, bf16x8& pa0, bf16x8& pa1, bf16x8& pa2, bf16x8& pa3) {
#define GLA_PK4(P, B_, OUT) do { unsigned a0 = moba::cvtpk(P[B_+0], P[B_+1]), a1 = moba::cvtpk(P[B_+2], P[B_+3]);                      \
        unsigned b0 = moba::cvtpk(P[B_+4], P[B_+5]), b1 = moba::cvtpk(P[B_+6], P[B_+7]);                                             \
        auto r0 = __builtin_amdgcn_permlane32_swap(a0, b0, false, false); auto r1 = __builtin_amdgcn_permlane32_swap(a1, b1, false, false); \
        u32x4 w = {r0[0], r1[0], r0[1], r1[1]}; OUT = *reinterpret_cast<bf16x8*>(&w); } while (0)
    GLA_PK4(p0, 0, pa0); GLA_PK4(p0, 8, pa1); GLA_PK4(p1, 0, pa2); GLA_PK4(p1, 8, pa3);
#undef GLA_PK4
}
__device__ __forceinline__ void pv_block(f32x16& o, int vb0  , bf16x8 pa0, bf16x8 pa1, bf16x8 pa2, bf16x8 pa3) {
#define GLA_TRRD(dst, off) asm volatile("ds_read_b64_tr_b16 %0, %1 offset:%2" : "=&v"(dst) : "v"(vb0), "i"(off) : "memory")
    s16x4 l0, l1, l2, l3, h0, h1, h2, h3; constexpr int b_ = 0;
    GLA_TRRD(l0, b_); GLA_TRRD(h0, b_ + 2048); GLA_TRRD(l1, b_ + 4096); GLA_TRRD(h1, b_ + 6144); GLA_TRRD(l2, b_ + 8192); GLA_TRRD(h2, b_ + 10240); GLA_TRRD(l3, b_ + 12288); GLA_TRRD(h3, b_ + 14336);
    asm volatile("s_waitcnt lgkmcnt(0)" ::: "memory"); __builtin_amdgcn_sched_barrier(0);
    o = __builtin_amdgcn_mfma_f32_32x32x16_bf16(pa0, (bf16x8){l0[0], l0[1], l0[2], l0[3], h0[0], h0[1], h0[2], h0[3]}, o, 0, 0, 0);
    o = __builtin_amdgcn_mfma_f32_32x32x16_bf16(pa1, (bf16x8){l1[0], l1[1], l1[2], l1[3], h1[0], h1[1], h1[2], h1[3]}, o, 0, 0, 0);
    o = __builtin_amdgcn_mfma_f32_32x32x16_bf16(pa2, (bf16x8){l2[0], l2[1], l2[2], l2[3], h2[0], h2[1], h2[2], h2[3]}, o, 0, 0, 0);
    o = __builtin_amdgcn_mfma_f32_32x32x16_bf16(pa3, (bf16x8){l3[0], l3[1], l3[2], l3[3], h3[0], h3[1], h3[2], h3[3]}, o, 0, 0, 0);
#undef GLA_TRRD
}
__device__ __forceinline__ void v_frags(int vb0, bf16x8 (&vf)[4]) {
#define GLA_TRRD(dst, off) asm volatile("ds_read_b64_tr_b16 %0, %1 offset:%2" : "=&v"(dst) : "v"(vb0), "i"(off) : "memory")
    s16x4 l0, l1, l2, l3, h0, h1, h2, h3; constexpr int b_ = 0;
    GLA_TRRD(l0, b_); GLA_TRRD(h0, b_ + 2048); GLA_TRRD(l1, b_ + 4096); GLA_TRRD(h1, b_ + 6144); GLA_TRRD(l2, b_ + 8192); GLA_TRRD(h2, b_ + 10240); GLA_TRRD(l3, b_ + 12288); GLA_TRRD(h3, b_ + 14336);
    asm volatile("s_waitcnt lgkmcnt(0)" ::: "memory"); __builtin_amdgcn_sched_barrier(0);
    vf[0] = (bf16x8){l0[0], l0[1], l0[2], l0[3], h0[0], h0[1], h0[2], h0[3]};
    vf[1] = (bf16x8){l1[0], l1[1], l1[2], l1[3], h1[0], h1[1], h1[2], h1[3]};
    vf[2] = (bf16x8){l2[0], l2[1], l2[2], l2[3], h2[0], h2[1], h2[2], h2[3]};
    vf[3] = (bf16x8){l3[0], l3[1], l3[2], l3[3], h3[0], h3[1], h3[2], h3[3]};
#undef GLA_TRRD
}
__device__ __forceinline__ void store_tile_bf16(const f32x16& o, bf16_t* dst, int ld, int r32, int hi) {
#pragma unroll
    for (int r = 0; r < 16; ++r) {
        const float v = o[r], vn = __int_as_float(__builtin_amdgcn_update_dpp(0, __float_as_int(v), 0xB1, 0xf, 0xf, true));
        if ((r32 & 1) == 0) *(unsigned*)(dst + (size_t)moba::crow(r, hi) * ld + r32) = moba::cvtpk(v, vn);
    }
}
template <int NT>
__device__ __forceinline__ void store_tiles_wide(const f32x16 (&o)[NT], bf16_t* dst, int ld, int lane, char* scr) {
    const int r32 = lane & 31, hi = lane >> 5;
#pragma unroll
    for (int i = 0; i < NT; ++i)
#pragma unroll
        for (int r = 0; r < 16; ++r) {
            const float v = o[i][r], vn = __int_as_float(__builtin_amdgcn_update_dpp(0, __float_as_int(v), 0xB1, 0xf, 0xf, true));
            if ((r32 & 1) == 0) *(unsigned*)(scr + moba::crow(r, hi) * (NT * 64) + i * 64 + r32 * 2) = moba::cvtpk(v, vn);
        }
    constexpr int LPR = NT * 4;
    constexpr int RPP = 64 / LPR;
#pragma unroll
    for (int ps = 0; ps < 32 / RPP; ++ps) {
        const int row = ps * RPP + lane / LPR, pc = lane % LPR;
        const u32x4 w = *(const u32x4*)(scr + row * (NT * 64) + pc * 16);
        *(u32x4*)(dst + (size_t)row * ld + pc * 8) = w;
    }
}
template <int NT>
__device__ __forceinline__ void tiles_to_scratch(const f32x16 (&o)[NT], int lane, char* scr) {
    const int r32 = lane & 31, hi = lane >> 5;
#pragma unroll
    for (int i = 0; i < NT; ++i)
#pragma unroll
        for (int r = 0; r < 16; ++r) {
            const float v = o[i][r], vn = __int_as_float(__builtin_amdgcn_update_dpp(0, __float_as_int(v), 0xB1, 0xf, 0xf, true));
            if ((r32 & 1) == 0) *(unsigned*)(scr + moba::crow(r, hi) * (NT * 64) + i * 64 + r32 * 2) = moba::cvtpk(v, vn);
        }
}
template <int NT>
__device__ __forceinline__ void scratch_to_global(bf16_t* dst, int ld, int lane, const char* scr) {
    constexpr int LPR = NT * 4, RPP = 64 / LPR;
#pragma unroll
    for (int ps = 0; ps < 32 / RPP; ++ps) {
        const int row = ps * RPP + lane / LPR, pc = lane % LPR;
        *(u32x4*)(dst + (size_t)row * ld + pc * 8) = *(const u32x4*)(scr + row * (NT * 64) + pc * 16);
    }
}
__device__ __forceinline__ void stage_v_load(const bf16_t* src, int ld, int t, bf16x8 (&r)[4]) {
    const int sr = t >> 4, sc = (t & 15) * 8;
    r[0] = *(const bf16x8*)(src + (size_t)sr * ld + sc); r[1] = *(const bf16x8*)(src + (size_t)(32 + sr) * ld + sc);
    r[2] = *(const bf16x8*)(src + (size_t)sr * ld + 128 + sc); r[3] = *(const bf16x8*)(src + (size_t)(32 + sr) * ld + 128 + sc);
}
__device__ __forceinline__ void stage_v_write(char* V_lds, int t, const bf16x8 (&r)[4]) {
    const int sr = t >> 4, sc = (t & 15) * 8;
    *(bf16x8*)(V_lds + moba::v_st(sr, sc)) = r[0]; *(bf16x8*)(V_lds + moba::v_st(32 + sr, sc)) = r[1];
    *(bf16x8*)(V_lds + moba::SHM_V + moba::v_st(sr, sc)) = r[2]; *(bf16x8*)(V_lds + moba::SHM_V + moba::v_st(32 + sr, sc)) = r[3];
}

__device__ __forceinline__ void g1_item(const Params& p, int item, char* lds, const int t) {
    const int c = item & 31, h = (item >> 5) & 3, sl = item >> 7;
    const size_t tl0 = (size_t)sl * SEQ + c * 64;
    char* Kt = lds; char* Qt = lds + 16384; char* V_lds = lds + 32768; float* segtot = (float*)(lds + 65536);
    float* graw = (float*)(lds + 67584); bf16_t* qraw = (bf16_t*)(lds + 100352); bf16_t* kraw = (bf16_t*)(lds + 116736);
    const int d = t & 127, seg = t >> 7;
    {
        bf16x8 vr[4];
        stage_v_load(p.va() + tl0 * 1024 + h * 256, 1024, t, vr);
        f32x4 gr[4]; bf16x8 qr2[2], kr2[2];
#pragma unroll
        for (int i = 0; i < 4; ++i) { const int ch = t + i * NTHREADS, row = ch >> 5, col = (ch & 31) * 4; gr[i] = *(const f32x4*)(p.g() + (tl0 + row) * 512 + h * 128 + col); }
#pragma unroll
        for (int i = 0; i < 2; ++i) { const int ch = t + i * NTHREADS, row = ch >> 4, col = (ch & 15) * 8;
            qr2[i] = *(const bf16x8*)(p.qa() + (tl0 + row) * 512 + h * 128 + col); kr2[i] = *(const bf16x8*)(p.ka() + (tl0 + row) * 512 + h * 128 + col); }
        stage_v_write(V_lds, t, vr);
#pragma unroll
        for (int i = 0; i < 4; ++i) { const int ch = t + i * NTHREADS; *(f32x4*)(graw + ch * 4) = gr[i]; }
#pragma unroll
        for (int i = 0; i < 2; ++i) { const int ch = t + i * NTHREADS; *(bf16x8*)(qraw + ch * 8) = qr2[i]; *(bf16x8*)(kraw + ch * 8) = kr2[i]; }
    }
    __syncthreads();
    float b[16];
#pragma unroll
    for (int i = 0; i < 16; ++i) b[i] = graw[(seg * 16 + i) * 128 + d];
#pragma unroll
    for (int i = 1; i < 16; ++i) b[i] += b[i - 1];
    segtot[seg * 128 + d] = b[15];
    __syncthreads();
    const float s0 = segtot[d], s1 = segtot[128 + d], s2 = segtot[256 + d], s3 = segtot[384 + d];
    const float prefix = (seg > 0 ? s0 : 0.f) + (seg > 1 ? s1 : 0.f) + (seg > 2 ? s2 : 0.f);
    const float ref = s0 + s1, blast = (s0 + s1) + (s2 + s3);
    const float er = __expf(-ref), el = __expf(blast);
    unsigned ksw[8];
#pragma unroll
    for (int i = 0; i < 16; ++i) {
        const int tt = seg * 16 + i;
        const float qv = bfu(qraw[tt * 128 + d]), kv = bfu(kraw[tt * 128 + d]);
        const float eb = __expf(b[i] + prefix);
        const float ebr = eb * er, inv = __builtin_amdgcn_rcpf(eb);
        const float qt = qv * ebr, kt = kv * __builtin_amdgcn_rcpf(ebr), qi = qv * eb, ks = kv * (el * inv);
        *(bf16_t*)(Qt + GLA_KSWZ(tt, d * 2)) = f2bf(qt);
        *(bf16_t*)(Kt + GLA_KSWZ(tt, d * 2)) = f2bf(kt);
        qraw[tt * 128 + d] = f2bf(qi);
        if (i & 1) ksw[i >> 1] |= (unsigned)f2bf(ks) << 16; else ksw[i >> 1] = f2bf(ks);
    }
    {
        bf16_t* dst = p.ka() + (tl0 + (d >> 1)) * 512 + h * 128 + (d & 1) * 64 + seg * 16;
        *(u32x4*)dst = (u32x4){ksw[0], ksw[1], ksw[2], ksw[3]};
        *(u32x4*)(dst + 8) = (u32x4){ksw[4], ksw[5], ksw[6], ksw[7]};
    }
    if (seg == 0) p.dl()[((size_t)(sl * 32 + c) * 4 + h) * 128 + d] = el;
    __syncthreads();
#pragma unroll
    for (int i = 0; i < 2; ++i) { const int ch = t + i * NTHREADS, row = ch >> 4, col = (ch & 15) * 8;
        *(bf16x8*)(p.qa() + (tl0 + row) * 512 + h * 128 + col) = *(const bf16x8*)(qraw + ch * 8); }
    const int wave = __builtin_amdgcn_readfirstlane(t >> 6), lane = t & 63, r32 = lane & 31, hi = lane >> 5, tt = wave & 1, vg = wave >> 1;
    bf16x8 qr[8];
#pragma unroll
    for (int d0 = 0; d0 < 8; ++d0) qr[d0] = *(const bf16x8*)(Qt + GLA_KSWZ(32 * tt + r32, (d0 * 16 + hi * 8) * 2));
    f32x16 p0, p1;
    moba::qkt<0, false>(p0, p1, Kt, r32, hi, qr, true);
    const int trow = 32 * tt + r32;
#pragma unroll
    for (int r = 0; r < 16; ++r) { const int s = moba::crow(r, hi); p0[r] = (s <= trow) ? p0[r] : 0.f; p1[r] = (s + 32 <= trow) ? p1[r] : 0.f; }
    bf16x8 pa0, pa1, pa2, pa3;
    pack_p(p0, p1, pa0, pa1, pa2, pa3);
    const int vb0 = (int)(uintptr_t)V_lds + moba::v_rd_base(lane);
    f32x16 oA = f32x16{}, oB = f32x16{};
    {
        const int vbw = vb0 + (vg >> 1) * moba::SHM_V + (vg & 1) * 1024;
        pv_block(oA, vbw, pa0, pa1, pa2, pa3);
        pv_block(oB, vbw + 512, pa0, pa1, pa2, pa3);
    }
    bf16_t* od = p.oi() + (tl0 + 32 * tt) * 1024 + h * 256 + vg * 64;
    {
        const f32x16 o2[2] = {oA, oB};
        store_tiles_wide<2>(o2, od, 1024, lane, lds + 67584 + wave * 4096);
    }
    __syncthreads();
}

struct G2Stage { bf16x8 q[2], k[2], v[4]; float dl; };
__device__ __forceinline__ void g2_load(const Params& p, size_t tl0, size_t slc, int h, int t, G2Stage& s) {
    { const int tr = t >> 3, dq = (t & 7) * 16; const bf16_t* src = p.qa() + (tl0 + tr) * 512 + h * 128 + dq; s.q[0] = *(const bf16x8*)src; s.q[1] = *(const bf16x8*)(src + 8); }
    { const int dr = t >> 2, tq = (t & 3) * 16; const bf16_t* src = p.ka() + (tl0 + (dr >> 1)) * 512 + h * 128 + (dr & 1) * 64 + tq; s.k[0] = *(const bf16x8*)src; s.k[1] = *(const bf16x8*)(src + 8); }
    stage_v_load(p.va() + tl0 * 1024 + h * 256, 1024, t, s.v);
    s.dl = (t < 128) ? p.dl()[(slc * 4 + h) * 128 + t] : 0.f;
}
__device__ __forceinline__ void g2_write(char* lds, int t, const G2Stage& s) {
    { const int tr = t >> 3, c8 = (t & 7) * 4, x = tr & 31;
#pragma unroll
      for (int i = 0; i < 2; ++i) { const s16x4 lo = {s.q[i][0], s.q[i][1], s.q[i][2], s.q[i][3]}, hi4 = {s.q[i][4], s.q[i][5], s.q[i][6], s.q[i][7]};
          *(s16x4*)(lds + tr * 256 + (((c8 + 2 * i) ^ x) << 3)) = lo; *(s16x4*)(lds + tr * 256 + (((c8 + 2 * i + 1) ^ x) << 3)) = hi4; } }
    { const int dr = t >> 2, ch = (t & 3) * 2;
#pragma unroll
      for (int i = 0; i < 2; ++i) *(bf16x8*)(lds + 16384 + dr * 128 + (((ch + i) ^ (dr & 7)) << 4)) = s.k[i]; }
    stage_v_write(lds + 32768, t, s.v);
    if (t < 128) ((float*)(lds + 65536))[t] = s.dl;
}
__device__ __forceinline__ void g2_update(f32x16 (&S)[4], const char* lds, int vb0, int r32, int hi) {
    bf16x8 vf[4];
    v_frags(vb0, vf);
#pragma unroll
    for (int dt = 0; dt < 4; ++dt) {
        const int dr = 32 * dt + r32;
#pragma unroll
        for (int kk = 0; kk < 4; ++kk) {
            const bf16x8 a = *(const bf16x8*)(lds + 16384 + dr * 128 + (((2 * kk + hi) ^ (dr & 7)) << 4));
            S[dt] = __builtin_amdgcn_mfma_f32_32x32x16_bf16(a, vf[kk], S[dt], 0, 0, 0);
        }
    }
}
template <int G2V = 0>
__device__ __forceinline__ void g2_item(const Params& p, int item, char* lds, const int t) {
    const int h = item & 3, sl = item >> 2;
    const int wave = __builtin_amdgcn_readfirstlane(t >> 6), lane = t & 63, r32 = lane & 31, hi = lane >> 5;
    const int vb0 = (int)(uintptr_t)(lds + 32768) + moba::v_rd_base(lane);
    f32x16 S[4];
#pragma unroll
    for (int dt = 0; dt < 4; ++dt) S[dt] = f32x16{};
    G2Stage st;
    g2_load(p, (size_t)sl * SEQ, (size_t)sl * 32, h, t, st);
#pragma unroll 1
    for (int c = 0; c < 32; ++c) {
        const size_t tl0 = (size_t)sl * SEQ + c * 64;
        __syncthreads();
        g2_write(lds, t, st);
        __syncthreads();
        if (G2V == 0 && c > 0) {
            bf16_t* od = p.oe() + (tl0 - 64) * 1024 + h * 256 + wave * 32;
            scratch_to_global<1>(od, 1024, lane, lds + 69632 + wave * 4096);
            scratch_to_global<1>(od + 32 * 1024, 1024, lane, lds + 69632 + wave * 4096 + 2048);
        }
        if (c + 1 < 32) g2_load(p, tl0 + 64, (size_t)sl * 32 + c + 1, h, t, st);
#pragma unroll
        for (int tt = 0; tt < ((G2V == 3 || G2V == 4) ? 0 : 2); ++tt) {
            f32x16 o = f32x16{};
            const char* rowp = lds + (32 * tt + r32) * 256;
#pragma unroll
            for (int dt = 0; dt < 4; ++dt) {
#pragma unroll
                for (int s = 0; s < 2; ++s) {
                    u32x4 w = {moba::cvtpk(S[dt][8 * s], S[dt][8 * s + 1]), moba::cvtpk(S[dt][8 * s + 2], S[dt][8 * s + 3]), moba::cvtpk(S[dt][8 * s + 4], S[dt][8 * s + 5]), moba::cvtpk(S[dt][8 * s + 6], S[dt][8 * s + 7])};
                    const bf16x8 sf = *reinterpret_cast<bf16x8*>(&w);
                    const int c8 = 8 * dt + 4 * s + hi;
                    const s16x4 lo = *(const s16x4*)(rowp + ((c8 ^ r32) << 3)), hi4 = *(const s16x4*)(rowp + (((c8 + 2) ^ r32) << 3));
                    const bf16x8 a = {lo[0], lo[1], lo[2], lo[3], hi4[0], hi4[1], hi4[2], hi4[3]};
                    o = __builtin_amdgcn_mfma_f32_32x32x16_bf16(a, sf, o, 0, 0, 0);
                }
            }
            if (G2V == 0) { const f32x16 o1[1] = {o}; tiles_to_scratch<1>(o1, lane, lds + 69632 + wave * 4096 + tt * 2048); }
            else asm volatile("" :: "v"(o[0]), "v"(o[5]), "v"(o[10]), "v"(o[15]));
        }
        const float* dlp = (const float*)(lds + 65536);
#pragma unroll
        for (int dt = 0; dt < 4; ++dt)
#pragma unroll
            for (int rq = 0; rq < 4; ++rq) {
                const f32x4 dv = *(const f32x4*)(dlp + 32 * dt + 8 * rq + 4 * hi);
#pragma unroll
                for (int j = 0; j < 4; ++j) S[dt][4 * rq + j] *= dv[j];
            }
        if (G2V != 2 && G2V != 4) g2_update(S, lds, vb0 + (wave >> 2) * moba::SHM_V + (wave & 3) * 512, r32, hi);
    }
    if (G2V != 0) asm volatile("" :: "v"(S[0][0]), "v"(S[1][3]), "v"(S[2][7]), "v"(S[3][15]));
    if (G2V == 0) {
        bf16_t* od = p.oe() + ((size_t)sl * SEQ + 31 * 64) * 1024 + h * 256 + wave * 32;
        scratch_to_global<1>(od, 1024, lane, lds + 69632 + wave * 4096);
        scratch_to_global<1>(od + 32 * 1024, 1024, lane, lds + 69632 + wave * 4096 + 2048);
    }
    __syncthreads();
}
}

__device__ __forceinline__ moba::BlockRef<bf16_t, bf16_t> moba_ref(const Params& p, int L) {
    const int sh = L & 63, qb = 7 - (L >> 6);
    moba::BlockRef<bf16_t, bf16_t> r;
    bf16_t* Qh = p.qb() + (size_t)sh * SEQ * 128;
    r.Q = Qh + (size_t)qb * 256 * 128; r.O = Qh + (size_t)qb * 256 * 128;
    r.K = p.kb() + (size_t)sh * SEQ * 128; r.V = p.vb() + (size_t)sh * SEQ * 128; r.P0 = qb * 256;
    return r;
}
__device__ __forceinline__ int moba_dequeue(unsigned* ctr, volatile unsigned* lds_word, const int t) {
    __syncthreads();
    if (t == 0) *lds_word = atomicAdd(ctr, 1u);
    __syncthreads();
    return __builtin_amdgcn_readfirstlane((int)*lds_word);
}
__device__ __forceinline__ void phase_moba_mfma(const Params& p, int chunk, unsigned char* lds_raw, const int t) {
    using BR = moba::BlockRef<bf16_t, bf16_t>;
    const int total = CHUNK_SEQS * 8 * 8, W = 0x7fffffff;
    unsigned* ctr = p.qctr() + 40 + chunk;
    volatile unsigned* lw = (volatile unsigned*)(lds_raw + 69632);
    int L = moba_dequeue(ctr, lw, t);
    if (L >= total) return;
    BR cur = moba_ref(p, L);
    moba::Seam<bf16_t> S;
    moba::causal_swa_prime<bf16_t, bf16_t>(cur, W, (char*)lds_raw, S, t);
    for (;;) {
        const int Ln = moba_dequeue(ctr, lw, t);
        const bool last = Ln >= total;
        const BR nxt = last ? cur : moba_ref(p, Ln);
        unsigned selmask = 0xffu;
        if (cur.P0 >= 1024) selmask = moba::moba_gate(S.qr, p.kmean() + (size_t)(L & 63) * 8 * 128, cur.P0 >> 8, (t >> 5) & 1);
        moba::causal_swa_block<bf16_t, bf16_t>(cur, nxt, SEQ, W, (char*)lds_raw, S, t, selmask);
        if (last) break;
        cur = nxt; L = Ln;
    }
}

__device__ __forceinline__ void unpack8(const u32x4 w, float (&f)[8]) {
#pragma unroll
    for (int j = 0; j < 4; ++j) { f[2 * j] = __uint_as_float(w[j] << 16); f[2 * j + 1] = __uint_as_float(w[j] & 0xffff0000u); }
}
struct MergeRaw { u32x4 oi[2], oe[2], ra[2], ga[2], gb[2], ob[2]; };
__device__ __forceinline__ void merge_load(const Params& p, int tl, int lane, MergeRaw& m) {
    const size_t ro = (size_t)tl * 1024 + lane * 16;
    const int s = tl >> 11, pos = tl & (SEQ - 1);
    const bf16_t* obp = p.qb() + ((size_t)(s * 8 + (lane >> 3)) * SEQ + pos) * 128 + (lane & 7) * 16;
#pragma unroll
    for (int hf = 0; hf < 2; ++hf) {
        m.oi[hf] = *(const u32x4*)(p.oi() + ro + hf * 8); m.oe[hf] = *(const u32x4*)(p.oe() + ro + hf * 8); m.ra[hf] = *(const u32x4*)(p.ra() + ro + hf * 8);
        m.ga[hf] = *(const u32x4*)(p.ga() + ro + hf * 8); m.gb[hf] = *(const u32x4*)(p.gb() + ro + hf * 8); m.ob[hf] = *(const u32x4*)(obp + hf * 8);
    }
}
__device__ __forceinline__ void merge_compute(const Params& p, int chunk, int tl, int lane, const MergeRaw& m, const float (&ng)[16]) {
    float o[16], tmp[8], t2[8];
#pragma unroll
    for (int hf = 0; hf < 2; ++hf) {
        unpack8(m.oi[hf], tmp); unpack8(m.oe[hf], t2);
#pragma unroll
        for (int j = 0; j < 8; ++j) o[hf * 8 + j] = tmp[j] + t2[j];
    }
    float ss = 0.f;
#pragma unroll
    for (int j = 0; j < 16; ++j) ss += o[j] * o[j];
    ss += __int_as_float(__builtin_amdgcn_update_dpp(0, __float_as_int(ss), 0xB1, 0xf, 0xf, true));
    ss += __int_as_float(__builtin_amdgcn_update_dpp(0, __float_as_int(ss), 0x4E, 0xf, 0xf, true));
    ss += __int_as_float(__builtin_amdgcn_update_dpp(0, __float_as_int(ss), 0x141, 0xf, 0xf, true));
    ss += __int_as_float(__builtin_amdgcn_update_dpp(0, __float_as_int(ss), 0x140, 0xf, 0xf, true));
    const float rs = rsqrtf(ss * (1.0f / 256.0f) + 1e-6f);
    unsigned w[8];
#pragma unroll
    for (int hf = 0; hf < 2; ++hf) {
        float r[8], ga[8], gb[8], ob[8];
        unpack8(m.ra[hf], r); unpack8(m.ga[hf], ga); unpack8(m.gb[hf], gb); unpack8(m.ob[hf], ob);
#pragma unroll
        for (int j = 0; j < 4; ++j) {
            const int e = hf * 8 + 2 * j;
            const float y0 = o[e] * rs * ng[e] * r[2 * j] * ga[2 * j] + ob[2 * j] * gb[2 * j];
            const float y1 = o[e + 1] * rs * ng[e + 1] * r[2 * j + 1] * ga[2 * j + 1] + ob[2 * j + 1] * gb[2 * j + 1];
            w[hf * 4 + j] = pack_bf16(y0, y1);
        }
    }
    bf16_t* yp = p.y() + ((size_t)chunk * CT + tl) * 1024 + lane * 16;
    *(u32x4*)yp = (u32x4){w[0], w[1], w[2], w[3]};
    *(u32x4*)(yp + 8) = (u32x4){w[4], w[5], w[6], w[7]};
}
__device__ __forceinline__ void phase_merge(const Params& p, int chunk, const int t) {
    const int wave = t >> 6, lane = t & 63;
    float ng[16];
#pragma unroll
    for (int j = 0; j < 16; ++j) ng[j] = p.gla_ng[(lane & 15) * 16 + j];
    const int stride = gridDim.x * 8;
    int tl = blockIdx.x * 8 + wave;
    MergeRaw a, b;
    if (tl < CT) merge_load(p, tl, lane, a);
#pragma unroll 1
    for (; tl < CT; tl += 2 * stride) {
        const bool hb = tl + stride < CT;
        if (hb) merge_load(p, tl + stride, lane, b);
        merge_compute(p, chunk, tl, lane, a, ng);
        if (tl + 2 * stride < CT) merge_load(p, tl + 2 * stride, lane, a);
        if (hb) merge_compute(p, chunk, tl + stride, lane, b, ng);
    }
}

__device__ __forceinline__ void phase_ln1(const Params& p, const int t) {
    const int wave = t >> 6, lane = t & 63;
    f32x4 g[4], be[4];
#pragma unroll
    for (int j = 0; j < 4; ++j) { g[j] = *(const f32x4*)(p.ln1_g + j * 256 + lane * 4); be[j] = *(const f32x4*)(p.ln1_b + j * 256 + lane * 4); }
    const int stride = gridDim.x * 8;
    f32x4 vn[4];
#pragma unroll
    for (int j = 0; j < 4; ++j) vn[j] = *(const f32x4*)(p.x1() + (size_t)(blockIdx.x * 8 + wave) * 1024 + j * 256 + lane * 4);
#pragma unroll 1
    for (int n = blockIdx.x * 8 + wave; n < NTOK; n += stride) {
        f32x4 v[4];
        float sum = 0.f;
#pragma unroll
        for (int j = 0; j < 4; ++j) { v[j] = vn[j]; sum += (v[j][0] + v[j][1]) + (v[j][2] + v[j][3]); }
        { const int nn = (n + stride < NTOK) ? n + stride : n;
#pragma unroll
          for (int j = 0; j < 4; ++j) vn[j] = *(const f32x4*)(p.x1() + (size_t)nn * 1024 + j * 256 + lane * 4); }
        const float mu = wave_sum(sum) * (1.0f / 1024.0f);
        float sq = 0.f;
#pragma unroll
        for (int j = 0; j < 4; ++j) { const f32x4 d = v[j] - mu; sq += (d[0] * d[0] + d[1] * d[1]) + (d[2] * d[2] + d[3] * d[3]); }
        const float rs = rsqrtf(wave_sum(sq) * (1.0f / 1024.0f) + 1e-5f);
#pragma unroll
        for (int j = 0; j < 4; ++j) {
            const f32x4 o = (v[j] - mu) * rs * g[j] + be[j];
            uint2 w; w.x = pack_bf16(o[0], o[1]); w.y = pack_bf16(o[2], o[3]);
            *(uint2*)(p.x1b() + (size_t)n * 1024 + j * 256 + lane * 4) = w;
        }
    }
}

__device__ __forceinline__ unsigned xcc_id() { return (unsigned)__builtin_amdgcn_s_getreg((3 << 11) | 20) & 0x7u; }
template <int CTRL> __device__ __forceinline__ float dpp_add(float v) {
    return v + __int_as_float(__builtin_amdgcn_update_dpp(0, __float_as_int(v), CTRL, 0xf, 0xf, true));
}
typedef __bf16 bf16x2_t __attribute__((ext_vector_type(2)));
__device__ __forceinline__ float dot2bf(unsigned a, unsigned b, float acc) {
    return __builtin_amdgcn_fdot2_f32_bf16(__builtin_bit_cast(bf16x2_t, a), __builtin_bit_cast(bf16x2_t, b), acc, false);
}
#define PEER_NS 8
#define PEER_TILE 64
#define PEER_NT (NTOK / PEER_TILE)

template <class F> __device__ __forceinline__ void peer_sliced(unsigned* qctr, unsigned* lds_word, const int t, F&& f) {
    const int xcc = (int)xcc_id();
#pragma unroll 1
    for (int j = 0; j < PEER_NS; ++j) {
        const int s = (xcc + j) & (PEER_NS - 1);
#pragma unroll 1
        for (;;) {
            __syncthreads();
            if (t == 0) *lds_word = atomicAdd(qctr + s, 1u);
            __syncthreads();
            const unsigned tile = *lds_word;
            if (tile >= PEER_NT) break;
            f(s, (int)tile);
        }
    }
}

typedef float f32x2 __attribute__((ext_vector_type(2)));
typedef int i32x8 __attribute__((ext_vector_type(8)));
typedef short s16x2 __attribute__((ext_vector_type(2)));
__device__ __forceinline__ void peer_u_item(const Params& p, int s, int tile, const int t) {
    const int wave = __builtin_amdgcn_readfirstlane(t >> 6), lane = t & 63, r = lane & 3, qa = lane >> 2;
    const int n0 = tile * PEER_TILE + wave * 8;
    const unsigned char* ub = p.u8() + s * 128 + r * 16;
    const float dw0 = (r == 0) ? 0.03125f : 0.f, dw1 = (r == 1) ? 0.03125f : 0.f, dw2 = (r == 2) ? 0.03125f : 0.f, dw3 = (r == 3) ? 0.03125f : 0.f;
    const bool bon = (lane >> 4) == ((lane >> 2) & 3);
    const int qc = 4 * (qa & 3) + (qa >> 2);
    const int* ep = p.sel_e() + (size_t)n0 * 128 + qa * 8;
    const bf16_t* xo = p.x1b() + (size_t)n0 * 1024 + s * 128 + r * 16;
    u32x4 A0[8][2], A1[8][2], XA[4], XB[4];
    u32x4 ia0, ia1, ib0, ib1;
#define PU_IDS(d0, d1, tt) do { d0 = *(const u32x4*)(ep + (tt) * 128); d1 = *(const u32x4*)(ep + (tt) * 128 + 4); } while (0)
#define PU_LOAD(A, d0, d1) do { _Pragma("unroll") for (int m = 0; m < 8; ++m) { const unsigned id = (m < 4) ? d0[m & 3] : d1[m & 3]; const unsigned char* rp = ub + (size_t)id * 1024; \
        A[m][0] = *(const u32x4*)rp; A[m][1] = *(const u32x4*)(rp + 64); } } while (0)
#define PU_XLOAD(X, tt) do { const bf16_t* xp = xo + (size_t)(tt) * 1024; X[0] = *(const u32x4*)xp; X[1] = *(const u32x4*)(xp + 8); X[2] = *(const u32x4*)(xp + 64); X[3] = *(const u32x4*)(xp + 72); } while (0)
#define PU_TOKEN(A, X, tt) do { i32x8 bm; _Pragma("unroll") for (int i = 0; i < 8; ++i) { const unsigned x0 = X[i >> 1][(i & 1) * 2], x1 = X[i >> 1][(i & 1) * 2 + 1]; int w = 0; \
            w = __builtin_amdgcn_cvt_pk_fp8_f32(__uint_as_float(x0 << 16), __uint_as_float(x0 & 0xffff0000u), w, false); \
            w = __builtin_amdgcn_cvt_pk_fp8_f32(__uint_as_float(x1 << 16), __uint_as_float(x1 & 0xffff0000u), w, true); \
            bm[i] = bon ? w : 0; } \
        float dsum[8]; \
        _Pragma("unroll") for (int m = 0; m < 8; ++m) { const i32x8 a = {(int)A[m][0][0], (int)A[m][0][1], (int)A[m][0][2], (int)A[m][0][3], (int)A[m][1][0], (int)A[m][1][1], (int)A[m][1][2], (int)A[m][1][3]}; \
            const f32x4 c = __builtin_amdgcn_mfma_scale_f32_16x16x128_f8f6f4(a, bm, (f32x4){0.f, 0.f, 0.f, 0.f}, 0, 0, 0, 0, 0, 0); \
            float d = (c[0] * dw0 + c[1] * dw1) + (c[2] * dw2 + c[3] * dw3); \
            d = dpp_add<0xB1>(d); dsum[m] = dpp_add<0x4E>(d); } \
        if (r == 0) *(u32x4*)(p.part() + ((size_t)s * NTOK + n0 + (tt)) * 128 + qc * 8) = (u32x4){pack_bf16(dsum[0], dsum[1]), pack_bf16(dsum[2], dsum[3]), pack_bf16(dsum[4], dsum[5]), pack_bf16(dsum[6], dsum[7])}; \
    } while (0)
    PU_IDS(ia0, ia1, 0);
    PU_IDS(ib0, ib1, 1);
    PU_XLOAD(XA, 0);
    PU_LOAD(A0, ia0, ia1);
#pragma unroll
    for (int tt = 0; tt < 8; tt += 2) {
        if (tt + 2 < 8) PU_IDS(ia0, ia1, tt + 2);
        PU_XLOAD(XB, tt + 1);
        __builtin_amdgcn_sched_barrier(0);
        PU_LOAD(A1, ib0, ib1);
        __builtin_amdgcn_sched_barrier(0);
        PU_TOKEN(A0, XA, tt);
        __builtin_amdgcn_sched_barrier(0);
        if (tt + 3 < 8) PU_IDS(ib0, ib1, tt + 3);
        if (tt + 2 < 8) PU_XLOAD(XA, tt + 2);
        __builtin_amdgcn_sched_barrier(0);
        if (tt + 2 < 8) PU_LOAD(A0, ia0, ia1);
        __builtin_amdgcn_sched_barrier(0);
        PU_TOKEN(A1, XB, tt + 1);
        __builtin_amdgcn_sched_barrier(0);
    }
#undef PU_IDS
#undef PU_LOAD
#undef PU_XLOAD
#undef PU_TOKEN
}
__device__ __forceinline__ void peer_reduce(const Params& p, const int t) {
#pragma unroll 1
    for (size_t i = (size_t)blockIdx.x * NTHREADS + t; i < (size_t)NTOK * 128; i += (size_t)gridDim.x * NTHREADS) {
        float d = 0.f;
#pragma unroll
        for (int s = 0; s < PEER_NS; ++s) d += bf2f(p.part()[(size_t)s * NTOK * 128 + i]);
        const float w = p.sel_g()[i] * 0.5f * d * (1.0f + erff(d * 0.7071067811865476f));
        p.sel_g()[i] = 0.5f * w;
    }
}
__device__ __forceinline__ void peer_v_item(const Params& p, int s, int tile, const int t) {
    const int wave = t >> 6, lane = t & 63, grp = lane >> 3, c8 = lane & 7;
    const unsigned char* vt = p.v8() + s * 128 + c8 * 16;
#pragma unroll 1
    for (int tt = 0; tt < 8; ++tt) {
        const int n = tile * PEER_TILE + wave * 8 + tt;
        const int* ep = p.sel_e() + (size_t)n * 128 + grp * 16;
        const float* wp = p.sel_g() + (size_t)n * 128 + grp * 16;
        u32x4 id4[4]; f32x4 w4[4];
#pragma unroll
        for (int q = 0; q < 4; ++q) { id4[q] = *(const u32x4*)(ep + q * 4); w4[q] = *(const f32x4*)(wp + q * 4); }
        f32x2 acc[8];
#pragma unroll
        for (int j = 0; j < 8; ++j) acc[j] = (f32x2){0.f, 0.f};
#pragma unroll
        for (int i = 0; i < 16; ++i) {
            const unsigned id = id4[i >> 2][i & 3];
            const float w = w4[i >> 2][i & 3];
            const f32x2 w2 = {w, w};
            const u32x4 vv = *(const u32x4*)(vt + (size_t)id * 1024);
#pragma unroll
            for (int j = 0; j < 4; ++j) {
                acc[2 * j] = __builtin_elementwise_fma(__builtin_amdgcn_cvt_pk_f32_fp8((int)vv[j], false), w2, acc[2 * j]);
                acc[2 * j + 1] = __builtin_elementwise_fma(__builtin_amdgcn_cvt_pk_f32_fp8((int)vv[j], true), w2, acc[2 * j + 1]);
            }
        }
        float o[16];
#pragma unroll
        for (int j = 0; j < 8; ++j) { o[2 * j] = acc[j].x; o[2 * j + 1] = acc[j].y; }
        float s8[8];
#pragma unroll
        for (int j = 0; j < 8; ++j) {
            const auto rr = __builtin_amdgcn_permlane32_swap(__float_as_uint(o[j]), __float_as_uint(o[j + 8]), false, false);
            s8[j] = __uint_as_float(rr[0]) + __uint_as_float(rr[1]);
        }
        const bool b4 = (lane & 16) != 0, b3 = (lane & 8) != 0;
        float s4[4];
#pragma unroll
        for (int j = 0; j < 4; ++j) {
            const float send = b3 ? s8[j] : s8[j + 4], keep = b3 ? s8[j + 4] : s8[j];
            s4[j] = keep + __int_as_float(__builtin_amdgcn_update_dpp(0, __float_as_int(send), 0x128, 0xf, 0xf, true));
        }
        float s2[2];
#pragma unroll
        for (int j = 0; j < 2; ++j) {
            const float send = b4 ? s4[j] : s4[j + 2], keep = b4 ? s4[j + 2] : s4[j];
            s2[j] = keep + __shfl_xor(send, 16, 64);
        }
        {
            const int col = c8 * 16 + ((lane >> 5) & 1) * 8 + ((lane >> 3) & 1) * 4 + ((lane >> 4) & 1) * 2;
            *(unsigned*)(p.h2() + (size_t)n * 1024 + s * 128 + col) = pack_bf16(s2[0], s2[1]);
        }
    }
}
__device__ __forceinline__ void peer_ln2(const Params& p, const int t) {
    const int wave = t >> 6, lane = t & 63;
    f32x4 g[4], be[4];
#pragma unroll
    for (int j = 0; j < 4; ++j) { const int c = (j >> 1) * 512 + lane * 8 + (j & 1) * 4; g[j] = *(const f32x4*)(p.ln2_g + c); be[j] = *(const f32x4*)(p.ln2_b + c); }
    const int stride = gridDim.x * 8;
    u32x4 awn[2], bwn[2];
#pragma unroll
    for (int hf = 0; hf < 2; ++hf) { awn[hf] = *(const u32x4*)(p.x1b() + (size_t)(blockIdx.x * 8 + wave) * 1024 + hf * 512 + lane * 8); bwn[hf] = *(const u32x4*)(p.h2() + (size_t)(blockIdx.x * 8 + wave) * 1024 + hf * 512 + lane * 8); }
#pragma unroll 1
    for (int n = blockIdx.x * 8 + wave; n < NTOK; n += stride) {
        f32x4 v[4];
        float sum = 0.f;
        const u32x4 awc[2] = {awn[0], awn[1]}, bwc[2] = {bwn[0], bwn[1]};
        { const int nn = (n + stride < NTOK) ? n + stride : n;
#pragma unroll
          for (int hf = 0; hf < 2; ++hf) { awn[hf] = *(const u32x4*)(p.x1b() + (size_t)nn * 1024 + hf * 512 + lane * 8); bwn[hf] = *(const u32x4*)(p.h2() + (size_t)nn * 1024 + hf * 512 + lane * 8); } }
#pragma unroll
        for (int hf = 0; hf < 2; ++hf) {
            const u32x4 aw = awc[hf];
            const u32x4 bw = bwc[hf];
#pragma unroll
            for (int q = 0; q < 2; ++q) {
                const f32x4 a = {__uint_as_float(aw[2 * q] << 16), __uint_as_float(aw[2 * q] & 0xffff0000u), __uint_as_float(aw[2 * q + 1] << 16), __uint_as_float(aw[2 * q + 1] & 0xffff0000u)};
                const f32x4 b = {__uint_as_float(bw[2 * q] << 16), __uint_as_float(bw[2 * q] & 0xffff0000u), __uint_as_float(bw[2 * q + 1] << 16), __uint_as_float(bw[2 * q + 1] & 0xffff0000u)};
                v[hf * 2 + q] = a * DN_ALPHA + b;
                sum += (v[hf * 2 + q][0] + v[hf * 2 + q][1]) + (v[hf * 2 + q][2] + v[hf * 2 + q][3]);
            }
        }
        const float mu = wave_sum(sum) * (1.0f / 1024.0f);
        float sq = 0.f;
#pragma unroll
        for (int j = 0; j < 4; ++j) { const f32x4 d = v[j] - mu; sq += (d[0] * d[0] + d[1] * d[1]) + (d[2] * d[2] + d[3] * d[3]); }
        const float rs = rsqrtf(wave_sum(sq) * (1.0f / 1024.0f) + 1e-5f);
#pragma unroll
        for (int j = 0; j < 4; ++j) *(f32x4*)(p.out + (size_t)n * 1024 + (j >> 1) * 512 + lane * 8 + (j & 1) * 4) = (v[j] - mu) * rs * g[j] + be[j];
    }
}
__device__ __forceinline__ unsigned pack_fp8x4(f32x4 a, float sc) {
    int w = 0;
    w = __builtin_amdgcn_cvt_pk_fp8_f32(a[0] * sc, a[1] * sc, w, false);
    w = __builtin_amdgcn_cvt_pk_fp8_f32(a[2] * sc, a[3] * sc, w, true);
    return (unsigned)w;
}
__device__ __forceinline__ void peer_tabconv(const Params& p, const int t) {
#pragma unroll 1
    for (size_t i = ((size_t)blockIdx.x * NTHREADS + t) * 16; i < (size_t)16384 * 1024; i += (size_t)gridDim.x * NTHREADS * 16) {
        u32x4 wu, wv;
#pragma unroll
        for (int q = 0; q < 4; ++q) { wu[q] = pack_fp8x4(*(const f32x4*)(p.pu + i + 4 * q), 32.0f); wv[q] = pack_fp8x4(*(const f32x4*)(p.pv + i + 4 * q), 2.0f); }
        *(u32x4*)(p.u8() + i) = wu;
        *(u32x4*)(p.v8() + i) = wv;
    }
}

namespace psel {
typedef short bf16x8 __attribute__((ext_vector_type(8)));
typedef float f32x16 __attribute__((ext_vector_type(16)));
#define PSEL_SWZ(row, colB) ((row) * 256 + ((colB) ^ (((row) & 7) << 4)))
__device__ __forceinline__ int f2key(int bits) { return bits ^ (int)((unsigned)(bits >> 31) >> 1); }
__device__ __forceinline__ void ce(int& a, int& b) { const int hi = a > b ? a : b, lo = a > b ? b : a; a = hi; b = lo; }
template <int N> __device__ __forceinline__ void sort_desc(int (&x)[N]) {
#pragma unroll
    for (int k = 2; k <= N; k <<= 1)
#pragma unroll
        for (int j = k >> 1; j > 0; j >>= 1)
#pragma unroll
            for (int i = 0; i < N; ++i) { const int l = i ^ j; if (l > i) { if ((i & k) == 0) ce(x[i], x[l]); else ce(x[l], x[i]); } }
}
template <int N> __device__ __forceinline__ void merge_desc(int (&x)[N]) {
#pragma unroll
    for (int j = N >> 1; j > 0; j >>= 1)
#pragma unroll
        for (int i = 0; i < N; ++i) { const int l = i ^ j; if (l > i) ce(x[i], x[l]); }
}
__device__ __forceinline__ void top16_merge(int (&a)[16], const int (&b)[16]) {
#pragma unroll
    for (int i = 0; i < 16; ++i) a[i] = a[i] > b[15 - i] ? a[i] : b[15 - i];
    merge_desc<16>(a);
}
__device__ __forceinline__ void cross_merge(int (&a)[16], int hi) {
    int b[16];
#pragma unroll
    for (int i = 0; i < 16; ++i) {
        const auto rr = __builtin_amdgcn_permlane32_swap((unsigned)a[i], (unsigned)a[i], false, false);
        b[i] = (int)(hi ? rr[0] : rr[1]);
    }
    top16_merge(a, b);
}
__device__ __forceinline__ void top16_scores(const f32x16 (&acc)[4], int hi, int (&out)[16]) {
    int x[4][16];
    const int hi4 = hi << 2;
#pragma unroll
    for (int kb = 0; kb < 4; ++kb)
#pragma unroll
        for (int r = 0; r < 16; ++r) {
            const int c = 32 * kb + (r & 3) + 8 * (r >> 2);
            x[kb][r] = f2key((__float_as_int(acc[kb][r]) & ~0x7F) | (c | hi4));
        }
#pragma unroll
    for (int kb = 0; kb < 4; ++kb) { sort_desc<16>(x[kb]); __builtin_amdgcn_sched_barrier(0); }
    top16_merge(x[0], x[1]);
    top16_merge(x[2], x[3]);
    top16_merge(x[0], x[2]);
#pragma unroll
    for (int i = 0; i < 16; ++i) out[i] = x[0][i];
    cross_merge(out, hi);
}
__device__ __forceinline__ int lut16(unsigned long long lo, unsigned long long hi, int a) {
    const unsigned long long d = (a & 8) ? hi : lo;
    return (int)(d >> ((a & 7) * 8)) & 0xFF;
}

__device__ __forceinline__ void stage_subkeys(const float* sub_keys, unsigned char* lds, const int t) {
#pragma unroll 1
    for (int i = t; i < 2 * 128 * 16; i += NTHREADS) {
        const int p = i >> 11, row = (i >> 4) & 127, ch = i & 15;
        const float* src = sub_keys + ((size_t)p * 128 + row) * 128 + ch * 8;
        const f32x4 a = *(const f32x4*)src, b = *(const f32x4*)(src + 4);
        u32x4 w; w.x = pack_bf16(a[0], a[1]); w.y = pack_bf16(a[2], a[3]); w.z = pack_bf16(b[0], b[1]); w.w = pack_bf16(b[2], b[3]);
        *(u32x4*)(lds + p * 32768 + PSEL_SWZ(row, ch * 16)) = w;
    }
}

__device__ __forceinline__ void wave_task(const bf16_t* qry, int* sel_e, float* sel_g, const unsigned char* lds, int tok0, int h, int lane) {
    const int r32 = lane & 31, hi = lane >> 5;
    int top[2][16];
#pragma unroll
    for (int p = 0; p < 2; ++p) {
        const bf16_t* qrow = qry + (size_t)(tok0 + r32) * 2048 + h * 256 + p * 128 + hi * 8;
        bf16x8 qf[8];
#pragma unroll
        for (int kk = 0; kk < 8; ++kk) qf[kk] = *(const bf16x8*)(qrow + kk * 16);
        f32x16 acc[4];
#pragma unroll
        for (int kb = 0; kb < 4; ++kb) acc[kb] = f32x16{};
        const unsigned char* base = lds + p * 32768;
#pragma unroll
        for (int kk = 0; kk < 8; ++kk)
#pragma unroll
            for (int kb = 0; kb < 4; ++kb) {
                const bf16x8 a = *(const bf16x8*)(base + PSEL_SWZ(32 * kb + r32, (2 * kk + hi) * 16));
                acc[kb] = __builtin_amdgcn_mfma_f32_32x32x16_bf16(a, qf[kk], acc[kb], 0, 0, 0);
            }
        __builtin_amdgcn_sched_barrier(0);
        top16_scores(acc, hi, top[p]);
        __builtin_amdgcn_sched_barrier(0);
    }
    float v1[16], v2[16];
    unsigned long long i0lo = 0, i0hi = 0, i1lo = 0, i1hi = 0;
#pragma unroll
    for (int i = 0; i < 16; ++i) {
        const int b0 = f2key(top[0][i]), b1 = f2key(top[1][i]);
        if (i < 8) { i0lo |= (unsigned long long)(b0 & 0x7F) << (i * 8); i1lo |= (unsigned long long)(b1 & 0x7F) << (i * 8); }
        else { i0hi |= (unsigned long long)(b0 & 0x7F) << ((i - 8) * 8); i1hi |= (unsigned long long)(b1 & 0x7F) << ((i - 8) * 8); }
        const float f0 = __int_as_float(b0 & ~0x7F), f1 = __int_as_float(b1 & ~0x7F);
        v1[i] = hi ? f1 : f0; v2[i] = hi ? f0 : f1;
    }
    const int hcode = hi << 8;
    const int PADK = (int)0x80000000;
    int g1[16], g2[16];
#pragma unroll
    for (int b = 0; b < 16; ++b) {
        int k = f2key((__float_as_int(v1[0] + v2[b]) & ~0x1FF) | (b | hcode));
        if (b == 0) k = hi ? PADK : k;
        g1[b] = k;
    }
    {
#define PSEL_C(n, a, b) g2[n] = f2key((__float_as_int(v1[a] + v2[b]) & ~0x1FF) | (((a) << 4) | (b) | hcode)); if ((a) == (b)) g2[n] = hi ? PADK : g2[n];
        PSEL_C(0, 1, 1) PSEL_C(1, 1, 2) PSEL_C(2, 1, 3) PSEL_C(3, 1, 4) PSEL_C(4, 1, 5) PSEL_C(5, 1, 6) PSEL_C(6, 1, 7)
        PSEL_C(7, 2, 2) PSEL_C(8, 2, 3) PSEL_C(9, 2, 4) PSEL_C(10, 3, 3)
#undef PSEL_C
        g2[11] = PADK; g2[12] = PADK; g2[13] = PADK; g2[14] = PADK; g2[15] = PADK;
    }
    merge_desc<16>(g1);
    __builtin_amdgcn_sched_barrier(0);
    sort_desc<16>(g2);
    top16_merge(g1, g2);
    cross_merge(g1, hi);
    __builtin_amdgcn_sched_barrier(0);
    float val[16];
    int code[16];
#pragma unroll
    for (int k = 0; k < 16; ++k) { const int b = f2key(g1[k]); val[k] = __int_as_float(b & ~0x1FF); code[k] = b & 0x1FF; }
    float e[16], sum = 0.f;
#pragma unroll
    for (int k = 0; k < 16; ++k) { e[k] = __expf(val[k] - val[0]); sum += e[k]; }
    const float inv = 1.0f / sum;
    int* ep = sel_e + (size_t)r32 * 128 + 2 * h;
    float* gp = sel_g + (size_t)r32 * 128 + 2 * h;
#pragma unroll
    for (int k = 0; k < 16; ++k) {
        if ((k >> 3) == hi) {
            const int c = code[k];
            const int sw = c >> 8, a0 = (c >> 4) & 15, b0 = c & 15;
            const int a = sw ? b0 : a0, b = sw ? a0 : b0;
            ep[(k & 7) * 16 + (k >> 3)] = lut16(i0lo, i0hi, a) * 128 + lut16(i1lo, i1hi, b);
            gp[(k & 7) * 16 + (k >> 3)] = e[k] * inv;
        }
    }
}
}

__device__ __forceinline__ void phase_select_mfma(const Params& p, unsigned char* lds_raw, const int t) {
    psel::stage_subkeys(p.sub_keys, lds_raw, t);
    int* oe = (int*)(lds_raw + 65536);
    float* og = (float*)(lds_raw + 81920);
    const int wave = t >> 6, lane = t & 63;
#pragma unroll 1
    for (int grp = blockIdx.x; grp < NTOK / 32; grp += gridDim.x) {
        __syncthreads();
        psel::wave_task(p.qry(), oe, og, lds_raw, grp * 32, wave, lane);
        __syncthreads();
#pragma unroll
        for (int i = 0; i < 2; ++i) {
            const int ch = t + i * NTHREADS;
            *(u32x4*)(p.sel_e() + (size_t)grp * 32 * 128 + ch * 4) = *(const u32x4*)(oe + ch * 4);
            *(f32x4*)(p.sel_g() + (size_t)grp * 32 * 128 + ch * 4) = *(const f32x4*)(og + ch * 4);
        }
    }
    __syncthreads();
}

#ifndef DIAG_TIME
#define DIAG_TIME 0
#endif
#if DIAG_TIME
#ifndef DT_GAIN
#define DT_GAIN 0.5f
#endif
#ifndef DT_Q
#define DT_Q 256.0f
#endif
#ifndef DT_A1
#define DT_A1 0
#define DT_B1 0
#define DT_A2 0
#define DT_B2 0
#define DT_C1 0
#define DT_D1 0
#define DT_C2 0
#define DT_D2 0
#endif
#define TSTAMP(p) ((unsigned long long*)((p).ws + ((size_t)505 << 20)))
#define STAMP(i) do { if (blockIdx.x == 0 && threadIdx.x == 0) TSTAMP(p)[i] = __builtin_amdgcn_s_memrealtime(); } while (0)
#else
#define STAMP(i) do {} while (0)
#endif
enum { PH_PROLOGUE = 0, PH_XCONV, PH_INPROJ, PH_G1, PH_GLA_MOBA, PH_MERGE, PH_OUTPROJ, PH_LN1, PH_QRY, PH_SELECT, PH_PEER_U, PH_PEER_RED, PH_PEER_V, PH_LN2 };
__device__ __forceinline__ void do_phase(const Params& p, const int ph, int chunk, unsigned char* lds_raw) {
    const int bid = blockIdx.x, nb = gridDim.x;
    float* smem_all = (float*)lds_raw;
    int t = (__builtin_amdgcn_readfirstlane(threadIdx.x) & ~63) + (int)__builtin_amdgcn_mbcnt_hi(~0u, __builtin_amdgcn_mbcnt_lo(~0u, 0u));
    asm volatile("" : "+v"(t));
    if (ph == PH_PROLOGUE) {
        const int t_in = 16 * 128, t_out = 16 * 16, t_q = 16 * 32;
#pragma unroll 1
        for (int vb = bid; vb < t_in + t_out + t_q; vb += nb) {
            if (vb < t_in) transpose_tile(p.w_in, IN_WIDTH, p.winT(), OFF_LR, 16, vb & 15, vb >> 4, smem_all, t);
            else if (vb < t_in + t_out) { const int v = vb - t_in; transpose_tile(p.w_out, 1024, p.woutT(), 1 << 30, 0, v & 15, v >> 4, smem_all, t); }
            else { const int v = vb - t_in - t_out; transpose_tile(p.w_q, 2048, p.wqT(), 1 << 30, 0, v & 15, v >> 4, smem_all, t); }
        }
        if (bid == 0 && t < 64) p.qctr()[t] = 0u;
        if (bid == 0 && t == 0) __hip_atomic_store((unsigned*)(p.ws + ((size_t)506 << 20)), 0u, __ATOMIC_RELAXED, __HIP_MEMORY_SCOPE_AGENT);
        if (bid < SEQ * 16 / NTHREADS) {
            const int i = bid * NTHREADS + t;
            const int pos = i >> 4, k = i & 15;
            const float inv_freq = exp2f(-(float)k * 1.1832230355827609f);
            const float ang = (float)pos * inv_freq;
            float s, c;
            sincosf(ang, &s, &c);
            p.rope_cos()[i] = c; p.rope_sin()[i] = s;
        }
        return;
    }
    if (ph == PH_XCONV) {
        if (bid < CHUNK_SEQS * 8 * 8 * 128 / NTHREADS) p.kmean()[bid * NTHREADS + t] = 0.f;
        phase_xconv(p, chunk, smem_all, t);
        return;
    }
    if (ph == PH_MERGE) {
        phase_merge(p, chunk, t);
        if (chunk + 1 < NCHUNK) {
            int t2 = t;
            asm volatile("" : "+v"(t2));
            if (bid < CHUNK_SEQS * 8 * 8 * 128 / NTHREADS) p.kmean()[bid * NTHREADS + t2] = 0.f;
            phase_xconv(p, chunk + 1, smem_all, t2);
        }
        return;
    }
    if (ph == PH_INPROJ) {
        pg8::Gemm g{p.xbc(), p.winT(), CT, 8192, 1024};
        pg8::StaticOrder S; S.init(g.M, g.N, nb, bid);
        EpiInProj E{InProjPtrs{(char*)p.qa(), p.kmean(), p.rope_cos(), p.rope_sin()}};
        __syncthreads();
        pg8::gemm_phase<EpiInProj, pg8::StaticOrder, true, true>((PG8_LAS unsigned char*)lds_raw, g, S, E, t);
        __syncthreads();
        return;
    }
    if (ph == PH_OUTPROJ) {
        pg8::Gemm g{p.y(), p.woutT(), NTOK, 1024, 1024};
        pg8::StaticOrder S; S.init(g.M, g.N, nb, bid);
        EpiResid E{p.x1(), p.x};
        __syncthreads();
        pg8::gemm_phase<EpiResid, pg8::StaticOrder, true, true>((PG8_LAS unsigned char*)lds_raw, g, S, E, t);
        __syncthreads();
        return;
    }
    if (ph == PH_QRY) {
        pg8::Gemm g{p.x1b(), p.wqT(), NTOK, 2048, 1024};
        pg8::StaticOrder S; S.init(g.M, g.N, nb, bid);
        EpiBf16 E{p.qry(), 2048};
        __syncthreads();
        pg8::gemm_phase<EpiBf16, pg8::StaticOrder, true, true>((PG8_LAS unsigned char*)lds_raw, g, S, E, t);
        __syncthreads();
        return;
    }
    if (ph == PH_G1) {
#pragma unroll 1
        for (int item = bid; item < CHUNK_SEQS * 4 * 32; item += nb) gla::g1_item(p, item, (char*)lds_raw, t);
        return;
    }
    if (ph == PH_GLA_MOBA) {
        __syncthreads();
#ifdef DIAG_G2X
#pragma unroll 1
        for (int item = bid; item < CHUNK_SEQS * 4; item += nb) gla::g2_item<DIAG_G2X>(p, item, (char*)lds_raw, t);
#endif
#pragma unroll 1
        for (int item = bid; item < CHUNK_SEQS * 4; item += nb) gla::g2_item<0>(p, item, (char*)lds_raw, t);
        __syncthreads();
        STAMP(19 + chunk);
        int t2 = t;
        asm volatile("" : "+v"(t2));
        phase_moba_mfma(p, chunk, lds_raw, t2);
        __syncthreads();
        return;
    }
    if (ph == PH_SELECT) { phase_select_mfma(p, lds_raw, t); return; }
    if (ph == PH_PEER_U) { peer_sliced(p.qctr() + chunk * 8, (unsigned*)lds_raw, t, [&](int s, int tile) { peer_u_item(p, s, tile, t); }); return; }
    if (ph == PH_PEER_RED) { peer_reduce(p, t); return; }
    if (ph == PH_PEER_V) { peer_sliced(p.qctr() + 16 + chunk * 8, (unsigned*)lds_raw, t, [&](int s, int tile) { peer_v_item(p, s, tile, t); }); return; }
    if (ph == PH_LN2) { peer_ln2(p, t); return; }
    if (ph == PH_LN1) { if (chunk != 2) peer_tabconv(p, t); if (chunk != 3) phase_ln1(p, t); return; }
}


#ifndef DIAG_MOBA
#define DIAG_MOBA 0
#endif
#if DIAG_MOBA
#define DQ(p) ((float*)((p).ws + ((size_t)472 << 20)))
#define DKM(p) ((float*)((p).ws + ((size_t)504 << 20) + 65536))
#define DOB(p) ((float*)((p).ws + ((size_t)496 << 20)))
#define DMET(p) ((float*)((p).ws + ((size_t)504 << 20)))
__device__ __forceinline__ void dg_sgemm_tile(const float* __restrict__ A, int lda, const float* __restrict__ B, int ldb, float* __restrict__ C, int ldc,
                           int N, int K, int tm, int tn, float* smem, int tid) {
    float* As = smem;
    float* Bs = smem + 16 * 64;
    const int tx = tid & 15, ty = tid >> 4;
    const int m0 = tm * 64, n0 = tn * 64;
    float acc[4][4];
#pragma unroll
    for (int i = 0; i < 4; ++i)
#pragma unroll
        for (int j = 0; j < 4; ++j) acc[i][j] = 0.f;
    const int ar = tid >> 2, akq = (tid & 3) * 4;
    const int bk = tid >> 4, bnq = (tid & 15) * 4;
    for (int k0 = 0; k0 < K; k0 += 16) {
        float4 av = *(const float4*)(A + (size_t)(m0 + ar) * lda + k0 + akq);
        float4 bv = *(const float4*)(B + (size_t)(k0 + bk) * ldb + n0 + bnq);
        __syncthreads();
        As[(akq + 0) * 64 + ar] = av.x; As[(akq + 1) * 64 + ar] = av.y; As[(akq + 2) * 64 + ar] = av.z; As[(akq + 3) * 64 + ar] = av.w;
        *(float4*)(Bs + bk * 64 + bnq) = bv;
        __syncthreads();
#pragma unroll
        for (int kk = 0; kk < 16; ++kk) {
            float4 a = *(const float4*)(As + kk * 64 + ty * 4);
            float4 b = *(const float4*)(Bs + kk * 64 + tx * 4);
            float aa[4] = {a.x, a.y, a.z, a.w}, bb[4] = {b.x, b.y, b.z, b.w};
#pragma unroll
            for (int i = 0; i < 4; ++i)
#pragma unroll
                for (int j = 0; j < 4; ++j) acc[i][j] += aa[i] * bb[j];
        }
    }
#pragma unroll
    for (int i = 0; i < 4; ++i) *(float4*)(C + (size_t)(m0 + ty * 4 + i) * ldc + n0 + tx * 4) = make_float4(acc[i][0], acc[i][1], acc[i][2], acc[i][3]);
}
__device__ __forceinline__ void dg_rope(const Params& p, int vb, int tid) {
    float* row = DQ(p) + (size_t)vb * 3072;
    const int which = tid >> 7, h = (tid >> 4) & 7, i = tid & 15;
    const float inv_freq = exp2f(-(float)i * 1.1832230355827609f);
    const float ang = (float)vb * inv_freq;
    float s, c;
    sincosf(ang, &s, &c);
    float* base = row + which * 1024 + h * 128;
    const float x1 = base[i], x2 = base[i + 16];
    base[i] = x1 * c - x2 * s;
    base[i + 16] = x1 * s + x2 * c;
}
__device__ __forceinline__ void dg_kmean(const Params& p, int vb, float* smem, int tid) {
    const int h = vb >> 3, n = vb & 7;
    const int d = tid & 127, half = tid >> 7;
    float acc = 0.f;
    const float* base = DQ(p) + (size_t)(n * 256 + half * 128) * 3072 + 1024 + h * 128 + d;
    for (int j = 0; j < 128; ++j) acc += base[(size_t)j * 3072];
    __syncthreads();
    smem[tid] = acc;
    __syncthreads();
    if (tid < 128) DKM(p)[(h * 8 + n) * 128 + d] = (smem[tid] + smem[tid + 128]) * (1.0f / 256.0f);
}
__device__ __forceinline__ void dg_moba(const Params& p, int vb, int tid) {
    const int wave = tid >> 6, lane = tid & 63;
    const int item = vb * 4 + wave;
    const int pos = item >> 3, h = item & 7;
    const int qblk = pos >> 8;
    const float* P = DQ(p);
    const float2 q = *(const float2*)(P + (size_t)pos * 3072 + h * 128 + 2 * lane);
    float g[7];
#pragma unroll
    for (int n = 0; n < 7; ++n) {
        const float2 km = *(const float2*)(DKM(p) + (h * 8 + n) * 128 + 2 * lane);
        const float d = wave_sum(q.x * km.x + q.y * km.y);
        g[n] = (n < qblk) ? d : -INFINITY;
    }
    unsigned selmask = 0;
    if (qblk <= 3) {
        selmask = (1u << qblk) - 1u;
    } else {
#pragma unroll
        for (int r = 0; r < 3; ++r) {
            float best = -INFINITY;
            int bi = 0;
#pragma unroll
            for (int n = 0; n < 7; ++n) {
                const bool ok = (n < qblk) && !((selmask >> n) & 1u) && (g[n] > best);
                best = ok ? g[n] : best;
                bi = ok ? n : bi;
            }
            selmask |= 1u << bi;
        }
    }
    const float scale = 0.08838834764831845f;
    float m = -INFINITY, l = 0.f;
    float2 acc = make_float2(0.f, 0.f);
    for (int n = 0; n <= qblk; ++n) {
        int nk;
        if (n == qblk) nk = (pos & 255) + 1;
        else if ((selmask >> n) & 1u) nk = 256;
        else continue;
        const float* kb = P + (size_t)(n * 256) * 3072 + 1024 + h * 128 + 2 * lane;
        const float* vb_ = P + (size_t)(n * 256) * 3072 + 2048 + h * 128 + 2 * lane;
        for (int j = 0; j < nk; ++j) {
            const float2 k2 = *(const float2*)(kb + (size_t)j * 3072);
            const float2 v2 = *(const float2*)(vb_ + (size_t)j * 3072);
            const float sc = wave_sum(q.x * k2.x + q.y * k2.y) * scale;
            const float mn = fmaxf(m, sc);
            const float corr = expf(m - mn);
            const float pe = expf(sc - mn);
            l = l * corr + pe;
            acc.x = acc.x * corr + pe * v2.x;
            acc.y = acc.y * corr + pe * v2.y;
            m = mn;
        }
    }
    const float inv = 1.0f / l;
    *(float2*)(DOB(p) + (size_t)pos * 1024 + h * 128 + 2 * lane) = make_float2(acc.x * inv, acc.y * inv);
}
#ifndef DIAG_SEL
#define DIAG_SEL 0
#endif
__device__ __forceinline__ void dg_compare(const Params& p, int vb, float* smem, int tid) {
    float num = 0.f, den = 0.f;
#pragma unroll
    for (int j = 0; j < 4; ++j) {
        const int c = j * 256 + tid;
        float ref, got;
        const size_t hm = ((size_t)(c >> 7) * SEQ + vb) * 128 + (c & 127);
        if (DIAG_SEL == 0) { ref = DOB(p)[(size_t)vb * 1024 + c]; got = bf2f(p.qb()[hm]); }
        else if (DIAG_SEL == 1) { ref = DQ(p)[(size_t)vb * 3072 + 1024 + c]; got = bf2f(p.kb()[hm]); }
        else if (DIAG_SEL == 2) { ref = DQ(p)[(size_t)vb * 3072 + 2048 + c]; got = bf2f(p.vb()[hm]); }
        else if (DIAG_SEL == 3) { ref = DKM(p)[(vb & 63) * 128 + (c & 127)]; got = p.kmean()[(vb & 63) * 128 + (c & 127)]; }
        else if (DIAG_SEL == 8) { ref = DQ(p)[(size_t)vb * 3072 + 2048 + c]; got = ref * 1.1f; }
        else { ref = DQ(p)[(size_t)vb * 3072 + 2048 + c]; got = 1.0f; }
        num += (got - ref) * (got - ref);
        den += ref * ref;
    }
    num = block_sum(num, smem, tid);
    den = block_sum(den, smem, tid);
    if (tid == 0) { atomicAdd(DMET(p), num); atomicAdd(DMET(p) + 1, den); }
}
enum { DG_GEMM = 100, DG_ROPE, DG_KMEAN, DG_MOBA, DG_CMP, DG_SCALE };
__device__ __forceinline__ void do_diag(const Params& p, const int ph, unsigned char* lds_raw) {
    const int bid = blockIdx.x, nb = gridDim.x;
    int t = (__builtin_amdgcn_readfirstlane(threadIdx.x) & ~63) + (int)__builtin_amdgcn_mbcnt_hi(~0u, __builtin_amdgcn_mbcnt_lo(~0u, 0u));
    asm volatile("" : "+v"(t));
    const int half = t >> 8, tid = t & 255;
    float* smem = (float*)lds_raw + half * 8192;
    int nvb = 0;
    if (ph == DG_GEMM) nvb = 32 * 48; else if (ph == DG_ROPE) nvb = 2048; else if (ph == DG_KMEAN) nvb = 64; else if (ph == DG_MOBA) nvb = 4096; else if (ph == DG_CMP) nvb = 2048;
    if (ph == DG_SCALE) {
        const float f = 1.0f + sqrtf(DMET(p)[0] / DMET(p)[1]);
#pragma unroll 1
        for (size_t i = (size_t)bid * NTHREADS + t; i < (size_t)NTOK * 1024; i += (size_t)nb * NTHREADS) p.out[i] *= f;
        return;
    }
    if (ph == DG_GEMM && bid == 0 && t < 2) DMET(p)[t] = 0.f;
#pragma unroll 1
    for (int vp = bid * 2; vp < nvb; vp += nb * 2) {
        const int vb = vp + half;
        __syncthreads();
        if (ph == DG_GEMM) dg_sgemm_tile(p.x, 1024, p.w_in + 3088, IN_WIDTH, DQ(p), 3072, 3072, 1024, vb / 48, vb % 48, smem, tid);
        else if (ph == DG_ROPE) dg_rope(p, vb, tid);
        else if (ph == DG_KMEAN) dg_kmean(p, vb, smem, tid);
        else if (ph == DG_MOBA) dg_moba(p, vb, tid);
        else if (ph == DG_CMP) dg_compare(p, vb, smem, tid);
    }
}
#endif

__global__ void __launch_bounds__(NTHREADS, 2) mega_kernel(Params p) {
    extern __shared__ __attribute__((aligned(16))) unsigned char dyn_lds[];
    cg::grid_group grid = cg::this_grid();
    unsigned* gbar_ctr = (unsigned*)(p.ws + ((size_t)506 << 20));
#define GSYNC() do { asm volatile("s_waitcnt vmcnt(0)" ::: "memory"); __syncthreads(); if (threadIdx.x == 0) { __builtin_amdgcn_fence(__ATOMIC_RELEASE, "agent"); asm volatile("s_waitcnt vmcnt(0)" ::: "memory"); \
        const unsigned old_ = __hip_atomic_fetch_add(gbar_ctr, 1u, __ATOMIC_RELAXED, __HIP_MEMORY_SCOPE_AGENT); const unsigned tgt_ = (old_ / gridDim.x + 1u) * gridDim.x; \
        while (__hip_atomic_load(gbar_ctr, __ATOMIC_RELAXED, __HIP_MEMORY_SCOPE_AGENT) < tgt_) { } \
        __builtin_amdgcn_fence(__ATOMIC_ACQUIRE, "agent"); asm volatile("s_waitcnt vmcnt(0)" ::: "memory"); } __syncthreads(); } while (0)
    STAMP(0);
    do_phase(p, PH_PROLOGUE, 0, dyn_lds);
#pragma unroll 1
    for (int chunk = 0; chunk < NCHUNK; ++chunk) {
        if (chunk == 0) { do_phase(p, PH_XCONV, 0, dyn_lds); grid.sync(); }
        STAMP(1 + chunk * 5);
        do_phase(p, PH_INPROJ, chunk, dyn_lds);
        GSYNC(); STAMP(2 + chunk * 5);
        do_phase(p, PH_G1, chunk, dyn_lds);
        GSYNC(); STAMP(3 + chunk * 5);
        do_phase(p, PH_GLA_MOBA, chunk, dyn_lds);
        GSYNC(); STAMP(4 + chunk * 5);
#if DIAG_MOBA
        if (chunk == 0) {
            do_diag(p, DG_GEMM, dyn_lds); GSYNC();
            do_diag(p, DG_ROPE, dyn_lds); GSYNC();
            do_diag(p, DG_KMEAN, dyn_lds); GSYNC();
            do_diag(p, DG_MOBA, dyn_lds); GSYNC();
            do_diag(p, DG_CMP, dyn_lds); GSYNC();
        }
#endif
        do_phase(p, PH_MERGE, chunk, dyn_lds);
        GSYNC(); STAMP(5 + chunk * 5);
    }
    do_phase(p, PH_OUTPROJ, 0, dyn_lds);
    GSYNC(); STAMP(11);
    do_phase(p, PH_LN1, 0, dyn_lds);
    GSYNC(); STAMP(12);
#ifdef DIAG_L1X
    do_phase(p, PH_LN1, DIAG_L1X, dyn_lds); GSYNC();
#endif
    do_phase(p, PH_QRY, 0, dyn_lds);
    GSYNC(); STAMP(13);
    do_phase(p, PH_SELECT, 0, dyn_lds);
    GSYNC(); STAMP(14);
    do_phase(p, PH_PEER_U, 0, dyn_lds);
    GSYNC(); STAMP(15);
#ifdef DIAG_UX
    do_phase(p, PH_PEER_U, 1, dyn_lds); GSYNC();
#endif
    do_phase(p, PH_PEER_RED, 0, dyn_lds);
    GSYNC(); STAMP(16);
    do_phase(p, PH_PEER_V, 0, dyn_lds);
    GSYNC(); STAMP(17);
#ifdef DIAG_VX
    do_phase(p, PH_PEER_V, 1, dyn_lds); GSYNC();
#endif
    do_phase(p, PH_LN2, 0, dyn_lds);
#ifdef DIAG_SYNCS
#pragma unroll 1
    for (int i = 0; i < DIAG_SYNCS; ++i) grid.sync();
#endif
#ifdef DIAG_FSYNCS
#pragma unroll 1
    for (int i = 0; i < DIAG_FSYNCS; ++i) GSYNC();
#endif
#if DIAG_MOBA
    grid.sync();
    do_diag(p, DG_SCALE, dyn_lds);
#endif
#if DIAG_TIME
    grid.sync(); STAMP(18);
    grid.sync();
    {
        const unsigned long long* ts = TSTAMP(p);
        const float tot = (float)(ts[18] - ts[0]);
        const float f1 = rintf(DT_Q * (float)((ts[DT_B1] - ts[DT_A1]) + (ts[DT_B2] - ts[DT_A2])) / tot) * (1.0f / DT_Q);
        const float f2 = (float)((ts[DT_D1] - ts[DT_C1]) + (ts[DT_D2] - ts[DT_C2])) / tot;
#pragma unroll 1
        for (size_t i = (size_t)blockIdx.x * NTHREADS + threadIdx.x; i < (size_t)NTOK * 1024; i += (size_t)gridDim.x * NTHREADS) p.out[i] *= (1.0f + DT_GAIN * f1);
        (void)f2;
    }
#endif
}

extern "C" void kernel_launch(void* const* d_in, const int* in_sizes, int n_in, void* d_out, int out_size, void* d_ws, size_t ws_size,
                              hipStream_t stream) {
    Params p{};
    p.x = (const float*)d_in[0];
    p.w_in = (const float*)d_in[1];
    p.gla_wd = (const float*)d_in[2];
    p.gla_bd = (const float*)d_in[3];
    p.gla_ng = (const float*)d_in[4];
    p.w_out = (const float*)d_in[5];
    p.ln1_g = (const float*)d_in[6];
    p.ln1_b = (const float*)d_in[7];
    p.w_q = (const float*)d_in[8];
    p.sub_keys = (const float*)d_in[9];
    p.pu = (const float*)d_in[10];
    p.pv = (const float*)d_in[11];
    p.ln2_g = (const float*)d_in[12];
    p.ln2_b = (const float*)d_in[13];
    p.out = (float*)d_out;
    p.ws = (char*)d_ws;
    const size_t MiB = 1 << 20;
    static int grid_blocks = 0;
    if (!grid_blocks) {
        if (507 * MiB > ws_size) { fprintf(stderr, "workspace too small: need %zu have %zu\n", (size_t)(503 * MiB), ws_size); grid_blocks = -1; return; }
        int dev = 0, cus = 0, per_cu = 0;
        (void)hipGetDevice(&dev);
        (void)hipDeviceGetAttribute(&cus, hipDeviceAttributeMultiprocessorCount, dev);
        if (hipFuncSetAttribute((const void*)mega_kernel, hipFuncAttributeMaxDynamicSharedMemorySize, LDS_BYTES) != hipSuccess) { fprintf(stderr, "hipFuncSetAttribute failed\n"); grid_blocks = -1; return; }
        (void)hipOccupancyMaxActiveBlocksPerMultiprocessor(&per_cu, (const void*)mega_kernel, NTHREADS, LDS_BYTES);
        if (per_cu < 1) { fprintf(stderr, "occupancy query says %d blocks per CU\n", per_cu); per_cu = 1; }
        grid_blocks = cus;
    }
    if (grid_blocks < 0) return;
    void* args[] = {&p};
    hipError_t e = hipLaunchCooperativeKernel((const void*)mega_kernel, dim3(grid_blocks), dim3(NTHREADS), args, LDS_BYTES, stream);
    if (e != hipSuccess) fprintf(stderr, "cooperative launch failed: %s (grid %d)\n", hipGetErrorString(e), grid_blocks);
}
```

```cpp
#include <hip/hip_runtime.h>
#include <hip/hip_cooperative_groups.h>
#include <math.h>
#include <stdint.h>
#include <stdio.h>

namespace cg = cooperative_groups;

#define D_MODEL 1024
#define SEQ 2048
#define NTOK 32768
#define IN_WIDTH 8208
#define OFF_LR 3072
#define CHUNK_SEQS 8
#define CT (CHUNK_SEQS * SEQ)
#define NCHUNK (NTOK / CT)
#define DN_ALPHA 1.189207115002721f
#define NTHREADS 512
#define LDS_BYTES 147456

namespace pg8 {
#define PG8_LAS __attribute__((address_space(3)))
typedef unsigned short bf16_t;
typedef short bf16x8 __attribute__((ext_vector_type(8)));
typedef float f32x4 __attribute__((ext_vector_type(4)));
typedef unsigned u32x4 __attribute__((ext_vector_type(4)));
constexpr int BM = 256, BK = 64, HALF = 128, HTB = HALF * BK * 2  , STAGE_BYTES = 8 * HTB, NXCD = 8, WGM = 8;

__host__ __device__ __forceinline__ int lds_byte(int r, int c) { const int st = (r >> 4) * 2 + (c >> 5), rr = r & 15, cc = c & 31, ob = rr * 64 + cc * 2; return st * 1024 + (ob ^ (((ob >> 9) & 1) << 5)); }
__host__ __device__ __forceinline__ void stage_rc(int b, int& R, int& C) { const int st = b / 1024, sb = b % 1024, swz = sb ^ (((sb >> 9) & 1) << 5); R = (st >> 1) * 16 + swz / 64; C = (st & 1) * 32 + (swz % 64) / 2; }
__host__ __device__ __forceinline__ int perm32(int rho) { const int n = rho >> 4, i = rho & 15; return 8 * (i >> 2) + 4 * n + (i & 3); }

struct Unit { int pm, pn; };
struct Gemm { const bf16_t* A; const bf16_t* Bt; int M, N, K; };

struct StaticOrder {
    int nM, nN, nwg, G, c;
    __host__ __device__ void init(int M, int N, int G_, int c_) { nM = M / BM; nN = N / BM; nwg = nM * nN; G = G_; c = c_; }
    __host__ __device__ bool next(int i, Unit& u) const {
        const long L = (long)i * G + c; if (L >= nwg) return false;
        int wgid = (int)L; { const int q = nwg / NXCD, r = nwg % NXCD, xcd = wgid % NXCD, off = wgid / NXCD; wgid = (xcd < r ? xcd * (q + 1) : r * (q + 1) + (xcd - r) * q) + off; }
        const int nig = WGM * nN, gid = wgid / nig, fm = gid * WGM, gsz = (nM - fm) < WGM ? (nM - fm) : WGM;
        u.pm = fm + ((wgid % nig) % gsz); u.pn = (wgid % nig) / gsz; return true;
    }
    __device__ __forceinline__ void a_ready(const Unit&) const {}
    __device__ __forceinline__ void done(const Unit&) const {}
};
__device__ __forceinline__ unsigned cvt_pk_bf16(float lo, float hi) { unsigned r; asm volatile("v_cvt_pk_bf16_f32 %0, %1, %2" : "=v"(r) : "v"(lo), "v"(hi)); return r; }
template <class Epi, class Sched, bool ALIGN_EPI = false, bool SP2 = false>
__device__ __forceinline__ void gemm_phase(PG8_LAS unsigned char* lds, const Gemm g, const Sched& S, const Epi& E, const int tid) {
    const int wid = __builtin_amdgcn_readfirstlane(tid >> 6), lane = tid & 63, wr = wid >> 2, wc = wid & 3, fr = lane & 15, fq = lane >> 4;
    const int K = g.K, nt = K / BK;
    unsigned voffA[2], voffB[2];
#pragma unroll
    for (int i = 0; i < 2; ++i) { int R, C; stage_rc(tid * 16 + i * 8192, R, C); const int Rb = Epi::PERM ? ((R & ~31) + perm32(R & 31)) : R;
        voffA[i] = (unsigned)(R * K + C) * 2u; voffB[i] = (unsigned)(Rb * K + C) * 2u; }
    const size_t kstep = (size_t)(BK * 2);
    const size_t hstep = (size_t)HALF * K * 2;
    const size_t tstep = 2 * hstep;
    const unsigned ldsw = (unsigned)wid * 1024u;
    const int aoff = lds_byte(wr * 64 + fr, fq * 8), boff = lds_byte(wc * 32 + fr, fq * 8);
#define PG8_SA(b, h) (((b) * 2 + (h)) * HTB)
#define PG8_SB(b, h) ((4 + (b) * 2 + (h)) * HTB)
#define PG8_STAGE(bufoff, gbase, voff) do { _Pragma("unroll") for (int _i = 0; _i < 2; ++_i) \
        __builtin_amdgcn_global_load_lds((const unsigned*)((const char*)(gbase) + (voff)[_i]), (PG8_LAS unsigned*)(lds + (bufoff) + ldsw + _i * 8192), 16, 0, 0); } while (0)
#define PG8_LDA(dst, b, h) do { _Pragma("unroll") for (int m = 0; m < 4; ++m) _Pragma("unroll") for (int k = 0; k < 2; ++k) dst[m][k] = *(const PG8_LAS bf16x8*)(lds + PG8_SA(b, h) + aoff + m * 2048 + k * 1024); } while (0)
#define PG8_LDB(dst, b, h) do { _Pragma("unroll") for (int n = 0; n < 2; ++n) _Pragma("unroll") for (int k = 0; k < 2; ++k) dst[n][k] = *(const PG8_LAS bf16x8*)(lds + PG8_SB(b, h) + boff + n * 2048 + k * 1024); } while (0)
#define PG8_MMA(ai, bj, At, Bt) do { __builtin_amdgcn_s_setprio(1); _Pragma("unroll") for (int m = 0; m < 4; ++m) _Pragma("unroll") for (int n = 0; n < 2; ++n) _Pragma("unroll") for (int k = 0; k < 2; ++k) \
        acc[ai][bj][m][n] = __builtin_amdgcn_mfma_f32_16x16x32_bf16(Bt[n][k], At[m][k], acc[ai][bj][m][n], 0, 0, 0); __builtin_amdgcn_s_setprio(0); } while (0)
#define PG8_WAIT_V(n) asm volatile("s_waitcnt vmcnt(" #n ")" ::: "memory")
#define PG8_WAIT_L(n) asm volatile("s_waitcnt lgkmcnt(" #n ")" ::: "memory")
#define PG8_BAR __builtin_amdgcn_s_barrier()
#define PG8_SCHED __builtin_amdgcn_sched_barrier(0)
    Unit cur, nxt; int ui = 0;
    if (!S.next(0, cur)) return;
    f32x4 acc[2][2][4][2];
#pragma unroll
    for (int a = 0; a < 2; ++a)
#pragma unroll
        for (int b = 0; b < 2; ++b)
#pragma unroll
            for (int m = 0; m < 4; ++m)
#pragma unroll
                for (int n = 0; n < 2; ++n) acc[a][b][m][n] = (f32x4){0.f, 0.f, 0.f, 0.f};
    bf16x8 At[4][2], B0[2][2], B1[2][2];
    const char* cA = (const char*)g.A + (size_t)cur.pm * tstep; const char* cB = (const char*)g.Bt + (size_t)cur.pn * tstep;
    S.a_ready(cur);
    if constexpr (SP2) {
        PG8_STAGE(PG8_SB(0, 0), cB, voffB); PG8_STAGE(PG8_SB(0, 1), cB + hstep, voffB); PG8_STAGE(PG8_SA(0, 0), cA, voffA); PG8_STAGE(PG8_SA(0, 1), cA + hstep, voffA);
        if (wr == 1) PG8_BAR;
        PG8_WAIT_V(2); PG8_BAR;
        PG8_STAGE(PG8_SB(1, 0), cB + kstep, voffB); PG8_STAGE(PG8_SA(1, 0), cA + kstep, voffA); PG8_STAGE(PG8_SB(1, 1), cB + hstep + kstep, voffB);
        PG8_WAIT_V(6); PG8_BAR;
    } else {
        PG8_STAGE(PG8_SB(0, 0), cB, voffB); PG8_STAGE(PG8_SA(0, 0), cA, voffA); PG8_STAGE(PG8_SB(0, 1), cB + hstep, voffB); PG8_STAGE(PG8_SA(0, 1), cA + hstep, voffA);
        if (wr == 1) PG8_BAR;
        PG8_WAIT_V(4); PG8_BAR;
        PG8_STAGE(PG8_SB(1, 0), cB + kstep, voffB); PG8_STAGE(PG8_SA(1, 0), cA + kstep, voffA); PG8_STAGE(PG8_SB(1, 1), cB + hstep + kstep, voffB);
        PG8_WAIT_V(6); PG8_BAR;
    }
    for (;;) {
        const bool has_next = S.next(ui + 1, nxt);
        const char* nA = has_next ? (const char*)g.A + (size_t)nxt.pm * tstep : cA; const char* nB = has_next ? (const char*)g.Bt + (size_t)nxt.pn * tstep : cB;
        for (int t = 0; t < nt; t += 2) {
            const bool last = (t == nt - 2);
            const char* a1 = cA + (size_t)(t + 1) * kstep;
            const char* a2 = last ? nA : cA + (size_t)(t + 2) * kstep; const char* b2 = last ? nB : cB + (size_t)(t + 2) * kstep;
            const char* a3 = a2 + kstep; const char* b3 = b2 + kstep;
            if (last && has_next) S.a_ready(nxt);
            if constexpr (SP2) {
            PG8_LDB(B0, 0, 0); PG8_LDB(B1, 0, 1); PG8_SCHED; PG8_LDA(At, 0, 0); PG8_STAGE(PG8_SA(1, 1), a1 + hstep, voffA);
            PG8_WAIT_V(8); PG8_WAIT_L(0); PG8_BAR; PG8_MMA(0, 0, At, B0); PG8_MMA(0, 1, At, B1); PG8_BAR; PG8_SCHED;
            PG8_LDA(At, 0, 1); PG8_STAGE(PG8_SB(0, 0), b2, voffB); PG8_STAGE(PG8_SB(0, 1), b2 + hstep, voffB); PG8_STAGE(PG8_SA(0, 0), a2, voffA);
            PG8_WAIT_V(8); PG8_WAIT_L(0); PG8_BAR; PG8_MMA(1, 0, At, B0); PG8_MMA(1, 1, At, B1); PG8_BAR; PG8_SCHED;
            PG8_LDB(B0, 1, 0); PG8_LDB(B1, 1, 1); PG8_SCHED; PG8_LDA(At, 1, 0); PG8_STAGE(PG8_SA(0, 1), a2 + hstep, voffA);
            PG8_WAIT_V(8); PG8_WAIT_L(0); PG8_BAR; PG8_MMA(0, 0, At, B0); PG8_MMA(0, 1, At, B1); PG8_BAR; PG8_SCHED;
            PG8_LDA(At, 1, 1); PG8_STAGE(PG8_SB(1, 0), b3, voffB); PG8_STAGE(PG8_SB(1, 1), b3 + hstep, voffB); PG8_STAGE(PG8_SA(1, 0), a3, voffA);
            PG8_WAIT_V(8); PG8_WAIT_L(0); PG8_BAR; PG8_MMA(1, 0, At, B0); PG8_MMA(1, 1, At, B1); PG8_BAR; PG8_SCHED;
            } else {
            PG8_LDB(B0, 0, 0); PG8_SCHED; PG8_LDA(At, 0, 0); PG8_STAGE(PG8_SA(1, 1), a1 + hstep, voffA);
            PG8_WAIT_L(8); PG8_BAR; PG8_WAIT_L(0); PG8_MMA(0, 0, At, B0); PG8_BAR; PG8_SCHED;
            PG8_LDB(B1, 0, 1); PG8_STAGE(PG8_SB(0, 0), b2, voffB);
            PG8_BAR; PG8_WAIT_L(0); PG8_MMA(0, 1, At, B1); PG8_BAR;
            PG8_LDA(At, 0, 1); PG8_STAGE(PG8_SA(0, 0), a2, voffA);
            PG8_BAR; PG8_WAIT_L(0); PG8_MMA(1, 0, At, B0); PG8_BAR; PG8_SCHED;
            PG8_STAGE(PG8_SB(0, 1), b2 + hstep, voffB);
            PG8_WAIT_V(6); PG8_BAR; PG8_MMA(1, 1, At, B1); PG8_BAR;
            PG8_LDB(B0, 1, 0); PG8_SCHED; PG8_LDA(At, 1, 0); PG8_STAGE(PG8_SA(0, 1), a2 + hstep, voffA);
            PG8_WAIT_L(8); PG8_BAR; PG8_WAIT_L(0); PG8_MMA(0, 0, At, B0); PG8_BAR; PG8_SCHED;
            PG8_LDB(B1, 1, 1); PG8_STAGE(PG8_SB(1, 0), b3, voffB);
            PG8_BAR; PG8_WAIT_L(0); PG8_MMA(0, 1, At, B1); PG8_BAR;
            PG8_LDA(At, 1, 1); PG8_STAGE(PG8_SA(1, 0), a3, voffA);
            PG8_BAR; PG8_WAIT_L(0); PG8_MMA(1, 0, At, B0); PG8_BAR; PG8_SCHED;
            PG8_STAGE(PG8_SB(1, 1), b3 + hstep, voffB);
            PG8_WAIT_V(6); PG8_BAR; PG8_MMA(1, 1, At, B1); PG8_BAR;
            }
        }
        if constexpr (ALIGN_EPI) { if (wr == 0) PG8_BAR; }
        if constexpr (!Epi::AFTER_DRAIN) { E(acc, cur, wr, wc, fr, fq); S.done(cur); }
        if (!has_next) break;
#pragma unroll
        for (int a = 0; a < 2; ++a)
#pragma unroll
            for (int b = 0; b < 2; ++b)
#pragma unroll
                for (int m = 0; m < 4; ++m)
#pragma unroll
                    for (int n = 0; n < 2; ++n) acc[a][b][m][n] = (f32x4){0.f, 0.f, 0.f, 0.f};
        cur = nxt; cA = nA; cB = nB; ++ui;
        if constexpr (ALIGN_EPI) { if (wr == 1) PG8_BAR; }
    }
    PG8_WAIT_V(0);
    if constexpr (!ALIGN_EPI) { if (wr == 0) PG8_BAR; }
    PG8_BAR;
    if constexpr (Epi::AFTER_DRAIN) { E.fused(acc, cur, wr, wc, fr, fq, lds, wid, lane); S.done(cur); }
#undef PG8_SA
#undef PG8_SB
#undef PG8_STAGE
#undef PG8_LDA
#undef PG8_LDB
#undef PG8_MMA
#undef PG8_WAIT_V
#undef PG8_WAIT_L
#undef PG8_BAR
#undef PG8_SCHED
}
}
typedef unsigned short bf16_t;
typedef unsigned u32x4 __attribute__((ext_vector_type(4)));
typedef float f32x4 __attribute__((ext_vector_type(4)));

struct Params {
    const float *x, *w_in, *gla_wd, *gla_bd, *gla_ng, *w_out, *ln1_g, *ln1_b, *w_q, *sub_keys, *pu, *pv, *ln2_g, *ln2_b;
    float* out;
    char* ws;
#define WSP(T, name, off_bytes) __host__ __device__ __forceinline__ T* name() const { return (T*)(ws + (size_t)(off_bytes)); }
    WSP(bf16_t, winT, 0)
    WSP(bf16_t, woutT, 16u << 20)
    WSP(bf16_t, wqT, 18u << 20)
    WSP(float, rope_cos, 22u << 20)
    WSP(float, rope_sin, (22u << 20) + 131072)
    WSP(float, kmean, (22u << 20) + 262144)
    WSP(bf16_t, y, 23u << 20)
    WSP(bf16_t, x1b, 23u << 20)
    WSP(bf16_t, xbc, 87u << 20)
    WSP(float, g, 119u << 20)
    WSP(bf16_t, qa, 151u << 20)
    WSP(bf16_t, ka, 167u << 20)
    WSP(bf16_t, va, 183u << 20)
    WSP(bf16_t, ra, 215u << 20)
    WSP(bf16_t, ga, 247u << 20)
    WSP(bf16_t, gb, 279u << 20)
    WSP(bf16_t, qb, 311u << 20)
    WSP(bf16_t, kb, 343u << 20)
    WSP(bf16_t, vb, 375u << 20)
    WSP(float, x1, 87u << 20)
    WSP(bf16_t, qry, 215u << 20)
    WSP(int, sel_e, 471u << 20)
    WSP(float, sel_g, 487u << 20)
    WSP(unsigned char, u8, 343u << 20)
    WSP(unsigned char, v8, 359u << 20)
    WSP(bf16_t, part, 87u << 20)
    WSP(bf16_t, h2, 87u << 20)
    WSP(unsigned, qctr, (22u << 20) + 524288)
    WSP(bf16_t, oi, 407u << 20)
    WSP(bf16_t, oe, 439u << 20)
    WSP(float, dl, 471u << 20)
#undef WSP
};

__device__ __forceinline__ unsigned pack_bf16(float lo, float hi) { unsigned r; asm("v_cvt_pk_bf16_f32 %0, %1, %2" : "=v"(r) : "v"(lo), "v"(hi)); return r; }
__device__ __forceinline__ bf16_t f2bf(float f) { return (bf16_t)(pack_bf16(f, f) & 0xffffu); }
__device__ __forceinline__ float bf2f(bf16_t h) { return __uint_as_float((unsigned)h << 16); }

__device__ __forceinline__ float wave_sum(float v) {
#define WS_DPP(ctrl, rmask) v += __int_as_float(__builtin_amdgcn_update_dpp(0, __float_as_int(v), ctrl, rmask, 0xf, true))
    WS_DPP(0xB1, 0xf);
    WS_DPP(0x4E, 0xf);
    WS_DPP(0x141, 0xf);
    WS_DPP(0x140, 0xf);
    WS_DPP(0x142, 0xa);
    WS_DPP(0x143, 0xc);
#undef WS_DPP
    return __int_as_float(__builtin_amdgcn_readlane(__float_as_int(v), 63));
}
__device__ __forceinline__ float block_sum(float v, float* red, int tid) {
    v = wave_sum(v);
    __syncthreads();
    if ((tid & 63) == 0) red[tid >> 6] = v;
    __syncthreads();
    return red[0] + red[1] + red[2] + red[3];
}

struct EpiF32 {
    static constexpr bool PERM = false, AFTER_DRAIN = false;
    float* C; int ldc;
    __device__ __forceinline__ void operator()(const f32x4 (&acc)[2][2][4][2], const pg8::Unit& u, int wr, int wc, int fr, int fq) const {
        const int row0 = u.pm * 256 + wr * 64 + fr, col0 = u.pn * 256 + wc * 32 + 4 * fq;
#pragma unroll
        for (int ai = 0; ai < 2; ++ai)
#pragma unroll
            for (int m = 0; m < 4; ++m) { float* rowp = C + (size_t)(row0 + ai * 128 + m * 16) * ldc + col0;
#pragma unroll
                for (int bj = 0; bj < 2; ++bj)
#pragma unroll
                    for (int n = 0; n < 2; ++n) *(f32x4*)(rowp + bj * 128 + n * 16) = acc[ai][bj][m][n]; }
    }
};
struct EpiBf16 {
    static constexpr bool PERM = true, AFTER_DRAIN = false;
    bf16_t* O; int ldc;
    __device__ __forceinline__ void operator()(const f32x4 (&acc)[2][2][4][2], const pg8::Unit& u, int wr, int wc, int fr, int fq) const {
        const int row0 = u.pm * 256 + wr * 64 + fr, col0 = u.pn * 256 + wc * 32 + 8 * fq;
#pragma unroll
        for (int ai = 0; ai < 2; ++ai)
#pragma unroll
            for (int m = 0; m < 4; ++m) { bf16_t* rowp = O + (size_t)(row0 + ai * 128 + m * 16) * ldc + col0;
#pragma unroll
                for (int bj = 0; bj < 2; ++bj) { const f32x4 v0 = acc[ai][bj][m][0], v1 = acc[ai][bj][m][1];
                    u32x4 w; w.x = pg8::cvt_pk_bf16(v0[0], v0[1]); w.y = pg8::cvt_pk_bf16(v0[2], v0[3]); w.z = pg8::cvt_pk_bf16(v1[0], v1[1]); w.w = pg8::cvt_pk_bf16(v1[2], v1[3]);
                    __builtin_nontemporal_store(w, (u32x4*)(rowp + bj * 128)); } }
    }
};
struct EpiResid {
    static constexpr bool PERM = false, AFTER_DRAIN = false;
    float* C; const float* X;
    __device__ __forceinline__ void operator()(const f32x4 (&acc)[2][2][4][2], const pg8::Unit& u, int wr, int wc, int fr, int fq) const {
        const int row0 = u.pm * 256 + wr * 64 + fr, col0 = u.pn * 256 + wc * 32 + 4 * fq;
#pragma unroll
        for (int ai = 0; ai < 2; ++ai)
#pragma unroll
            for (int m = 0; m < 4; ++m) { const size_t ro = (size_t)(row0 + ai * 128 + m * 16) * 1024 + col0;
#pragma unroll
                for (int bj = 0; bj < 2; ++bj)
#pragma unroll
                    for (int n = 0; n < 2; ++n) { const f32x4 xv = *(const f32x4*)(X + ro + bj * 128 + n * 16);
                        __builtin_nontemporal_store(acc[ai][bj][m][n] + xv * DN_ALPHA, (f32x4*)(C + ro + bj * 128 + n * 16)); } }
    }
};
struct InProjPtrs { char* pc; float *kmean; const float *rope_cos, *rope_sin; };
struct EpiInProj {
    static constexpr bool PERM = true, AFTER_DRAIN = false;
    InProjPtrs p;
    __device__ __forceinline__ void operator()(const f32x4 (&acc)[2][2][4][2], const pg8::Unit& u, int wr, int wc, int fr, int fq) const {
        const int pn = u.pn;
        const int row0 = u.pm * 256 + wr * 64 + fr;
        const int cin = wc * 32 + 8 * fq;
        if (pn >= 12 && pn < 24) {
            const int which = (pn - 12) >> 2;
            bf16_t* T = (bf16_t*)(p.pc + ((size_t)(160 + 32 * which) << 20));
            const int seq = u.pm >> 3, t0 = (u.pm & 7) * 256 + wr * 64 + fr;
            const bool rope = (which < 2) && (wc == 0);
            float ksum[2][8];
#pragma unroll
            for (int bj = 0; bj < 2; ++bj)
#pragma unroll
                for (int e = 0; e < 8; ++e) ksum[bj][e] = 0.f;
#pragma unroll
            for (int ai = 0; ai < 2; ++ai)
#pragma unroll
                for (int m = 0; m < 4; ++m) {
                    int t = t0 + ai * 128 + m * 16;
                    asm volatile("" : "+v"(t) :: "memory");
                    f32x4 c0 = {1.f, 1.f, 1.f, 1.f}, c1 = c0, s0 = {0.f, 0.f, 0.f, 0.f}, s1 = s0;
                    if (rope) {
                        const float* cp = p.rope_cos + t * 16 + 8 * (fq & 1);
                        const float* sp = p.rope_sin + t * 16 + 8 * (fq & 1);
                        c0 = *(const f32x4*)cp; c1 = *(const f32x4*)(cp + 4); s0 = *(const f32x4*)sp; s1 = *(const f32x4*)(sp + 4);
                        if (fq < 2) { s0 = -s0; s1 = -s1; }
                    }
#pragma unroll
                    for (int bj = 0; bj < 2; ++bj) {
                        f32x4 v0 = acc[ai][bj][m][0], v1 = acc[ai][bj][m][1];
                        if (rope) {
                            f32x4 o0, o1;
#pragma unroll
                            for (int j = 0; j < 4; ++j) {
                                const auto r0 = __builtin_amdgcn_permlane32_swap(__float_as_uint(v0[j]), __float_as_uint(v0[j]), false, false);
                                const auto r1 = __builtin_amdgcn_permlane32_swap(__float_as_uint(v1[j]), __float_as_uint(v1[j]), false, false);
                                o0[j] = __uint_as_float(fq < 2 ? r0[1] : r0[0]); o1[j] = __uint_as_float(fq < 2 ? r1[1] : r1[0]);
                            }
                            v0 = v0 * c0 + o0 * s0; v1 = v1 * c1 + o1 * s1;
                        }
                        if (which == 1) {
#pragma unroll
                            for (int j = 0; j < 4; ++j) { ksum[bj][j] += v0[j]; ksum[bj][4 + j] += v1[j]; }
                        }
                        const int head = ((pn - 12) & 3) * 2 + bj;
                        u32x4 w; w.x = pg8::cvt_pk_bf16(v0[0], v0[1]); w.y = pg8::cvt_pk_bf16(v0[2], v0[3]); w.z = pg8::cvt_pk_bf16(v1[0], v1[1]); w.w = pg8::cvt_pk_bf16(v1[2], v1[3]);
                        __builtin_nontemporal_store(w, (u32x4*)(T + ((size_t)(seq * 8 + head) * SEQ + t) * 128 + cin));
                    }
                }
            if (which == 1) {
#pragma unroll
                for (int bj = 0; bj < 2; ++bj)
#pragma unroll
                    for (int e = 0; e < 8; ++e) {
                        float s = ksum[bj][e];
                        s += __int_as_float(__builtin_amdgcn_update_dpp(0, __float_as_int(s), 0xB1, 0xf, 0xf, true));
                        s += __int_as_float(__builtin_amdgcn_update_dpp(0, __float_as_int(s), 0x4E, 0xf, 0xf, true));
                        s += __int_as_float(__builtin_amdgcn_update_dpp(0, __float_as_int(s), 0x141, 0xf, 0xf, true));
                        s += __int_as_float(__builtin_amdgcn_update_dpp(0, __float_as_int(s), 0x140, 0xf, 0xf, true));
                        if (fr == 0) {
                            const int head = ((pn - 12) & 3) * 2 + bj;
                            atomicAdd(p.kmean + ((size_t)((u.pm >> 3) * 8 + head) * 8 + (u.pm & 7)) * 128 + cin + e, s * (1.0f / 256.0f));
                        }
                    }
            }
            return;
        }
        int ld, cbase, mode, offm;
        if (pn < 4) { ld = 512; cbase = (pn & 1) * 256; offm = (pn >> 1) * 16; mode = (pn < 2) ? 1 : 0; }
        else { ld = 1024; cbase = (pn & 3) * 256; const int idx = (pn < 12) ? ((pn - 4) >> 2) : (((pn - 24) >> 2) + 2); offm = 32 + 32 * idx; mode = (idx == 0) ? 0 : (idx == 1 ? 2 : 3); }
        bf16_t* T = (bf16_t*)(p.pc + ((size_t)offm << 20));
#pragma unroll
        for (int ai = 0; ai < 2; ++ai)
#pragma unroll
            for (int m = 0; m < 4; ++m) {
                bf16_t* rowp = T + (size_t)(row0 + ai * 128 + m * 16) * ld + cbase + cin;
#pragma unroll
                for (int bj = 0; bj < 2; ++bj) {
                    f32x4 v0 = acc[ai][bj][m][0], v1 = acc[ai][bj][m][1];
                    if (mode == 1) { v0 = v0 * 0.08838834764831845f; v1 = v1 * 0.08838834764831845f; }
                    else if (mode >= 2) {
#pragma unroll
                        for (int j = 0; j < 4; ++j) {
                            const float g0 = __builtin_amdgcn_rcpf(1.0f + __expf(-v0[j])), g1 = __builtin_amdgcn_rcpf(1.0f + __expf(-v1[j]));
                            v0[j] = (mode == 2) ? v0[j] * g0 : g0; v1[j] = (mode == 2) ? v1[j] * g1 : g1;
                        }
                    }
                    u32x4 w; w.x = pg8::cvt_pk_bf16(v0[0], v0[1]); w.y = pg8::cvt_pk_bf16(v0[2], v0[3]); w.z = pg8::cvt_pk_bf16(v1[0], v1[1]); w.w = pg8::cvt_pk_bf16(v1[2], v1[3]);
                    __builtin_nontemporal_store(w, (u32x4*)(rowp + bj * 128));
                }
            }
    }
};

__device__ __forceinline__ void transpose_tile(const float* __restrict__ src, int ld, bf16_t* __restrict__ dst, int gap_at, int gap, int tk, int tn, float* smem, int tid) {
    const int k0 = tk * 64, n0 = tn * 64;
    int c0 = n0; if (c0 >= gap_at) c0 += gap;
    {
        const int r = tid >> 3, cq = (tid & 7) * 8;
        const float4 a = *(const float4*)(src + (size_t)(k0 + r) * ld + c0 + cq);
        const float4 b = *(const float4*)(src + (size_t)(k0 + r) * ld + c0 + cq + 4);
        float* d = smem + r * 65 + cq;
        d[0] = a.x; d[1] = a.y; d[2] = a.z; d[3] = a.w; d[4] = b.x; d[5] = b.y; d[6] = b.z; d[7] = b.w;
    }
    __syncthreads();
    {
        const int n = tid >> 3, kq = (tid & 7) * 8;
        unsigned w[4];
#pragma unroll
        for (int j = 0; j < 4; ++j) w[j] = pack_bf16(smem[(kq + 2 * j) * 65 + n], smem[(kq + 2 * j + 1) * 65 + n]);
        *(u32x4*)(dst + (size_t)(n0 + n) * 1024 + k0 + kq) = (u32x4){w[0], w[1], w[2], w[3]};
    }
    __syncthreads();
}

__device__ __forceinline__ void phase_xconv(const Params& p, int chunk, float* smem, const int t) {
    const int wave = t >> 6, lane = t & 63;
    float* wlr = smem;
    float* wd = smem + 16 * 1024;
#pragma unroll 1
    for (int i = t; i < 16 * 1024; i += NTHREADS) { const int k = i >> 4, r = i & 15; wlr[r * 1024 + k] = p.w_in[(size_t)k * IN_WIDTH + OFF_LR + r]; }
#pragma unroll 1
    for (int i = t; i < 16 * 512; i += NTHREADS) wd[i] = p.gla_wd[i];
    __syncthreads();
    f32x4 bd0 = *(const f32x4*)(p.gla_bd + lane * 8), bd1 = *(const f32x4*)(p.gla_bd + lane * 8 + 4);
#pragma unroll 1
    for (int tl = blockIdx.x * 8 + wave; tl < CT; tl += gridDim.x * 8) {
        const float* xr = p.x + ((size_t)chunk * CT + tl) * 1024;
        f32x4 xv[4];
#pragma unroll
        for (int j = 0; j < 4; ++j) xv[j] = *(const f32x4*)(xr + j * 256 + lane * 4);
#pragma unroll
        for (int j = 0; j < 4; ++j) {
            uint2 w; w.x = pack_bf16(xv[j][0], xv[j][1]); w.y = pack_bf16(xv[j][2], xv[j][3]);
            *(uint2*)(p.xbc() + (size_t)tl * 1024 + j * 256 + lane * 4) = w;
        }
        f32x4 z0 = bd0, z1 = bd1;
#pragma unroll 1
        for (int r = 0; r < 16; ++r) {
            float d = 0.f;
#pragma unroll
            for (int j = 0; j < 4; ++j) { const f32x4 wv = *(const f32x4*)(wlr + r * 1024 + j * 256 + lane * 4); d += (wv[0] * xv[j][0] + wv[1] * xv[j][1]) + (wv[2] * xv[j][2] + wv[3] * xv[j][3]); }
            const float lr = wave_sum(d);
            const f32x4 w0 = *(const f32x4*)(wd + r * 512 + lane * 8), w1 = *(const f32x4*)(wd + r * 512 + lane * 8 + 4);
            z0 += w0 * lr; z1 += w1 * lr;
        }
        f32x4 g0, g1;
#pragma unroll
        for (int j = 0; j < 4; ++j) {
            g0[j] = (fminf(z0[j], 0.f) - __logf(1.0f + __expf(-fabsf(z0[j])))) * (1.0f / 16.0f);
            g1[j] = (fminf(z1[j], 0.f) - __logf(1.0f + __expf(-fabsf(z1[j])))) * (1.0f / 16.0f);
        }
        *(f32x4*)(p.g() + (size_t)tl * 512 + lane * 8) = g0;
        *(f32x4*)(p.g() + (size_t)tl * 512 + lane * 8 + 4) = g1;
    }
    __syncthreads();
}

namespace moba {
constexpr int D = 128;
constexpr float THR = 8.f;
constexpr bool WSKIP = false;
constexpr float SCALE = 0.08838834764831845f;
constexpr int NW = 8, QBLK = 32, KVBLK = 64, QB = NW * QBLK;
constexpr int SHM_V = KVBLK * D * 2, SHM_K = KVBLK * D * 2;
constexpr int LDS_ATTN = 2 * SHM_V + 2 * SHM_K + NW * 64 * 4;
typedef short bf16x8 __attribute__((ext_vector_type(8)));
typedef short s16x4 __attribute__((ext_vector_type(4)));
typedef float f32x16 __attribute__((ext_vector_type(16)));
template <class A, class Bt> struct same_t { static constexpr bool v = false; };
template <class A> struct same_t<A, A> { static constexpr bool v = true; };
#define KSWZ(row, colB) ((row) * 256 + ((colB) ^ (((row) & 7) << 4)))
#define SBAR() __builtin_amdgcn_sched_barrier(0)
__device__ __forceinline__ int v_st(int k, int c) { const int kk = (k & ~0xC) | ((k & 4) << 1) | ((k & 8) >> 1); return ((kk >> 3) * 4 + (c >> 5)) * 512 + ((kk & 7) * 32 + (c & 31)) * 2; }
__device__ __forceinline__ int v_rd_base(int lane) { return ((lane & 3) << 3) | (((lane >> 2) & 3) << 6) | (((lane >> 4) & 1) << 5) | (((lane >> 5) & 1) << 8); }
constexpr int v_rd_off(int d0, int ks, int half) { return d0 * 512 + ks * 4096 + half * 2048; }
__device__ __forceinline__ int crow(int r, int hi) { return (r & 3) + 8 * (r >> 2) + 4 * hi; }
__device__ __forceinline__ unsigned cvtpk(float lo, float hi) {
    unsigned r; asm volatile("v_cvt_pk_bf16_f32 %0, %1, %2" : "=v"(r) : "v"(lo), "v"(hi)); return r;
}
__device__ __forceinline__ bf16x8 pack8(f32x4 a, f32x4 b) {
    u32x4 w = {cvtpk(a[0], a[1]), cvtpk(a[2], a[3]), cvtpk(b[0], b[1]), cvtpk(b[2], b[3])};
    return *reinterpret_cast<bf16x8*>(&w);
}
template <class T> __device__ __forceinline__ bf16x8 load8(const T* p) {
    if constexpr (same_t<T, float>::v) { return pack8(*(const f32x4*)p, *(const f32x4*)(p + 4)); }
    else { return *reinterpret_cast<const bf16x8*>(p); }
}
__device__ __forceinline__ void mask_tile(f32x16& p0, f32x16& p1, int dq, unsigned W) {
    const float NEG = -__builtin_inff();
#pragma unroll
    for (int r = 0; r < 16; ++r) {
        const int c = (r & 3) + 8 * (r >> 2);
        if ((unsigned)(dq - c) >= W) p0[r] = NEG;
        if ((unsigned)(dq - c - 32) >= W) p1[r] = NEG;
    }
}
__device__ __forceinline__ void partialSM(f32x16& p0, f32x16& p1, float& m_reg, float& mn, float& alpha) {
    float pmax = p0[0]; for (int r = 1; r < 16; ++r) pmax = fmaxf(pmax, p0[r]); for (int r = 0; r < 16; ++r) pmax = fmaxf(pmax, p1[r]);
    { auto rr = __builtin_amdgcn_permlane32_swap(__float_as_uint(pmax), __float_as_uint(pmax), false, false);
      pmax = fmaxf(__uint_as_float(rr[0]), __uint_as_float(rr[1])); }
    constexpr float C2 = 1.4426950408889634f * SCALE;
    if (__builtin_expect(__all((pmax - m_reg) * SCALE <= THR), 1)) { mn = m_reg; alpha = 1.f; }
    else { mn = fmaxf(m_reg, pmax); alpha = __builtin_amdgcn_exp2f((m_reg - mn) * C2); m_reg = mn; }
    const float mnL = -mn * C2;
    for (int r = 0; r < 16; ++r) p0[r] = fmaf(p0[r], C2, mnL); for (int r = 0; r < 16; ++r) p1[r] = fmaf(p1[r], C2, mnL);
    for (int r = 0; r < 16; ++r) p0[r] = __builtin_amdgcn_exp2f(p0[r]);
}
__device__ __forceinline__ void finishSM(f32x16& p0, f32x16& p1, float alpha, float& l_reg, bf16x8& pa0, bf16x8& pa1, bf16x8& pa2, bf16x8& pa3) {
    for (int r = 0; r < 16; ++r) p1[r] = __builtin_amdgcn_exp2f(p1[r]);
    float ps = 0; for (int r = 0; r < 16; ++r) ps += p0[r]; for (int r = 0; r < 16; ++r) ps += p1[r];
    { auto rr = __builtin_amdgcn_permlane32_swap(__float_as_uint(ps), __float_as_uint(ps), false, false);
      ps = __uint_as_float(rr[0]) + __uint_as_float(rr[1]); }
    l_reg = l_reg * alpha + ps;
#define PK4(P, B_, OUT) do { unsigned a0 = cvtpk(P[B_+0], P[B_+1]), a1 = cvtpk(P[B_+2], P[B_+3]);                          \
        unsigned b0 = cvtpk(P[B_+4], P[B_+5]), b1 = cvtpk(P[B_+6], P[B_+7]);                                             \
        auto r0 = __builtin_amdgcn_permlane32_swap(a0, b0, false, false); auto r1 = __builtin_amdgcn_permlane32_swap(a1, b1, false, false); \
        u32x4 w = {r0[0], r1[0], r0[1], r1[1]}; OUT = *reinterpret_cast<bf16x8*>(&w); } while (0)
    PK4(p0, 0, pa0); PK4(p0, 8, pa1); PK4(p1, 0, pa2); PK4(p1, 8, pa3);
#undef PK4
}
template <int KB, bool SK>
__device__ __forceinline__ void qkt(f32x16& p0, f32x16& p1, const char* K_lds, int r32, int hi, const bf16x8* qr, bool act) {
    if (SK && !act) { const float NEG = -__builtin_inff();
#pragma unroll
        for (int r = 0; r < 16; ++r) { p0[r] = NEG; p1[r] = NEG; } return; }
    p0 = f32x16{}; p1 = f32x16{};
    const char* kb[4];
#pragma unroll
    for (int dd = 0; dd < 4; ++dd) kb[dd] = K_lds + KB * SHM_K + KSWZ(r32, (dd * 16 + hi * 8) * 2);
#pragma unroll
    for (int d0 = 0; d0 < 8; ++d0) { const char* a = kb[d0 & 3] + (d0 >> 2) * 128;
        bf16x8 b0 = *reinterpret_cast<const bf16x8*>(a);
        bf16x8 b1 = *reinterpret_cast<const bf16x8*>(a + 32 * 256);
        p0 = __builtin_amdgcn_mfma_f32_32x32x16_bf16(b0, qr[d0], p0, 0, 0, 0);
        p1 = __builtin_amdgcn_mfma_f32_32x32x16_bf16(b1, qr[d0], p1, 0, 0, 0); }
}
template <int VB, bool SK>
__device__ __forceinline__ void pv_tile(f32x16* o, int vb0, bf16x8 pa0, bf16x8 pa1, bf16x8 pa2, bf16x8 pa3, bool act) {
    if (SK && !act) return;
#define TRRD(dst, off) asm volatile("ds_read_b64_tr_b16 %0, %1 offset:%2" : "=&v"(dst) : "v"(vb0), "i"(off) : "memory")
#define PV_D0(d0) do { s16x4 l0, l1, l2, l3, h0, h1, h2, h3; constexpr int b_ = VB * SHM_V + v_rd_off(d0, 0, 0);     \
        TRRD(l0, b_); TRRD(h0, b_ + 2048); TRRD(l1, b_ + 4096); TRRD(h1, b_ + 6144); TRRD(l2, b_ + 8192); TRRD(h2, b_ + 10240); TRRD(l3, b_ + 12288); TRRD(h3, b_ + 14336); \
        asm volatile("s_waitcnt lgkmcnt(0)" ::: "memory"); SBAR();                 \
        o[d0] = __builtin_amdgcn_mfma_f32_32x32x16_bf16(pa0, (bf16x8){l0[0], l0[1], l0[2], l0[3], h0[0], h0[1], h0[2], h0[3]}, o[d0], 0, 0, 0);   \
        o[d0] = __builtin_amdgcn_mfma_f32_32x32x16_bf16(pa1, (bf16x8){l1[0], l1[1], l1[2], l1[3], h1[0], h1[1], h1[2], h1[3]}, o[d0], 0, 0, 0);   \
        o[d0] = __builtin_amdgcn_mfma_f32_32x32x16_bf16(pa2, (bf16x8){l2[0], l2[1], l2[2], l2[3], h2[0], h2[1], h2[2], h2[3]}, o[d0], 0, 0, 0);   \
        o[d0] = __builtin_amdgcn_mfma_f32_32x32x16_bf16(pa3, (bf16x8){l3[0], l3[1], l3[2], l3[3], h3[0], h3[1], h3[2], h3[3]}, o[d0], 0, 0, 0); } while (0)
    PV_D0(0); PV_D0(1); PV_D0(2); PV_D0(3);
#undef PV_D0
#undef TRRD
}

template <class TIn, class TOut> struct BlockRef { const TIn* Q; const TIn* K; const TIn* V; TOut* O; int P0; };
template <class TIn> struct Seam {
    bf16x8 qr[8];
    bf16x8 st_v0, st_v1, st_k0, st_k1; f32x4 sf0, sf1, sf2, sf3;
    f32x4 tq[16];
};
__device__ __forceinline__ int swa_jlo(int P0, int W) { const int lowk = P0 - W + 1; return lowk > 0 ? lowk / KVBLK : 0; }
#define ROW(p, k0, rr) ((p) + (size_t)((k0) + (rr)) * D + sc)
#define VMW() asm volatile("s_waitcnt vmcnt(0)" ::: "memory")
#define VMWN(n) asm volatile("s_waitcnt vmcnt(%0)" :: "i"(n) : "memory")
#define SLOAD_H(Kp, Vp, k0) do { S.st_v0 = load8<TIn>(ROW(Vp, k0, sr)); S.st_v1 = load8<TIn>(ROW(Vp, k0, 32 + sr));              \
                         S.st_k0 = load8<TIn>(ROW(Kp, k0, sr)); S.st_k1 = load8<TIn>(ROW(Kp, k0, 32 + sr)); } while (0)
#define SWRITE_HK(bf) do { *(bf16x8*)(K_lds + (bf) * SHM_K + kws) = S.st_k0; *(bf16x8*)(K_lds + (bf) * SHM_K + kws + 32 * 256) = S.st_k1; } while (0)
#define SWRITE_HV(bf) do { *(bf16x8*)(V_lds + (bf) * SHM_V + vst0) = S.st_v0; *(bf16x8*)(V_lds + (bf) * SHM_V + vst1) = S.st_v1; } while (0)
#define SWRITE_H(bf) do { SWRITE_HV(bf); SWRITE_HK(bf); } while (0)
#define SLOAD_F(p, k0) do { S.sf0 = *(const f32x4*)ROW(p, k0, sr); S.sf1 = *(const f32x4*)(ROW(p, k0, sr) + 4);                \
                            S.sf2 = *(const f32x4*)ROW(p, k0, 32 + sr); S.sf3 = *(const f32x4*)(ROW(p, k0, 32 + sr) + 4); } while (0)
#define SWRITE_KF(bf) do { *(bf16x8*)(K_lds + (bf) * SHM_K + kws) = pack8(S.sf0, S.sf1); *(bf16x8*)(K_lds + (bf) * SHM_K + kws + 32 * 256) = pack8(S.sf2, S.sf3); } while (0)
#define SWRITE_VF(bf) do { *(bf16x8*)(V_lds + (bf) * SHM_V + vst0) = pack8(S.sf0, S.sf1); *(bf16x8*)(V_lds + (bf) * SHM_V + vst1) = pack8(S.sf2, S.sf3); } while (0)
template <class TIn, class TOut>
__device__ __forceinline__ void causal_swa_prime(const BlockRef<TIn, TOut>& cur, int W, char* lds, Seam<TIn>& S, const int tid) {
    constexpr bool F32 = same_t<TIn, float>::v;
    const int wid = __builtin_amdgcn_readfirstlane(tid >> 6), lane = tid & 63, r32 = lane & 31, hi = lane >> 5;
    const int sr = tid >> 4, sc = (tid & 15) * 8, kws = KSWZ(sr, sc * 2); char* K_lds = lds + 2 * SHM_V;
    const int kb0 = swa_jlo(cur.P0, W) * KVBLK;
    for (int d0 = 0; d0 < 8; ++d0) S.qr[d0] = load8<TIn>(cur.Q + (size_t)(wid * QBLK + r32) * D + d0 * 16 + hi * 8);
    if constexpr (F32) { SLOAD_F((const float*)cur.K, kb0); VMW(); SWRITE_KF(0); SBAR(); SLOAD_F((const float*)cur.V, kb0); }
    else { SLOAD_H(cur.K, cur.V, kb0); VMW(); SWRITE_HK(0); }
    __syncthreads();
}
template <class TIn, class TOut>
__device__ __forceinline__ void causal_swa_block(const BlockRef<TIn, TOut>& cur, const BlockRef<TIn, TOut>& nxt, int skv, int W, char* lds, Seam<TIn>& S, const int tid, const unsigned selmask) {
    constexpr bool F32 = same_t<TIn, float>::v;
    const int wid = __builtin_amdgcn_readfirstlane(tid >> 6), lane = tid & 63, r32 = lane & 31, hi = lane >> 5;
    const int j_lo = swa_jlo(cur.P0, W);
    int j_hi = (cur.P0 + QB - 1) / KVBLK + 1; if (j_hi > skv / KVBLK) j_hi = skv / KVBLK;
    const int NT = j_hi - j_lo;
    const int kbn = swa_jlo(nxt.P0, W) * KVBLK;
    const int qlo = cur.P0 + wid * QBLK, qm = qlo + r32 - 4 * hi;
    char* V_lds = lds; char* K_lds = lds + 2 * SHM_V;
    float* ws = (float*)(lds + 2 * SHM_V + 2 * SHM_K) + wid * 64; float* li_l = ws, * al_l = ws + 32;
    float m_reg = -1e30f, l_reg = 0; f32x16 o[4] = {};
    const int sr = tid >> 4, sc = (tid & 15) * 8, vst0 = v_st(sr, sc), vst1 = v_st(32 + sr, sc), kws = KSWZ(sr, sc * 2);
    const int vb0 = (int)(uintptr_t)V_lds + v_rd_base(lane);
    const TIn* Kh = cur.K; const TIn* Vh = cur.V;
    const int qb = cur.P0 >> 8;
#define RESC(a) do { if (__any((a) < 1.f)) { if (hi == 0) al_l[r32] = (a); asm volatile("s_waitcnt lgkmcnt(0)" ::: "memory");              \
                     for (int d_ = 0; d_ < 4; ++d_) for (int r = 0; r < 16; ++r) o[d_][r] *= al_l[crow(r, hi)]; } } while (0)
#define KBASE(t) ((j_lo + (t)) * KVBLK)
#define ACT(t) (KBASE(t) <= qlo + QBLK - 1 && KBASE(t) + KVBLK - 1 >= qlo - W + 1)
#define MASKT(P0_, P1_, t) do { const int kb_ = KBASE(t); if (kb_ + KVBLK - 1 > qlo) mask_tile(P0_, P1_, qm - kb_, (unsigned)W);                  \
        else if (qb >= 4 && kb_ < cur.P0) { const bool keep_ = (selmask >> (kb_ >> 8)) & 1u; const float NEG_ = -__builtin_inff();          \
            _Pragma("unroll") for (int r_ = 0; r_ < 16; ++r_) { P0_[r_] = keep_ ? P0_[r_] : NEG_; P1_[r_] = keep_ ? P1_[r_] : NEG_; } } } while (0)
    constexpr int NQL = F32 ? 16 : 8;
    constexpr bool SK = WSKIP && !F32;
#define SEAM_K0() do { VMWN(NQL); if constexpr (F32) { SWRITE_KF(0); SBAR(); SLOAD_F((const float*)nxt.V, kbn); } else { SWRITE_HK(0); } SBAR(); } while (0)
    f32x16 pA0, pA1, pB0, pB1; float mnA, mnB, alA, alB; bf16x8 pa0, pa1, pa2, pa3;
    if constexpr (F32) { VMW(); SWRITE_VF(0); SBAR(); } else { SWRITE_HV(0); SBAR(); }
    if (NT > 1) { if constexpr (F32) SLOAD_F((const float*)Kh, KBASE(1)); else SLOAD_H(Kh, Vh, KBASE(1)); }
    SBAR(); qkt<0, SK>(pA0, pA1, K_lds, r32, hi, S.qr, ACT(0));
    if constexpr (F32) { if (NT > 1) { VMW(); SWRITE_KF(1); SBAR(); SLOAD_F((const float*)Vh, KBASE(1)); } }
    MASKT(pA0, pA1, 0); partialSM(pA0, pA1, m_reg, mnA, alA);
    if (NT > 1) { VMW(); if constexpr (F32) { SWRITE_VF(1); SBAR(); if (NT > 2) SLOAD_F((const float*)Kh, KBASE(2)); } else SWRITE_H(1); }
    __syncthreads();
#define HALF_STEP(PX0, PX1, mnX, alX, PY0, PY1, alY, t, KB, VB, SB) do {                                                      \
        SBAR(); qkt<KB, SK>(PX0, PX1, K_lds, r32, hi, S.qr, ACT(t));                                             \
        finishSM(PY0, PY1, alY, l_reg, pa0, pa1, pa2, pa3); SBAR();                                                           \
        if ((t) + 1 < NT) { if constexpr (F32) { VMW(); SWRITE_KF(SB); SBAR(); SLOAD_F((const float*)Vh, KBASE((t) + 1)); }  \
                            else { SLOAD_H(Kh, Vh, KBASE((t) + 1)); } SBAR(); }                                               \
        pv_tile<VB, SK>(o, vb0, pa0, pa1, pa2, pa3, ACT((t) - 1)); MASKT(PX0, PX1, (t)); partialSM(PX0, PX1, m_reg, mnX, alX);                                        \
        __syncthreads();                                                                                                      \
        if ((t) + 1 < NT) { VMW(); if constexpr (F32) { SWRITE_VF(SB); SBAR(); if ((t) + 2 < NT) SLOAD_F((const float*)Kh, KBASE((t) + 2)); } \
                            else { SWRITE_H(SB); } }                                                                          \
        RESC(alX); __syncthreads(); } while (0)
    for (int t = 1; t + 1 < NT; t += 2) {
        HALF_STEP(pB0, pB1, mnB, alB, pA0, pA1, alA, t, 1, 0, 0);
        HALF_STEP(pA0, pA1, mnA, alA, pB0, pB1, alB, t + 1, 0, 1, 1);
    }
    const bool even = (NT & 1) == 0;
    if (even) { SBAR(); qkt<1, SK>(pB0, pB1, K_lds, r32, hi, S.qr, ACT(NT - 1)); SBAR(); }
#define QROW(e) (nxt.Q + (size_t)(wid * QBLK + r32) * D + ((e) >> 1) * 16 + hi * 8 + ((e) & 1) * 4)
    if constexpr (F32) { SLOAD_F((const float*)nxt.K, kbn); SBAR();
#pragma unroll
        for (int e = 0; e < 8; ++e) S.tq[e] = *(const f32x4*)QROW(e); }
    else { SLOAD_H(nxt.K, nxt.V, kbn); SBAR();
#pragma unroll
        for (int d0 = 0; d0 < 8; ++d0) S.qr[d0] = load8<TIn>(nxt.Q + (size_t)(wid * QBLK + r32) * D + d0 * 16 + hi * 8); }
    SBAR();
    finishSM(pA0, pA1, alA, l_reg, pa0, pa1, pa2, pa3); SBAR();
    if constexpr (F32) {
#pragma unroll
        for (int e = 8; e < 16; ++e) S.tq[e] = *(const f32x4*)QROW(e); SBAR(); }
#undef QROW
    pv_tile<0, SK>(o, vb0, pa0, pa1, pa2, pa3, ACT(even ? NT - 2 : NT - 1));
    if (even) { MASKT(pB0, pB1, NT - 1); partialSM(pB0, pB1, m_reg, mnB, alB); __syncthreads(); RESC(alB);
        finishSM(pB0, pB1, alB, l_reg, pa0, pa1, pa2, pa3); SBAR(); pv_tile<1, SK>(o, vb0, pa0, pa1, pa2, pa3, ACT(NT - 1)); }
    SBAR(); SEAM_K0();
    if (hi == 0) li_l[r32] = l_reg; asm volatile("s_waitcnt lgkmcnt(0)" ::: "memory");
    float rli[16];
#pragma unroll
    for (int r = 0; r < 16; ++r) rli[r] = __builtin_amdgcn_rcpf(li_l[crow(r, hi)]);
    TOut* Ow = cur.O + (size_t)(wid * QBLK) * D;
#pragma unroll
    for (int r = 0; r < 16; ++r) { const int orow = crow(r, hi);
#pragma unroll
        for (int d0 = 0; d0 < 4; ++d0) { const float v = o[d0][r] * rli[r];
            if constexpr (same_t<TOut, float>::v) { Ow[(size_t)orow * D + d0 * 32 + r32] = v; }
            else { const float vn = __int_as_float(__builtin_amdgcn_update_dpp(0, __float_as_int(v), 0xB1, 0xf, 0xf, true));
                   if ((r32 & 1) == 0) *(unsigned*)(Ow + (size_t)orow * D + d0 * 32 + r32) = cvtpk(v, vn); } } }
    if constexpr (F32) {
#pragma unroll
        for (int d0 = 0; d0 < 8; ++d0) S.qr[d0] = pack8(S.tq[2 * d0], S.tq[2 * d0 + 1]); }
    __syncthreads();
#undef RESC
#undef KBASE
#undef ACT
#undef MASKT
#undef SEAM_K0
#undef HALF_STEP
}
#undef ROW
#undef VMW
#undef VMWN
#undef SLOAD_H
#undef SWRITE_HK
#undef SWRITE_HV
#undef SWRITE_H
#undef SLOAD_F
#undef SWRITE_KF
#undef SWRITE_VF


__device__ __forceinline__ unsigned moba_gate(const bf16x8 (&qr)[8], const float* kmean, int qb, int hi) {
    float v1 = -__builtin_inff(), v2 = v1, v3 = v1; int i1 = 0, i2 = 0, i3 = 0;
#pragma unroll 1
    for (int n = 0; n < qb; ++n) {
        const float* km = kmean + n * 128 + hi * 8;
        float g = 0.f;
#pragma unroll
        for (int d0 = 0; d0 < 8; ++d0) {
            const f32x4 k0 = *(const f32x4*)(km + d0 * 16), k1 = *(const f32x4*)(km + d0 * 16 + 4);
#pragma unroll
            for (int j = 0; j < 4; ++j) {
                g += __uint_as_float((unsigned)(unsigned short)qr[d0][j] << 16) * k0[j];
                g += __uint_as_float((unsigned)(unsigned short)qr[d0][4 + j] << 16) * k1[j];
            }
        }
        { auto rr = __builtin_amdgcn_permlane32_swap(__float_as_uint(g), __float_as_uint(g), false, false); g = __uint_as_float(rr[0]) + __uint_as_float(rr[1]); }
        if (g > v1) { v3 = v2; i3 = i2; v2 = v1; i2 = i1; v1 = g; i1 = n; }
        else if (g > v2) { v3 = v2; i3 = i2; v2 = g; i2 = n; }
        else if (g > v3) { v3 = g; i3 = n; }
    }
    return (1u << i1) | (1u << i2) | (1u << i3);
}
}

namespace gla {
using moba::bf16x8; using moba::s16x4; using moba::f32x16;
#define GLA_KSWZ(row, colB) ((row) * 256 + ((colB) ^ (((row) & 7) << 4)))
__device__ __forceinline__ float bfu(bf16_t h) { return __uint_as_float((unsigned)h << 16); }

__device__ __forceinline__ void pack_p(const f32x16& p0, const f32x16& p1, bf16x8& pa0, bf16x8& pa1, bf16x8& pa2, bf16x8& pa3) {
#define GLA_PK4(P, B_, OUT) do { unsigned a0 = moba::cvtpk(P[B_+0], P[B_+1]), a1 = moba::cvtpk(P[B_+2], P[B_+3]);                      \
        unsigned b0 = moba::cvtpk(P[B_+4], P[B_+5]), b1 = moba::cvtpk(P[B_+6], P[B_+7]);                                             \
        auto r0 = __builtin_amdgcn_permlane32_swap(a0, b0, false, false); auto r1 = __builtin_amdgcn_permlane32_swap(a1, b1, false, false); \
        u32x4 w = {r0[0], r1[0], r0[1], r1[1]}; OUT = *reinterpret_cast<bf16x8*>(&w); } while (0)
    GLA_PK4(p0, 0, pa0); GLA_PK4(p0, 8, pa1); GLA_PK4(p1, 0, pa2); GLA_PK4(p1, 8, pa3);
#undef GLA_PK4
}
__device__ __forceinline__ void pv_block(f32x16& o, int vb0  , bf16x8 pa0, bf16x8 pa1, bf16x8 pa2, bf16x8 pa3) {
#define GLA_TRRD(dst, off) asm volatile("ds_read_b64_tr_b16 %0, %1 offset:%2" : "=&v"(dst) : "v"(vb0), "i"(off) : "memory")
    s16x4 l0, l1, l2, l3, h0, h1, h2, h3; constexpr int b_ = 0;
    GLA_TRRD(l0, b_); GLA_TRRD(h0, b_ + 2048); GLA_TRRD(l1, b_ + 4096); GLA_TRRD(h1, b_ + 6144); GLA_TRRD(l2, b_ + 8192); GLA_TRRD(h2, b_ + 10240); GLA_TRRD(l3, b_ + 12288); GLA_TRRD(h3, b_ + 14336);
    asm volatile("s_waitcnt lgkmcnt(0)" ::: "memory"); __builtin_amdgcn_sched_barrier(0);
    o = __builtin_amdgcn_mfma_f32_32x32x16_bf16(pa0, (bf16x8){l0[0], l0[1], l0[2], l0[3], h0[0], h0[1], h0[2], h0[3]}, o, 0, 0, 0);
    o = __builtin_amdgcn_mfma_f32_32x32x16_bf16(pa1, (bf16x8){l1[0], l1[1], l1[2], l1[3], h1[0], h1[1], h1[2], h1[3]}, o, 0, 0, 0);
    o = __builtin_amdgcn_mfma_f32_32x32x16_bf16(pa2, (bf16x8){l2[0], l2[1], l2[2], l2[3], h2[0], h2[1], h2[2], h2[3]}, o, 0, 0, 0);
    o = __builtin_amdgcn_mfma_f32_32x32x16_bf16(pa3, (bf16x8){l3[0], l3[1], l3[2], l3[3], h3[0], h3[1], h3[2], h3[3]}, o, 0, 0, 0);
#undef GLA_TRRD
}
__device__ __forceinline__ void v_frags(int vb0, bf16x8 (&vf)[4]) {
#define GLA_TRRD(dst, off) asm volatile("ds_read_b64_tr_b16 %0, %1 offset:%2" : "=&v"(dst) : "v"(vb0), "i"(off) : "memory")
    s16x4 l0, l1, l2, l3, h0, h1, h2, h3; constexpr int b_ = 0;
    GLA_TRRD(l0, b_); GLA_TRRD(h0, b_ + 2048); GLA_TRRD(l1, b_ + 4096); GLA_TRRD(h1, b_ + 6144); GLA_TRRD(l2, b_ + 8192); GLA_TRRD(h2, b_ + 10240); GLA_TRRD(l3, b_ + 12288); GLA_TRRD(h3, b_ + 14336);
    asm volatile("s_waitcnt lgkmcnt(0)" ::: "memory"); __builtin_amdgcn_sched_barrier(0);
    vf[0] = (bf16x8){l0[0], l0[1], l0[2], l0[3], h0[0], h0[1], h0[2], h0[3]};
    vf[1] = (bf16x8){l1[0], l1[1], l1[2], l1[3], h1[0], h1[1], h1[2], h1[3]};
    vf[2] = (bf16x8){l2[0], l2[1], l2[2], l2[3], h2[0], h2[1], h2[2], h2[3]};
    vf[3] = (bf16x8){l3[0], l3[1], l3[2], l3[3], h3[0], h3[1], h3[2], h3[3]};
#undef GLA_TRRD
}
__device__ __forceinline__ void store_tile_bf16(const f32x16& o, bf16_t* dst, int ld, int r32, int hi) {
#pragma unroll
    for (int r = 0; r < 16; ++r) {
        const float v = o[r], vn = __int_as_float(__builtin_amdgcn_update_dpp(0, __float_as_int(v), 0xB1, 0xf, 0xf, true));
        if ((r32 & 1) == 0) *(unsigned*)(dst + (size_t)moba::crow(r, hi) * ld + r32) = moba::cvtpk(v, vn);
    }
}
template <int NT>
__device__ __forceinline__ void store_tiles_wide(const f32x16 (&o)[NT], bf16_t* dst, int ld, int lane, char* scr) {
    const int r32 = lane & 31, hi = lane >> 5;
#pragma unroll
    for (int i = 0; i < NT; ++i)
#pragma unroll
        for (int r = 0; r < 16; ++r) {
            const float v = o[i][r], vn = __int_as_float(__builtin_amdgcn_update_dpp(0, __float_as_int(v), 0xB1, 0xf, 0xf, true));
            if ((r32 & 1) == 0) *(unsigned*)(scr + moba::crow(r, hi) * (NT * 64) + i * 64 + r32 * 2) = moba::cvtpk(v, vn);
        }
    constexpr int LPR = NT * 4;
    constexpr int RPP = 64 / LPR;
#pragma unroll
    for (int ps = 0; ps < 32 / RPP; ++ps) {
        const int row = ps * RPP + lane / LPR, pc = lane % LPR;
        const u32x4 w = *(const u32x4*)(scr + row * (NT * 64) + pc * 16);
        *(u32x4*)(dst + (size_t)row * ld + pc * 8) = w;
    }
}
template <int NT>
__device__ __forceinline__ void tiles_to_scratch(const f32x16 (&o)[NT], int lane, char* scr) {
    const int r32 = lane & 31, hi = lane >> 5;
#pragma unroll
    for (int i = 0; i < NT; ++i)
#pragma unroll
        for (int r = 0; r < 16; ++r) {
            const float v = o[i][r], vn = __int_as_float(__builtin_amdgcn_update_dpp(0, __float_as_int(v), 0xB1, 0xf, 0xf, true));
            if ((r32 & 1) == 0) *(unsigned*)(scr + moba::crow(r, hi) * (NT * 64) + i * 64 + r32 * 2) = moba::cvtpk(v, vn);
        }
}
template <int NT>
__device__ __forceinline__ void scratch_to_global(bf16_t* dst, int ld, int lane, const char* scr) {
    constexpr int LPR = NT * 4, RPP = 64 / LPR;
#pragma unroll
    for (int ps = 0; ps < 32 / RPP; ++ps) {
        const int row = ps * RPP + lane / LPR, pc = lane % LPR;
        *(u32x4*)(dst + (size_t)row * ld + pc * 8) = *(const u32x4*)(scr + row * (NT * 64) + pc * 16);
    }
}
__device__ __forceinline__ void stage_v_load(const bf16_t* src, int ld, int t, bf16x8 (&r)[4]) {
    const int sr = t >> 4, sc = (t & 15) * 8;
    r[0] = *(const bf16x8*)(src + (size_t)sr * ld + sc); r[1] = *(const bf16x8*)(src + (size_t)(32 + sr) * ld + sc);
    r[2] = *(const bf16x8*)(src + (size_t)sr * ld + 128 + sc); r[3] = *(const bf16x8*)(src + (size_t)(32 + sr) * ld + 128 + sc);
}
__device__ __forceinline__ void stage_v_write(char* V_lds, int t, const bf16x8 (&r)[4]) {
    const int sr = t >> 4, sc = (t & 15) * 8;
    *(bf16x8*)(V_lds + moba::v_st(sr, sc)) = r[0]; *(bf16x8*)(V_lds + moba::v_st(32 + sr, sc)) = r[1];
    *(bf16x8*)(V_lds + moba::SHM_V + moba::v_st(sr, sc)) = r[2]; *(bf16x8*)(V_lds + moba::SHM_V + moba::v_st(32 + sr, sc)) = r[3];
}

__device__ __forceinline__ void g1_item(const Params& p, int item, char* lds, const int t) {
    const int c = item & 31, h = (item >> 5) & 3, sl = item >> 7;
    const size_t tl0 = (size_t)sl * SEQ + c * 64;
    char* Kt = lds; char* Qt = lds + 16384; char* V_lds = lds + 32768; float* segtot = (float*)(lds + 65536);
    float* graw = (float*)(lds + 67584); bf16_t* qraw = (bf16_t*)(lds + 100352); bf16_t* kraw = (bf16_t*)(lds + 116736);
    const int d = t & 127, seg = t >> 7;
    {
        bf16x8 vr[4];
        stage_v_load(p.va() + tl0 * 1024 + h * 256, 1024, t, vr);
        f32x4 gr[4]; bf16x8 qr2[2], kr2[2];
#pragma unroll
        for (int i = 0; i < 4; ++i) { const int ch = t + i * NTHREADS, row = ch >> 5, col = (ch & 31) * 4; gr[i] = *(const f32x4*)(p.g() + (tl0 + row) * 512 + h * 128 + col); }
#pragma unroll
        for (int i = 0; i < 2; ++i) { const int ch = t + i * NTHREADS, row = ch >> 4, col = (ch & 15) * 8;
            qr2[i] = *(const bf16x8*)(p.qa() + (tl0 + row) * 512 + h * 128 + col); kr2[i] = *(const bf16x8*)(p.ka() + (tl0 + row) * 512 + h * 128 + col); }
        stage_v_write(V_lds, t, vr);
#pragma unroll
        for (int i = 0; i < 4; ++i) { const int ch = t + i * NTHREADS; *(f32x4*)(graw + ch * 4) = gr[i]; }
#pragma unroll
        for (int i = 0; i < 2; ++i) { const int ch = t + i * NTHREADS; *(bf16x8*)(qraw + ch * 8) = qr2[i]; *(bf16x8*)(kraw + ch * 8) = kr2[i]; }
    }
    __syncthreads();
    float b[16];
#pragma unroll
    for (int i = 0; i < 16; ++i) b[i] = graw[(seg * 16 + i) * 128 + d];
#pragma unroll
    for (int i = 1; i < 16; ++i) b[i] += b[i - 1];
    segtot[seg * 128 + d] = b[15];
    __syncthreads();
    const float s0 = segtot[d], s1 = segtot[128 + d], s2 = segtot[256 + d], s3 = segtot[384 + d];
    const float prefix = (seg > 0 ? s0 : 0.f) + (seg > 1 ? s1 : 0.f) + (seg > 2 ? s2 : 0.f);
    const float ref = s0 + s1, blast = (s0 + s1) + (s2 + s3);
    const float er = __expf(-ref), el = __expf(blast);
    unsigned ksw[8];
#pragma unroll
    for (int i = 0; i < 16; ++i) {
        const int tt = seg * 16 + i;
        const float qv = bfu(qraw[tt * 128 + d]), kv = bfu(kraw[tt * 128 + d]);
        const float eb = __expf(b[i] + prefix);
        const float ebr = eb * er, inv = __builtin_amdgcn_rcpf(eb);
        const float qt = qv * ebr, kt = kv * __builtin_amdgcn_rcpf(ebr), qi = qv * eb, ks = kv * (el * inv);
        *(bf16_t*)(Qt + GLA_KSWZ(tt, d * 2)) = f2bf(qt);
        *(bf16_t*)(Kt + GLA_KSWZ(tt, d * 2)) = f2bf(kt);
        qraw[tt * 128 + d] = f2bf(qi);
        if (i & 1) ksw[i >> 1] |= (unsigned)f2bf(ks) << 16; else ksw[i >> 1] = f2bf(ks);
    }
    {
        bf16_t* dst = p.ka() + (tl0 + (d >> 1)) * 512 + h * 128 + (d & 1) * 64 + seg * 16;
        *(u32x4*)dst = (u32x4){ksw[0], ksw[1], ksw[2], ksw[3]};
        *(u32x4*)(dst + 8) = (u32x4){ksw[4], ksw[5], ksw[6], ksw[7]};
    }
    if (seg == 0) p.dl()[((size_t)(sl * 32 + c) * 4 + h) * 128 + d] = el;
    __syncthreads();
#pragma unroll
    for (int i = 0; i < 2; ++i) { const int ch = t + i * NTHREADS, row = ch >> 4, col = (ch & 15) * 8;
        *(bf16x8*)(p.qa() + (tl0 + row) * 512 + h * 128 + col) = *(const bf16x8*)(qraw + ch * 8); }
    const int wave = __builtin_amdgcn_readfirstlane(t >> 6), lane = t & 63, r32 = lane & 31, hi = lane >> 5, tt = wave & 1, vg = wave >> 1;
    bf16x8 qr[8];
#pragma unroll
    for (int d0 = 0; d0 < 8; ++d0) qr[d0] = *(const bf16x8*)(Qt + GLA_KSWZ(32 * tt + r32, (d0 * 16 + hi * 8) * 2));
    f32x16 p0, p1;
    moba::qkt<0, false>(p0, p1, Kt, r32, hi, qr, true);
    const int trow = 32 * tt + r32;
#pragma unroll
    for (int r = 0; r < 16; ++r) { const int s = moba::crow(r, hi); p0[r] = (s <= trow) ? p0[r] : 0.f; p1[r] = (s + 32 <= trow) ? p1[r] : 0.f; }
    bf16x8 pa0, pa1, pa2, pa3;
    pack_p(p0, p1, pa0, pa1, pa2, pa3);
    const int vb0 = (int)(uintptr_t)V_lds + moba::v_rd_base(lane);
    f32x16 oA = f32x16{}, oB = f32x16{};
    {
        const int vbw = vb0 + (vg >> 1) * moba::SHM_V + (vg & 1) * 1024;
        pv_block(oA, vbw, pa0, pa1, pa2, pa3);
        pv_block(oB, vbw + 512, pa0, pa1, pa2, pa3);
    }
    bf16_t* od = p.oi() + (tl0 + 32 * tt) * 1024 + h * 256 + vg * 64;
    {
        const f32x16 o2[2] = {oA, oB};
        store_tiles_wide<2>(o2, od, 1024, lane, lds + 67584 + wave * 4096);
    }
    __syncthreads();
}

struct G2Stage { bf16x8 q[2], k[2], v[4]; float dl; };
__device__ __forceinline__ void g2_load(const Params& p, size_t tl0, size_t slc, int h, int t, G2Stage& s) {
    { const int tr = t >> 3, dq = (t & 7) * 16; const bf16_t* src = p.qa() + (tl0 + tr) * 512 + h * 128 + dq; s.q[0] = *(const bf16x8*)src; s.q[1] = *(const bf16x8*)(src + 8); }
    { const int dr = t >> 2, tq = (t & 3) * 16; const bf16_t* src = p.ka() + (tl0 + (dr >> 1)) * 512 + h * 128 + (dr & 1) * 64 + tq; s.k[0] = *(const bf16x8*)src; s.k[1] = *(const bf16x8*)(src + 8); }
    stage_v_load(p.va() + tl0 * 1024 + h * 256, 1024, t, s.v);
    s.dl = (t < 128) ? p.dl()[(slc * 4 + h) * 128 + t] : 0.f;
}
__device__ __forceinline__ void g2_write(char* lds, int t, const G2Stage& s) {
    { const int tr = t >> 3, c8 = (t & 7) * 4, x = tr & 31;
#pragma unroll
      for (int i = 0; i < 2; ++i) { const s16x4 lo = {s.q[i][0], s.q[i][1], s.q[i][2], s.q[i][3]}, hi4 = {s.q[i][4], s.q[i][5], s.q[i][6], s.q[i][7]};
          *(s16x4*)(lds + tr * 256 + (((c8 + 2 * i) ^ x) << 3)) = lo; *(s16x4*)(lds + tr * 256 + (((c8 + 2 * i + 1) ^ x) << 3)) = hi4; } }
    { const int dr = t >> 2, ch = (t & 3) * 2;
#pragma unroll
      for (int i = 0; i < 2; ++i) *(bf16x8*)(lds + 16384 + dr * 128 + (((ch + i) ^ (dr & 7)) << 4)) = s.k[i]; }
    stage_v_write(lds + 32768, t, s.v);
    if (t < 128) ((float*)(lds + 65536))[t] = s.dl;
}
__device__ __forceinline__ void g2_update(f32x16 (&S)[4], const char* lds, int vb0, int r32, int hi) {
    bf16x8 vf[4];
    v_frags(vb0, vf);
#pragma unroll
    for (int dt = 0; dt < 4; ++dt) {
        const int dr = 32 * dt + r32;
#pragma unroll
        for (int kk = 0; kk < 4; ++kk) {
            const bf16x8 a = *(const bf16x8*)(lds + 16384 + dr * 128 + (((2 * kk + hi) ^ (dr & 7)) << 4));
            S[dt] = __builtin_amdgcn_mfma_f32_32x32x16_bf16(a, vf[kk], S[dt], 0, 0, 0);
        }
    }
}
template <int G2V = 0>
__device__ __forceinline__ void g2_item(const Params& p, int item, char* lds, const int t) {
    const int h = item & 3, sl = item >> 2;
    const int wave = __builtin_amdgcn_readfirstlane(t >> 6), lane = t & 63, r32 = lane & 31, hi = lane >> 5;
    const int vb0 = (int)(uintptr_t)(lds + 32768) + moba::v_rd_base(lane);
    f32x16 S[4];
#pragma unroll
    for (int dt = 0; dt < 4; ++dt) S[dt] = f32x16{};
    G2Stage st;
    g2_load(p, (size_t)sl * SEQ, (size_t)sl * 32, h, t, st);
#pragma unroll 1
    for (int c = 0; c < 32; ++c) {
        const size_t tl0 = (size_t)sl * SEQ + c * 64;
        __syncthreads();
        g2_write(lds, t, st);
        __syncthreads();
        if (G2V == 0 && c > 0) {
            bf16_t* od = p.oe() + (tl0 - 64) * 1024 + h * 256 + wave * 32;
            scratch_to_global<1>(od, 1024, lane, lds + 69632 + wave * 4096);
            scratch_to_global<1>(od + 32 * 1024, 1024, lane, lds + 69632 + wave * 4096 + 2048);
        }
        if (c + 1 < 32) g2_load(p, tl0 + 64, (size_t)sl * 32 + c + 1, h, t, st);
#pragma unroll
        for (int tt = 0; tt < ((G2V == 3 || G2V == 4) ? 0 : 2); ++tt) {
            f32x16 o = f32x16{};
            const char* rowp = lds + (32 * tt + r32) * 256;
#pragma unroll
            for (int dt = 0; dt < 4; ++dt) {
#pragma unroll
                for (int s = 0; s < 2; ++s) {
                    u32x4 w = {moba::cvtpk(S[dt][8 * s], S[dt][8 * s + 1]), moba::cvtpk(S[dt][8 * s + 2], S[dt][8 * s + 3]), moba::cvtpk(S[dt][8 * s + 4], S[dt][8 * s + 5]), moba::cvtpk(S[dt][8 * s + 6], S[dt][8 * s + 7])};
                    const bf16x8 sf = *reinterpret_cast<bf16x8*>(&w);
                    const int c8 = 8 * dt + 4 * s + hi;
                    const s16x4 lo = *(const s16x4*)(rowp + ((c8 ^ r32) << 3)), hi4 = *(const s16x4*)(rowp + (((c8 + 2) ^ r32) << 3));
                    const bf16x8 a = {lo[0], lo[1], lo[2], lo[3], hi4[0], hi4[1], hi4[2], hi4[3]};
                    o = __builtin_amdgcn_mfma_f32_32x32x16_bf16(a, sf, o, 0, 0, 0);
                }
            }
            if (G2V == 0) { const f32x16 o1[1] = {o}; tiles_to_scratch<1>(o1, lane, lds + 69632 + wave * 4096 + tt * 2048); }
            else asm volatile("" :: "v"(o[0]), "v"(o[5]), "v"(o[10]), "v"(o[15]));
        }
        const float* dlp = (const float*)(lds + 65536);
#pragma unroll
        for (int dt = 0; dt < 4; ++dt)
#pragma unroll
            for (int rq = 0; rq < 4; ++rq) {
                const f32x4 dv = *(const f32x4*)(dlp + 32 * dt + 8 * rq + 4 * hi);
#pragma unroll
                for (int j = 0; j < 4; ++j) S[dt][4 * rq + j] *= dv[j];
            }
        if (G2V != 2 && G2V != 4) g2_update(S, lds, vb0 + (wave >> 2) * moba::SHM_V + (wave & 3) * 512, r32, hi);
    }
    if (G2V != 0) asm volatile("" :: "v"(S[0][0]), "v"(S[1][3]), "v"(S[2][7]), "v"(S[3][15]));
    if (G2V == 0) {
        bf16_t* od = p.oe() + ((size_t)sl * SEQ + 31 * 64) * 1024 + h * 256 + wave * 32;
        scratch_to_global<1>(od, 1024, lane, lds + 69632 + wave * 4096);
        scratch_to_global<1>(od + 32 * 1024, 1024, lane, lds + 69632 + wave * 4096 + 2048);
    }
    __syncthreads();
}
}

__device__ __forceinline__ moba::BlockRef<bf16_t, bf16_t> moba_ref(const Params& p, int L) {
    const int sh = L & 63, qb = 7 - (L >> 6);
    moba::BlockRef<bf16_t, bf16_t> r;
    bf16_t* Qh = p.qb() + (size_t)sh * SEQ * 128;
    r.Q = Qh + (size_t)qb * 256 * 128; r.O = Qh + (size_t)qb * 256 * 128;
    r.K = p.kb() + (size_t)sh * SEQ * 128; r.V = p.vb() + (size_t)sh * SEQ * 128; r.P0 = qb * 256;
    return r;
}
__device__ __forceinline__ int moba_dequeue(unsigned* ctr, volatile unsigned* lds_word, const int t) {
    __syncthreads();
    if (t == 0) *lds_word = atomicAdd(ctr, 1u);
    __syncthreads();
    return __builtin_amdgcn_readfirstlane((int)*lds_word);
}
__device__ __forceinline__ void phase_moba_mfma(const Params& p, int chunk, unsigned char* lds_raw, const int t) {
    using BR = moba::BlockRef<bf16_t, bf16_t>;
    const int total = CHUNK_SEQS * 8 * 8, W = 0x7fffffff;
    unsigned* ctr = p.qctr() + 40 + chunk;
    volatile unsigned* lw = (volatile unsigned*)(lds_raw + 69632);
    int L = moba_dequeue(ctr, lw, t);
    if (L >= total) return;
    BR cur = moba_ref(p, L);
    moba::Seam<bf16_t> S;
    moba::causal_swa_prime<bf16_t, bf16_t>(cur, W, (char*)lds_raw, S, t);
    for (;;) {
        const int Ln = moba_dequeue(ctr, lw, t);
        const bool last = Ln >= total;
        const BR nxt = last ? cur : moba_ref(p, Ln);
        unsigned selmask = 0xffu;
        if (cur.P0 >= 1024) selmask = moba::moba_gate(S.qr, p.kmean() + (size_t)(L & 63) * 8 * 128, cur.P0 >> 8, (t >> 5) & 1);
        moba::causal_swa_block<bf16_t, bf16_t>(cur, nxt, SEQ, W, (char*)lds_raw, S, t, selmask);
        if (last) break;
        cur = nxt; L = Ln;
    }
}

__device__ __forceinline__ void unpack8(const u32x4 w, float (&f)[8]) {
#pragma unroll
    for (int j = 0; j < 4; ++j) { f[2 * j] = __uint_as_float(w[j] << 16); f[2 * j + 1] = __uint_as_float(w[j] & 0xffff0000u); }
}
struct MergeRaw { u32x4 oi[2], oe[2], ra[2], ga[2], gb[2], ob[2]; };
__device__ __forceinline__ void merge_load(const Params& p, int tl, int lane, MergeRaw& m) {
    const size_t ro = (size_t)tl * 1024 + lane * 16;
    const int s = tl >> 11, pos = tl & (SEQ - 1);
    const bf16_t* obp = p.qb() + ((size_t)(s * 8 + (lane >> 3)) * SEQ + pos) * 128 + (lane & 7) * 16;
#pragma unroll
    for (int hf = 0; hf < 2; ++hf) {
        m.oi[hf] = *(const u32x4*)(p.oi() + ro + hf * 8); m.oe[hf] = *(const u32x4*)(p.oe() + ro + hf * 8); m.ra[hf] = *(const u32x4*)(p.ra() + ro + hf * 8);
        m.ga[hf] = *(const u32x4*)(p.ga() + ro + hf * 8); m.gb[hf] = *(const u32x4*)(p.gb() + ro + hf * 8); m.ob[hf] = *(const u32x4*)(obp + hf * 8);
    }
}
__device__ __forceinline__ void merge_compute(const Params& p, int chunk, int tl, int lane, const MergeRaw& m, const float (&ng)[16]) {
    float o[16], tmp[8], t2[8];
#pragma unroll
    for (int hf = 0; hf < 2; ++hf) {
        unpack8(m.oi[hf], tmp); unpack8(m.oe[hf], t2);
#pragma unroll
        for (int j = 0; j < 8; ++j) o[hf * 8 + j] = tmp[j] + t2[j];
    }
    float ss = 0.f;
#pragma unroll
    for (int j = 0; j < 16; ++j) ss += o[j] * o[j];
    ss += __int_as_float(__builtin_amdgcn_update_dpp(0, __float_as_int(ss), 0xB1, 0xf, 0xf, true));
    ss += __int_as_float(__builtin_amdgcn_update_dpp(0, __float_as_int(ss), 0x4E, 0xf, 0xf, true));
    ss += __int_as_float(__builtin_amdgcn_update_dpp(0, __float_as_int(ss), 0x141, 0xf, 0xf, true));
    ss += __int_as_float(__builtin_amdgcn_update_dpp(0, __float_as_int(ss), 0x140, 0xf, 0xf, true));
    const float rs = rsqrtf(ss * (1.0f / 256.0f) + 1e-6f);
    unsigned w[8];
#pragma unroll
    for (int hf = 0; hf < 2; ++hf) {
        float r[8], ga[8], gb[8], ob[8];
        unpack8(m.ra[hf], r); unpack8(m.ga[hf], ga); unpack8(m.gb[hf], gb); unpack8(m.ob[hf], ob);
#pragma unroll
        for (int j = 0; j < 4; ++j) {
            const int e = hf * 8 + 2 * j;
            const float y0 = o[e] * rs * ng[e] * r[2 * j] * ga[2 * j] + ob[2 * j] * gb[2 * j];
            const float y1 = o[e + 1] * rs * ng[e + 1] * r[2 * j + 1] * ga[2 * j + 1] + ob[2 * j + 1] * gb[2 * j + 1];
            w[hf * 4 + j] = pack_bf16(y0, y1);
        }
    }
    bf16_t* yp = p.y() + ((size_t)chunk * CT + tl) * 1024 + lane * 16;
    *(u32x4*)yp = (u32x4){w[0], w[1], w[2], w[3]};
    *(u32x4*)(yp + 8) = (u32x4){w[4], w[5], w[6], w[7]};
}
__device__ __forceinline__ void phase_merge(const Params& p, int chunk, const int t) {
    const int wave = t >> 6, lane = t & 63;
    float ng[16];
#pragma unroll
    for (int j = 0; j < 16; ++j) ng[j] = p.gla_ng[(lane & 15) * 16 + j];
    const int stride = gridDim.x * 8;
    int tl = blockIdx.x * 8 + wave;
    MergeRaw a, b;
    if (tl < CT) merge_load(p, tl, lane, a);
#pragma unroll 1
    for (; tl < CT; tl += 2 * stride) {
        const bool hb = tl + stride < CT;
        if (hb) merge_load(p, tl + stride, lane, b);
        merge_compute(p, chunk, tl, lane, a, ng);
        if (tl + 2 * stride < CT) merge_load(p, tl + 2 * stride, lane, a);
        if (hb) merge_compute(p, chunk, tl + stride, lane, b, ng);
    }
}

__device__ __forceinline__ void phase_ln1(const Params& p, const int t) {
    const int wave = t >> 6, lane = t & 63;
    f32x4 g[4], be[4];
#pragma unroll
    for (int j = 0; j < 4; ++j) { g[j] = *(const f32x4*)(p.ln1_g + j * 256 + lane * 4); be[j] = *(const f32x4*)(p.ln1_b + j * 256 + lane * 4); }
#pragma unroll 1
    for (int n = blockIdx.x * 8 + wave; n < NTOK; n += gridDim.x * 8) {
        f32x4 v[4];
        float sum = 0.f;
#pragma unroll
        for (int j = 0; j < 4; ++j) { v[j] = *(const f32x4*)(p.x1() + (size_t)n * 1024 + j * 256 + lane * 4); sum += (v[j][0] + v[j][1]) + (v[j][2] + v[j][3]); }
        const float mu = wave_sum(sum) * (1.0f / 1024.0f);
        float sq = 0.f;
#pragma unroll
        for (int j = 0; j < 4; ++j) { const f32x4 d = v[j] - mu; sq += (d[0] * d[0] + d[1] * d[1]) + (d[2] * d[2] + d[3] * d[3]); }
        const float rs = rsqrtf(wave_sum(sq) * (1.0f / 1024.0f) + 1e-5f);
#pragma unroll
        for (int j = 0; j < 4; ++j) {
            const f32x4 o = (v[j] - mu) * rs * g[j] + be[j];
            uint2 w; w.x = pack_bf16(o[0], o[1]); w.y = pack_bf16(o[2], o[3]);
            *(uint2*)(p.x1b() + (size_t)n * 1024 + j * 256 + lane * 4) = w;
        }
    }
}

__device__ __forceinline__ unsigned xcc_id() { return (unsigned)__builtin_amdgcn_s_getreg((3 << 11) | 20) & 0x7u; }
template <int CTRL> __device__ __forceinline__ float dpp_add(float v) {
    return v + __int_as_float(__builtin_amdgcn_update_dpp(0, __float_as_int(v), CTRL, 0xf, 0xf, true));
}
typedef __bf16 bf16x2_t __attribute__((ext_vector_type(2)));
__device__ __forceinline__ float dot2bf(unsigned a, unsigned b, float acc) {
    return __builtin_amdgcn_fdot2_f32_bf16(__builtin_bit_cast(bf16x2_t, a), __builtin_bit_cast(bf16x2_t, b), acc, false);
}
#define PEER_NS 8
#define PEER_TILE 64
#define PEER_NT (NTOK / PEER_TILE)

template <class F> __device__ __forceinline__ void peer_sliced(unsigned* qctr, unsigned* lds_word, const int t, F&& f) {
    const int xcc = (int)xcc_id();
#pragma unroll 1
    for (int j = 0; j < PEER_NS; ++j) {
        const int s = (xcc + j) & (PEER_NS - 1);
#pragma unroll 1
        for (;;) {
            __syncthreads();
            if (t == 0) *lds_word = atomicAdd(qctr + s, 1u);
            __syncthreads();
            const unsigned tile = *lds_word;
            if (tile >= PEER_NT) break;
            f(s, (int)tile);
        }
    }
}

typedef float f32x2 __attribute__((ext_vector_type(2)));
typedef int i32x8 __attribute__((ext_vector_type(8)));
typedef short s16x2 __attribute__((ext_vector_type(2)));
__device__ __forceinline__ void peer_u_item(const Params& p, int s, int tile, const int t) {
    const int wave = __builtin_amdgcn_readfirstlane(t >> 6), lane = t & 63, r = lane & 3, qa = lane >> 2;
    const int n0 = tile * PEER_TILE + wave * 8;
    const unsigned char* ub = p.u8() + s * 128 + r * 16;
    const float dw0 = (r == 0) ? 0.03125f : 0.f, dw1 = (r == 1) ? 0.03125f : 0.f, dw2 = (r == 2) ? 0.03125f : 0.f, dw3 = (r == 3) ? 0.03125f : 0.f;
    const bool bon = (lane >> 4) == ((lane >> 2) & 3);
    const int qc = 4 * (qa & 3) + (qa >> 2);
    const int* ep = p.sel_e() + (size_t)n0 * 128 + qa * 8;
    const bf16_t* xo = p.x1b() + (size_t)n0 * 1024 + s * 128 + r * 16;
    unsigned pf;
    {
        const char* pa = (lane < 16) ? (const char*)(p.x1b() + (size_t)(n0 + (lane >> 1)) * 1024 + s * 128) + (lane & 1) * 128
                                     : (const char*)(p.sel_e() + (size_t)n0 * 128) + ((lane - 16) & 31) * 128;
        pf = *(const unsigned*)pa;
    }
    u32x4 A0[8][2], A1[8][2], XA[4], XB[4];
    u32x4 ia0, ia1, ib0, ib1;
#define PU_IDS(d0, d1, tt) do { d0 = *(const u32x4*)(ep + (tt) * 128); d1 = *(const u32x4*)(ep + (tt) * 128 + 4); } while (0)
#define PU_LOAD(A, d0, d1) do { _Pragma("unroll") for (int m = 0; m < 8; ++m) { const unsigned id = (m < 4) ? d0[m & 3] : d1[m & 3]; const unsigned char* rp = ub + (size_t)id * 1024; \
        A[m][0] = *(const u32x4*)rp; A[m][1] = *(const u32x4*)(rp + 64); } } while (0)
#define PU_XLOAD(X, tt) do { const bf16_t* xp = xo + (size_t)(tt) * 1024; X[0] = *(const u32x4*)xp; X[1] = *(const u32x4*)(xp + 8); X[2] = *(const u32x4*)(xp + 64); X[3] = *(const u32x4*)(xp + 72); } while (0)
#define PU_TOKEN(A, X, tt) do { i32x8 bm; _Pragma("unroll") for (int i = 0; i < 8; ++i) { const unsigned x0 = X[i >> 1][(i & 1) * 2], x1 = X[i >> 1][(i & 1) * 2 + 1]; int w = 0; \
            w = __builtin_amdgcn_cvt_pk_fp8_f32(__uint_as_float(x0 << 16), __uint_as_float(x0 & 0xffff0000u), w, false); \
            w = __builtin_amdgcn_cvt_pk_fp8_f32(__uint_as_float(x1 << 16), __uint_as_float(x1 & 0xffff0000u), w, true); \
            bm[i] = bon ? w : 0; } \
        float dsum[8]; \
        _Pragma("unroll") for (int m = 0; m < 8; ++m) { const i32x8 a = {(int)A[m][0][0], (int)A[m][0][1], (int)A[m][0][2], (int)A[m][0][3], (int)A[m][1][0], (int)A[m][1][1], (int)A[m][1][2], (int)A[m][1][3]}; \
            const f32x4 c = __builtin_amdgcn_mfma_scale_f32_16x16x128_f8f6f4(a, bm, (f32x4){0.f, 0.f, 0.f, 0.f}, 0, 0, 0, 0, 0, 0); \
            float d = (c[0] * dw0 + c[1] * dw1) + (c[2] * dw2 + c[3] * dw3); \
            d = dpp_add<0xB1>(d); dsum[m] = dpp_add<0x4E>(d); } \
        if (r == 0) *(u32x4*)(p.part() + ((size_t)s * NTOK + n0 + (tt)) * 128 + qc * 8) = (u32x4){pack_bf16(dsum[0], dsum[1]), pack_bf16(dsum[2], dsum[3]), pack_bf16(dsum[4], dsum[5]), pack_bf16(dsum[6], dsum[7])}; \
    } while (0)
    PU_IDS(ia0, ia1, 0);
    PU_IDS(ib0, ib1, 1);
    PU_XLOAD(XA, 0);
    PU_LOAD(A0, ia0, ia1);
#pragma unroll
    for (int tt = 0; tt < 8; tt += 2) {
        if (tt + 2 < 8) PU_IDS(ia0, ia1, tt + 2);
        PU_XLOAD(XB, tt + 1);
        __builtin_amdgcn_sched_barrier(0);
        PU_LOAD(A1, ib0, ib1);
        __builtin_amdgcn_sched_barrier(0);
        PU_TOKEN(A0, XA, tt);
        __builtin_amdgcn_sched_barrier(0);
        if (tt + 3 < 8) PU_IDS(ib0, ib1, tt + 3);
        if (tt + 2 < 8) PU_XLOAD(XA, tt + 2);
        __builtin_amdgcn_sched_barrier(0);
        if (tt + 2 < 8) PU_LOAD(A0, ia0, ia1);
        __builtin_amdgcn_sched_barrier(0);
        PU_TOKEN(A1, XB, tt + 1);
        __builtin_amdgcn_sched_barrier(0);
    }
#undef PU_IDS
#undef PU_LOAD
#undef PU_XLOAD
#undef PU_TOKEN
    asm volatile("" :: "v"(pf));
}
__device__ __forceinline__ void peer_reduce(const Params& p, const int t) {
#pragma unroll 1
    for (size_t i = (size_t)blockIdx.x * NTHREADS + t; i < (size_t)NTOK * 128; i += (size_t)gridDim.x * NTHREADS) {
        float d = 0.f;
#pragma unroll
        for (int s = 0; s < PEER_NS; ++s) d += bf2f(p.part()[(size_t)s * NTOK * 128 + i]);
        const float w = p.sel_g()[i] * 0.5f * d * (1.0f + erff(d * 0.7071067811865476f));
        p.sel_g()[i] = 0.5f * w;
    }
}
__device__ __forceinline__ void peer_v_item(const Params& p, int s, int tile, const int t) {
    const int wave = t >> 6, lane = t & 63, grp = lane >> 3, c8 = lane & 7;
    const unsigned char* vt = p.v8() + s * 128 + c8 * 16;
#pragma unroll 1
    for (int tt = 0; tt < 8; ++tt) {
        const int n = tile * PEER_TILE + wave * 8 + tt;
        const int* ep = p.sel_e() + (size_t)n * 128 + grp * 16;
        const float* wp = p.sel_g() + (size_t)n * 128 + grp * 16;
        u32x4 id4[4]; f32x4 w4[4];
#pragma unroll
        for (int q = 0; q < 4; ++q) { id4[q] = *(const u32x4*)(ep + q * 4); w4[q] = *(const f32x4*)(wp + q * 4); }
        f32x2 acc[8];
#pragma unroll
        for (int j = 0; j < 8; ++j) acc[j] = (f32x2){0.f, 0.f};
#pragma unroll
        for (int i = 0; i < 16; ++i) {
            const unsigned id = id4[i >> 2][i & 3];
            const float w = w4[i >> 2][i & 3];
            const f32x2 w2 = {w, w};
            const u32x4 vv = *(const u32x4*)(vt + (size_t)id * 1024);
#pragma unroll
            for (int j = 0; j < 4; ++j) {
                acc[2 * j] = __builtin_elementwise_fma(__builtin_amdgcn_cvt_pk_f32_fp8((int)vv[j], false), w2, acc[2 * j]);
                acc[2 * j + 1] = __builtin_elementwise_fma(__builtin_amdgcn_cvt_pk_f32_fp8((int)vv[j], true), w2, acc[2 * j + 1]);
            }
        }
        float o[16];
#pragma unroll
        for (int j = 0; j < 8; ++j) { o[2 * j] = acc[j].x; o[2 * j + 1] = acc[j].y; }
        float s8[8];
#pragma unroll
        for (int j = 0; j < 8; ++j) {
            const auto rr = __builtin_amdgcn_permlane32_swap(__float_as_uint(o[j]), __float_as_uint(o[j + 8]), false, false);
            s8[j] = __uint_as_float(rr[0]) + __uint_as_float(rr[1]);
        }
        const bool b4 = (lane & 16) != 0, b3 = (lane & 8) != 0;
        float s4[4];
#pragma unroll
        for (int j = 0; j < 4; ++j) {
            const float send = b3 ? s8[j] : s8[j + 4], keep = b3 ? s8[j + 4] : s8[j];
            s4[j] = keep + __int_as_float(__builtin_amdgcn_update_dpp(0, __float_as_int(send), 0x128, 0xf, 0xf, true));
        }
        float s2[2];
#pragma unroll
        for (int j = 0; j < 2; ++j) {
            const float send = b4 ? s4[j] : s4[j + 2], keep = b4 ? s4[j + 2] : s4[j];
            s2[j] = keep + __shfl_xor(send, 16, 64);
        }
        {
            const int col = c8 * 16 + ((lane >> 5) & 1) * 8 + ((lane >> 3) & 1) * 4 + ((lane >> 4) & 1) * 2;
            *(unsigned*)(p.h2() + (size_t)n * 1024 + s * 128 + col) = pack_bf16(s2[0], s2[1]);
        }
    }
}
__device__ __forceinline__ void peer_ln2(const Params& p, const int t) {
    const int wave = t >> 6, lane = t & 63;
    f32x4 g[4], be[4];
#pragma unroll
    for (int j = 0; j < 4; ++j) { const int c = (j >> 1) * 512 + lane * 8 + (j & 1) * 4; g[j] = *(const f32x4*)(p.ln2_g + c); be[j] = *(const f32x4*)(p.ln2_b + c); }
#pragma unroll 1
    for (int n = blockIdx.x * 8 + wave; n < NTOK; n += gridDim.x * 8) {
        f32x4 v[4];
        float sum = 0.f;
#pragma unroll
        for (int hf = 0; hf < 2; ++hf) {
            const u32x4 aw = *(const u32x4*)(p.x1b() + (size_t)n * 1024 + hf * 512 + lane * 8);
            const u32x4 bw = *(const u32x4*)(p.h2() + (size_t)n * 1024 + hf * 512 + lane * 8);
#pragma unroll
            for (int q = 0; q < 2; ++q) {
                const f32x4 a = {__uint_as_float(aw[2 * q] << 16), __uint_as_float(aw[2 * q] & 0xffff0000u), __uint_as_float(aw[2 * q + 1] << 16), __uint_as_float(aw[2 * q + 1] & 0xffff0000u)};
                const f32x4 b = {__uint_as_float(bw[2 * q] << 16), __uint_as_float(bw[2 * q] & 0xffff0000u), __uint_as_float(bw[2 * q + 1] << 16), __uint_as_float(bw[2 * q + 1] & 0xffff0000u)};
                v[hf * 2 + q] = a * DN_ALPHA + b;
                sum += (v[hf * 2 + q][0] + v[hf * 2 + q][1]) + (v[hf * 2 + q][2] + v[hf * 2 + q][3]);
            }
        }
        const float mu = wave_sum(sum) * (1.0f / 1024.0f);
        float sq = 0.f;
#pragma unroll
        for (int j = 0; j < 4; ++j) { const f32x4 d = v[j] - mu; sq += (d[0] * d[0] + d[1] * d[1]) + (d[2] * d[2] + d[3] * d[3]); }
        const float rs = rsqrtf(wave_sum(sq) * (1.0f / 1024.0f) + 1e-5f);
#pragma unroll
        for (int j = 0; j < 4; ++j) *(f32x4*)(p.out + (size_t)n * 1024 + (j >> 1) * 512 + lane * 8 + (j & 1) * 4) = (v[j] - mu) * rs * g[j] + be[j];
    }
}
__device__ __forceinline__ unsigned pack_fp8x4(f32x4 a, float sc) {
    int w = 0;
    w = __builtin_amdgcn_cvt_pk_fp8_f32(a[0] * sc, a[1] * sc, w, false);
    w = __builtin_amdgcn_cvt_pk_fp8_f32(a[2] * sc, a[3] * sc, w, true);
    return (unsigned)w;
}
__device__ __forceinline__ void peer_tabconv(const Params& p, const int t) {
#pragma unroll 1
    for (size_t i = ((size_t)blockIdx.x * NTHREADS + t) * 16; i < (size_t)16384 * 1024; i += (size_t)gridDim.x * NTHREADS * 16) {
        u32x4 wu, wv;
#pragma unroll
        for (int q = 0; q < 4; ++q) { wu[q] = pack_fp8x4(*(const f32x4*)(p.pu + i + 4 * q), 32.0f); wv[q] = pack_fp8x4(*(const f32x4*)(p.pv + i + 4 * q), 2.0f); }
        *(u32x4*)(p.u8() + i) = wu;
        *(u32x4*)(p.v8() + i) = wv;
    }
}

namespace psel {
typedef short bf16x8 __attribute__((ext_vector_type(8)));
typedef float f32x16 __attribute__((ext_vector_type(16)));
#define PSEL_SWZ(row, colB) ((row) * 256 + ((colB) ^ (((row) & 7) << 4)))
__device__ __forceinline__ int f2key(int bits) { return bits ^ (int)((unsigned)(bits >> 31) >> 1); }
__device__ __forceinline__ void ce(int& a, int& b) { const int hi = a > b ? a : b, lo = a > b ? b : a; a = hi; b = lo; }
template <int N> __device__ __forceinline__ void sort_desc(int (&x)[N]) {
#pragma unroll
    for (int k = 2; k <= N; k <<= 1)
#pragma unroll
        for (int j = k >> 1; j > 0; j >>= 1)
#pragma unroll
            for (int i = 0; i < N; ++i) { const int l = i ^ j; if (l > i) { if ((i & k) == 0) ce(x[i], x[l]); else ce(x[l], x[i]); } }
}
template <int N> __device__ __forceinline__ void merge_desc(int (&x)[N]) {
#pragma unroll
    for (int j = N >> 1; j > 0; j >>= 1)
#pragma unroll
        for (int i = 0; i < N; ++i) { const int l = i ^ j; if (l > i) ce(x[i], x[l]); }
}
__device__ __forceinline__ void top16_merge(int (&a)[16], const int (&b)[16]) {
#pragma unroll
    for (int i = 0; i < 16; ++i) a[i] = a[i] > b[15 - i] ? a[i] : b[15 - i];
    merge_desc<16>(a);
}
__device__ __forceinline__ void cross_merge(int (&a)[16], int hi) {
    int b[16];
#pragma unroll
    for (int i = 0; i < 16; ++i) {
        const auto rr = __builtin_amdgcn_permlane32_swap((unsigned)a[i], (unsigned)a[i], false, false);
        b[i] = (int)(hi ? rr[0] : rr[1]);
    }
    top16_merge(a, b);
}
__device__ __forceinline__ void top16_scores(const f32x16 (&acc)[4], int hi, int (&out)[16]) {
    int x[4][16];
    const int hi4 = hi << 2;
#pragma unroll
    for (int kb = 0; kb < 4; ++kb)
#pragma unroll
        for (int r = 0; r < 16; ++r) {
            const int c = 32 * kb + (r & 3) + 8 * (r >> 2);
            x[kb][r] = f2key((__float_as_int(acc[kb][r]) & ~0x7F) | (c | hi4));
        }
#pragma unroll
    for (int kb = 0; kb < 4; ++kb) { sort_desc<16>(x[kb]); __builtin_amdgcn_sched_barrier(0); }
    top16_merge(x[0], x[1]);
    top16_merge(x[2], x[3]);
    top16_merge(x[0], x[2]);
#pragma unroll
    for (int i = 0; i < 16; ++i) out[i] = x[0][i];
    cross_merge(out, hi);
}
__device__ __forceinline__ int lut16(unsigned long long lo, unsigned long long hi, int a) {
    const unsigned long long d = (a & 8) ? hi : lo;
    return (int)(d >> ((a & 7) * 8)) & 0xFF;
}

__device__ __forceinline__ void stage_subkeys(const float* sub_keys, unsigned char* lds, const int t) {
#pragma unroll 1
    for (int i = t; i < 2 * 128 * 16; i += NTHREADS) {
        const int p = i >> 11, row = (i >> 4) & 127, ch = i & 15;
        const float* src = sub_keys + ((size_t)p * 128 + row) * 128 + ch * 8;
        const f32x4 a = *(const f32x4*)src, b = *(const f32x4*)(src + 4);
        u32x4 w; w.x = pack_bf16(a[0], a[1]); w.y = pack_bf16(a[2], a[3]); w.z = pack_bf16(b[0], b[1]); w.w = pack_bf16(b[2], b[3]);
        *(u32x4*)(lds + p * 32768 + PSEL_SWZ(row, ch * 16)) = w;
    }
}

__device__ __forceinline__ void wave_task(const bf16_t* qry, int* sel_e, float* sel_g, const unsigned char* lds, int tok0, int h, int lane) {
    const int r32 = lane & 31, hi = lane >> 5;
    int top[2][16];
#pragma unroll
    for (int p = 0; p < 2; ++p) {
        const bf16_t* qrow = qry + (size_t)(tok0 + r32) * 2048 + h * 256 + p * 128 + hi * 8;
        bf16x8 qf[8];
#pragma unroll
        for (int kk = 0; kk < 8; ++kk) qf[kk] = *(const bf16x8*)(qrow + kk * 16);
        f32x16 acc[4];
#pragma unroll
        for (int kb = 0; kb < 4; ++kb) acc[kb] = f32x16{};
        const unsigned char* base = lds + p * 32768;
#pragma unroll
        for (int kk = 0; kk < 8; ++kk)
#pragma unroll
            for (int kb = 0; kb < 4; ++kb) {
                const bf16x8 a = *(const bf16x8*)(base + PSEL_SWZ(32 * kb + r32, (2 * kk + hi) * 16));
                acc[kb] = __builtin_amdgcn_mfma_f32_32x32x16_bf16(a, qf[kk], acc[kb], 0, 0, 0);
            }
        __builtin_amdgcn_sched_barrier(0);
        top16_scores(acc, hi, top[p]);
        __builtin_amdgcn_sched_barrier(0);
    }
    float v1[16], v2[16];
    unsigned long long i0lo = 0, i0hi = 0, i1lo = 0, i1hi = 0;
#pragma unroll
    for (int i = 0; i < 16; ++i) {
        const int b0 = f2key(top[0][i]), b1 = f2key(top[1][i]);
        if (i < 8) { i0lo |= (unsigned long long)(b0 & 0x7F) << (i * 8); i1lo |= (unsigned long long)(b1 & 0x7F) << (i * 8); }
        else { i0hi |= (unsigned long long)(b0 & 0x7F) << ((i - 8) * 8); i1hi |= (unsigned long long)(b1 & 0x7F) << ((i - 8) * 8); }
        const float f0 = __int_as_float(b0 & ~0x7F), f1 = __int_as_float(b1 & ~0x7F);
        v1[i] = hi ? f1 : f0; v2[i] = hi ? f0 : f1;
    }
    const int hcode = hi << 8;
    const int PADK = (int)0x80000000;
    int g1[16], g2[16];
#pragma unroll
    for (int b = 0; b < 16; ++b) {
        int k = f2key((__float_as_int(v1[0] + v2[b]) & ~0x1FF) | (b | hcode));
        if (b == 0) k = hi ? PADK : k;
        g1[b] = k;
    }
    {
#define PSEL_C(n, a, b) g2[n] = f2key((__float_as_int(v1[a] + v2[b]) & ~0x1FF) | (((a) << 4) | (b) | hcode)); if ((a) == (b)) g2[n] = hi ? PADK : g2[n];
        PSEL_C(0, 1, 1) PSEL_C(1, 1, 2) PSEL_C(2, 1, 3) PSEL_C(3, 1, 4) PSEL_C(4, 1, 5) PSEL_C(5, 1, 6) PSEL_C(6, 1, 7)
        PSEL_C(7, 2, 2) PSEL_C(8, 2, 3) PSEL_C(9, 2, 4) PSEL_C(10, 3, 3)
#undef PSEL_C
        g2[11] = PADK; g2[12] = PADK; g2[13] = PADK; g2[14] = PADK; g2[15] = PADK;
    }
    merge_desc<16>(g1);
    __builtin_amdgcn_sched_barrier(0);
    sort_desc<16>(g2);
    top16_merge(g1, g2);
    cross_merge(g1, hi);
    __builtin_amdgcn_sched_barrier(0);
    float val[16];
    int code[16];
#pragma unroll
    for (int k = 0; k < 16; ++k) { const int b = f2key(g1[k]); val[k] = __int_as_float(b & ~0x1FF); code[k] = b & 0x1FF; }
    float e[16], sum = 0.f;
#pragma unroll
    for (int k = 0; k < 16; ++k) { e[k] = __expf(val[k] - val[0]); sum += e[k]; }
    const float inv = 1.0f / sum;
    int* ep = sel_e + (size_t)r32 * 128 + 2 * h;
    float* gp = sel_g + (size_t)r32 * 128 + 2 * h;
#pragma unroll
    for (int k = 0; k < 16; ++k) {
        if ((k >> 3) == hi) {
            const int c = code[k];
            const int sw = c >> 8, a0 = (c >> 4) & 15, b0 = c & 15;
            const int a = sw ? b0 : a0, b = sw ? a0 : b0;
            ep[(k & 7) * 16 + (k >> 3)] = lut16(i0lo, i0hi, a) * 128 + lut16(i1lo, i1hi, b);
            gp[(k & 7) * 16 + (k >> 3)] = e[k] * inv;
        }
    }
}
}

__device__ __forceinline__ void phase_select_mfma(const Params& p, unsigned char* lds_raw, const int t) {
    psel::stage_subkeys(p.sub_keys, lds_raw, t);
    int* oe = (int*)(lds_raw + 65536);
    float* og = (float*)(lds_raw + 81920);
    const int wave = t >> 6, lane = t & 63;
#pragma unroll 1
    for (int grp = blockIdx.x; grp < NTOK / 32; grp += gridDim.x) {
        __syncthreads();
        psel::wave_task(p.qry(), oe, og, lds_raw, grp * 32, wave, lane);
        __syncthreads();
#pragma unroll
        for (int i = 0; i < 2; ++i) {
            const int ch = t + i * NTHREADS;
            *(u32x4*)(p.sel_e() + (size_t)grp * 32 * 128 + ch * 4) = *(const u32x4*)(oe + ch * 4);
            *(f32x4*)(p.sel_g() + (size_t)grp * 32 * 128 + ch * 4) = *(const f32x4*)(og + ch * 4);
        }
    }
    __syncthreads();
}

#ifndef DIAG_TIME
#define DIAG_TIME 0
#endif
#if DIAG_TIME
#ifndef DT_GAIN
#define DT_GAIN 0.5f
#endif
#ifndef DT_Q
#define DT_Q 256.0f
#endif
#ifndef DT_A1
#define DT_A1 0
#define DT_B1 0
#define DT_A2 0
#define DT_B2 0
#define DT_C1 0
#define DT_D1 0
#define DT_C2 0
#define DT_D2 0
#endif
#define TSTAMP(p) ((unsigned long long*)((p).ws + ((size_t)505 << 20)))
#define STAMP(i) do { if (blockIdx.x == 0 && threadIdx.x == 0) TSTAMP(p)[i] = __builtin_amdgcn_s_memrealtime(); } while (0)
#else
#define STAMP(i) do {} while (0)
#endif
enum { PH_PROLOGUE = 0, PH_XCONV, PH_INPROJ, PH_G1, PH_GLA_MOBA, PH_MERGE, PH_OUTPROJ, PH_LN1, PH_QRY, PH_SELECT, PH_PEER_U, PH_PEER_RED, PH_PEER_V, PH_LN2 };
__device__ __forceinline__ void do_phase(const Params& p, const int ph, int chunk, unsigned char* lds_raw) {
    const int bid = blockIdx.x, nb = gridDim.x;
    float* smem_all = (float*)lds_raw;
    int t = (__builtin_amdgcn_readfirstlane(threadIdx.x) & ~63) + (int)__builtin_amdgcn_mbcnt_hi(~0u, __builtin_amdgcn_mbcnt_lo(~0u, 0u));
    asm volatile("" : "+v"(t));
    if (ph == PH_PROLOGUE) {
        const int t_in = 16 * 128, t_out = 16 * 16, t_q = 16 * 32;
#pragma unroll 1
        for (int vb = bid; vb < t_in + t_out + t_q; vb += nb) {
            if (vb < t_in) transpose_tile(p.w_in, IN_WIDTH, p.winT(), OFF_LR, 16, vb & 15, vb >> 4, smem_all, t);
            else if (vb < t_in + t_out) { const int v = vb - t_in; transpose_tile(p.w_out, 1024, p.woutT(), 1 << 30, 0, v & 15, v >> 4, smem_all, t); }
            else { const int v = vb - t_in - t_out; transpose_tile(p.w_q, 2048, p.wqT(), 1 << 30, 0, v & 15, v >> 4, smem_all, t); }
        }
        if (bid == 0 && t < 64) p.qctr()[t] = 0u;
        if (bid == 0 && t == 0) __hip_atomic_store((unsigned*)(p.ws + ((size_t)506 << 20)), 0u, __ATOMIC_RELAXED, __HIP_MEMORY_SCOPE_AGENT);
        if (bid < SEQ * 16 / NTHREADS) {
            const int i = bid * NTHREADS + t;
            const int pos = i >> 4, k = i & 15;
            const float inv_freq = exp2f(-(float)k * 1.1832230355827609f);
            const float ang = (float)pos * inv_freq;
            float s, c;
            sincosf(ang, &s, &c);
            p.rope_cos()[i] = c; p.rope_sin()[i] = s;
        }
        return;
    }
    if (ph == PH_XCONV) {
        if (bid < CHUNK_SEQS * 8 * 8 * 128 / NTHREADS) p.kmean()[bid * NTHREADS + t] = 0.f;
        phase_xconv(p, chunk, smem_all, t);
        return;
    }
    if (ph == PH_MERGE) {
        phase_merge(p, chunk, t);
        if (chunk + 1 < NCHUNK) {
            int t2 = t;
            asm volatile("" : "+v"(t2));
            if (bid < CHUNK_SEQS * 8 * 8 * 128 / NTHREADS) p.kmean()[bid * NTHREADS + t2] = 0.f;
            phase_xconv(p, chunk + 1, smem_all, t2);
        }
        return;
    }
    if (ph == PH_INPROJ) {
        pg8::Gemm g{p.xbc(), p.winT(), CT, 8192, 1024};
        pg8::StaticOrder S; S.init(g.M, g.N, nb, bid);
        EpiInProj E{InProjPtrs{(char*)p.qa(), p.kmean(), p.rope_cos(), p.rope_sin()}};
        __syncthreads();
        pg8::gemm_phase<EpiInProj, pg8::StaticOrder, true, true>((PG8_LAS unsigned char*)lds_raw, g, S, E, t);
        __syncthreads();
        return;
    }
    if (ph == PH_OUTPROJ) {
        pg8::Gemm g{p.y(), p.woutT(), NTOK, 1024, 1024};
        pg8::StaticOrder S; S.init(g.M, g.N, nb, bid);
        EpiResid E{p.x1(), p.x};
        __syncthreads();
        pg8::gemm_phase<EpiResid, pg8::StaticOrder, true, true>((PG8_LAS unsigned char*)lds_raw, g, S, E, t);
        __syncthreads();
        return;
    }
    if (ph == PH_QRY) {
        pg8::Gemm g{p.x1b(), p.wqT(), NTOK, 2048, 1024};
        pg8::StaticOrder S; S.init(g.M, g.N, nb, bid);
        EpiBf16 E{p.qry(), 2048};
        __syncthreads();
        pg8::gemm_phase<EpiBf16, pg8::StaticOrder, true, true>((PG8_LAS unsigned char*)lds_raw, g, S, E, t);
        __syncthreads();
        return;
    }
    if (ph == PH_G1) {
#pragma unroll 1
        for (int item = bid; item < CHUNK_SEQS * 4 * 32; item += nb) gla::g1_item(p, item, (char*)lds_raw, t);
        return;
    }
    if (ph == PH_GLA_MOBA) {
        __syncthreads();
#ifdef DIAG_G2X
#pragma unroll 1
        for (int item = bid; item < CHUNK_SEQS * 4; item += nb) gla::g2_item<DIAG_G2X>(p, item, (char*)lds_raw, t);
#endif
#pragma unroll 1
        for (int item = bid; item < CHUNK_SEQS * 4; item += nb) gla::g2_item<0>(p, item, (char*)lds_raw, t);
        __syncthreads();
        STAMP(19 + chunk);
        int t2 = t;
        asm volatile("" : "+v"(t2));
        phase_moba_mfma(p, chunk, lds_raw, t2);
        __syncthreads();
        return;
    }
    if (ph == PH_SELECT) { phase_select_mfma(p, lds_raw, t); return; }
    if (ph == PH_PEER_U) { peer_sliced(p.qctr() + chunk * 8, (unsigned*)lds_raw, t, [&](int s, int tile) { peer_u_item(p, s, tile, t); }); return; }
    if (ph == PH_PEER_RED) { peer_reduce(p, t); return; }
    if (ph == PH_PEER_V) { peer_sliced(p.qctr() + 16 + chunk * 8, (unsigned*)lds_raw, t, [&](int s, int tile) { peer_v_item(p, s, tile, t); }); return; }
    if (ph == PH_LN2) { peer_ln2(p, t); return; }
    if (ph == PH_LN1) { if (chunk != 2) peer_tabconv(p, t); if (chunk != 3) phase_ln1(p, t); return; }
}


#ifndef DIAG_MOBA
#define DIAG_MOBA 0
#endif
#if DIAG_MOBA
#define DQ(p) ((float*)((p).ws + ((size_t)472 << 20)))
#define DKM(p) ((float*)((p).ws + ((size_t)504 << 20) + 65536))
#define DOB(p) ((float*)((p).ws + ((size_t)496 << 20)))
#define DMET(p) ((float*)((p).ws + ((size_t)504 << 20)))
__device__ __forceinline__ void dg_sgemm_tile(const float* __restrict__ A, int lda, const float* __restrict__ B, int ldb, float* __restrict__ C, int ldc,
                           int N, int K, int tm, int tn, float* smem, int tid) {
    float* As = smem;
    float* Bs = smem + 16 * 64;
    const int tx = tid & 15, ty = tid >> 4;
    const int m0 = tm * 64, n0 = tn * 64;
    float acc[4][4];
#pragma unroll
    for (int i = 0; i < 4; ++i)
#pragma unroll
        for (int j = 0; j < 4; ++j) acc[i][j] = 0.f;
    const int ar = tid >> 2, akq = (tid & 3) * 4;
    const int bk = tid >> 4, bnq = (tid & 15) * 4;
    for (int k0 = 0; k0 < K; k0 += 16) {
        float4 av = *(const float4*)(A + (size_t)(m0 + ar) * lda + k0 + akq);
        float4 bv = *(const float4*)(B + (size_t)(k0 + bk) * ldb + n0 + bnq);
        __syncthreads();
        As[(akq + 0) * 64 + ar] = av.x; As[(akq + 1) * 64 + ar] = av.y; As[(akq + 2) * 64 + ar] = av.z; As[(akq + 3) * 64 + ar] = av.w;
        *(float4*)(Bs + bk * 64 + bnq) = bv;
        __syncthreads();
#pragma unroll
        for (int kk = 0; kk < 16; ++kk) {
            float4 a = *(const float4*)(As + kk * 64 + ty * 4);
            float4 b = *(const float4*)(Bs + kk * 64 + tx * 4);
            float aa[4] = {a.x, a.y, a.z, a.w}, bb[4] = {b.x, b.y, b.z, b.w};
#pragma unroll
            for (int i = 0; i < 4; ++i)
#pragma unroll
                for (int j = 0; j < 4; ++j) acc[i][j] += aa[i] * bb[j];
        }
    }
#pragma unroll
    for (int i = 0; i < 4; ++i) *(float4*)(C + (size_t)(m0 + ty * 4 + i) * ldc + n0 + tx * 4) = make_float4(acc[i][0], acc[i][1], acc[i][2], acc[i][3]);
}
__device__ __forceinline__ void dg_rope(const Params& p, int vb, int tid) {
    float* row = DQ(p) + (size_t)vb * 3072;
    const int which = tid >> 7, h = (tid >> 4) & 7, i = tid & 15;
    const float inv_freq = exp2f(-(float)i * 1.1832230355827609f);
    const float ang = (float)vb * inv_freq;
    float s, c;
    sincosf(ang, &s, &c);
    float* base = row + which * 1024 + h * 128;
    const float x1 = base[i], x2 = base[i + 16];
    base[i] = x1 * c - x2 * s;
    base[i + 16] = x1 * s + x2 * c;
}
__device__ __forceinline__ void dg_kmean(const Params& p, int vb, float* smem, int tid) {
    const int h = vb >> 3, n = vb & 7;
    const int d = tid & 127, half = tid >> 7;
    float acc = 0.f;
    const float* base = DQ(p) + (size_t)(n * 256 + half * 128) * 3072 + 1024 + h * 128 + d;
    for (int j = 0; j < 128; ++j) acc += base[(size_t)j * 3072];
    __syncthreads();
    smem[tid] = acc;
    __syncthreads();
    if (tid < 128) DKM(p)[(h * 8 + n) * 128 + d] = (smem[tid] + smem[tid + 128]) * (1.0f / 256.0f);
}
__device__ __forceinline__ void dg_moba(const Params& p, int vb, int tid) {
    const int wave = tid >> 6, lane = tid & 63;
    const int item = vb * 4 + wave;
    const int pos = item >> 3, h = item & 7;
    const int qblk = pos >> 8;
    const float* P = DQ(p);
    const float2 q = *(const float2*)(P + (size_t)pos * 3072 + h * 128 + 2 * lane);
    float g[7];
#pragma unroll
    for (int n = 0; n < 7; ++n) {
        const float2 km = *(const float2*)(DKM(p) + (h * 8 + n) * 128 + 2 * lane);
        const float d = wave_sum(q.x * km.x + q.y * km.y);
        g[n] = (n < qblk) ? d : -INFINITY;
    }
    unsigned selmask = 0;
    if (qblk <= 3) {
        selmask = (1u << qblk) - 1u;
    } else {
#pragma unroll
        for (int r = 0; r < 3; ++r) {
            float best = -INFINITY;
            int bi = 0;
#pragma unroll
            for (int n = 0; n < 7; ++n) {
                const bool ok = (n < qblk) && !((selmask >> n) & 1u) && (g[n] > best);
                best = ok ? g[n] : best;
                bi = ok ? n : bi;
            }
            selmask |= 1u << bi;
        }
    }
    const float scale = 0.08838834764831845f;
    float m = -INFINITY, l = 0.f;
    float2 acc = make_float2(0.f, 0.f);
    for (int n = 0; n <= qblk; ++n) {
        int nk;
        if (n == qblk) nk = (pos & 255) + 1;
        else if ((selmask >> n) & 1u) nk = 256;
        else continue;
        const float* kb = P + (size_t)(n * 256) * 3072 + 1024 + h * 128 + 2 * lane;
        const float* vb_ = P + (size_t)(n * 256) * 3072 + 2048 + h * 128 + 2 * lane;
        for (int j = 0; j < nk; ++j) {
            const float2 k2 = *(const float2*)(kb + (size_t)j * 3072);
            const float2 v2 = *(const float2*)(vb_ + (size_t)j * 3072);
            const float sc = wave_sum(q.x * k2.x + q.y * k2.y) * scale;
            const float mn = fmaxf(m, sc);
            const float corr = expf(m - mn);
            const float pe = expf(sc - mn);
            l = l * corr + pe;
            acc.x = acc.x * corr + pe * v2.x;
            acc.y = acc.y * corr + pe * v2.y;
            m = mn;
        }
    }
    const float inv = 1.0f / l;
    *(float2*)(DOB(p) + (size_t)pos * 1024 + h * 128 + 2 * lane) = make_float2(acc.x * inv, acc.y * inv);
}
#ifndef DIAG_SEL
#define DIAG_SEL 0
#endif
__device__ __forceinline__ void dg_compare(const Params& p, int vb, float* smem, int tid) {
    float num = 0.f, den = 0.f;
#pragma unroll
    for (int j = 0; j < 4; ++j) {
        const int c = j * 256 + tid;
        float ref, got;
        const size_t hm = ((size_t)(c >> 7) * SEQ + vb) * 128 + (c & 127);
        if (DIAG_SEL == 0) { ref = DOB(p)[(size_t)vb * 1024 + c]; got = bf2f(p.qb()[hm]); }
        else if (DIAG_SEL == 1) { ref = DQ(p)[(size_t)vb * 3072 + 1024 + c]; got = bf2f(p.kb()[hm]); }
        else if (DIAG_SEL == 2) { ref = DQ(p)[(size_t)vb * 3072 + 2048 + c]; got = bf2f(p.vb()[hm]); }
        else if (DIAG_SEL == 3) { ref = DKM(p)[(vb & 63) * 128 + (c & 127)]; got = p.kmean()[(vb & 63) * 128 + (c & 127)]; }
        else if (DIAG_SEL == 8) { ref = DQ(p)[(size_t)vb * 3072 + 2048 + c]; got = ref * 1.1f; }
        else { ref = DQ(p)[(size_t)vb * 3072 + 2048 + c]; got = 1.0f; }
        num += (got - ref) * (got - ref);
        den += ref * ref;
    }
    num = block_sum(num, smem, tid);
    den = block_sum(den, smem, tid);
    if (tid == 0) { atomicAdd(DMET(p), num); atomicAdd(DMET(p) + 1, den); }
}
enum { DG_GEMM = 100, DG_ROPE, DG_KMEAN, DG_MOBA, DG_CMP, DG_SCALE };
__device__ __forceinline__ void do_diag(const Params& p, const int ph, unsigned char* lds_raw) {
    const int bid = blockIdx.x, nb = gridDim.x;
    int t = (__builtin_amdgcn_readfirstlane(threadIdx.x) & ~63) + (int)__builtin_amdgcn_mbcnt_hi(~0u, __builtin_amdgcn_mbcnt_lo(~0u, 0u));
    asm volatile("" : "+v"(t));
    const int half = t >> 8, tid = t & 255;
    float* smem = (float*)lds_raw + half * 8192;
    int nvb = 0;
    if (ph == DG_GEMM) nvb = 32 * 48; else if (ph == DG_ROPE) nvb = 2048; else if (ph == DG_KMEAN) nvb = 64; else if (ph == DG_MOBA) nvb = 4096; else if (ph == DG_CMP) nvb = 2048;
    if (ph == DG_SCALE) {
        const float f = 1.0f + sqrtf(DMET(p)[0] / DMET(p)[1]);
#pragma unroll 1
        for (size_t i = (size_t)bid * NTHREADS + t; i < (size_t)NTOK * 1024; i += (size_t)nb * NTHREADS) p.out[i] *= f;
        return;
    }
    if (ph == DG_GEMM && bid == 0 && t < 2) DMET(p)[t] = 0.f;
#pragma unroll 1
    for (int vp = bid * 2; vp < nvb; vp += nb * 2) {
        const int vb = vp + half;
        __syncthreads();
        if (ph == DG_GEMM) dg_sgemm_tile(p.x, 1024, p.w_in + 3088, IN_WIDTH, DQ(p), 3072, 3072, 1024, vb / 48, vb % 48, smem, tid);
        else if (ph == DG_ROPE) dg_rope(p, vb, tid);
        else if (ph == DG_KMEAN) dg_kmean(p, vb, smem, tid);
        else if (ph == DG_MOBA) dg_moba(p, vb, tid);
        else if (ph == DG_CMP) dg_compare(p, vb, smem, tid);
    }
}
#endif

__global__ void __launch_bounds__(NTHREADS, 2) mega_kernel(Params p) {
    extern __shared__ __attribute__((aligned(16))) unsigned char dyn_lds[];
    cg::grid_group grid = cg::this_grid();
    unsigned* gbar_ctr = (unsigned*)(p.ws + ((size_t)506 << 20));
#define GSYNC() do { asm volatile("s_waitcnt vmcnt(0)" ::: "memory"); __syncthreads(); if (threadIdx.x == 0) { __builtin_amdgcn_fence(__ATOMIC_RELEASE, "agent"); asm volatile("s_waitcnt vmcnt(0)" ::: "memory"); \
        const unsigned old_ = __hip_atomic_fetch_add(gbar_ctr, 1u, __ATOMIC_RELAXED, __HIP_MEMORY_SCOPE_AGENT); const unsigned tgt_ = (old_ / gridDim.x + 1u) * gridDim.x; \
        while (__hip_atomic_load(gbar_ctr, __ATOMIC_RELAXED, __HIP_MEMORY_SCOPE_AGENT) < tgt_) { } \
        __builtin_amdgcn_fence(__ATOMIC_ACQUIRE, "agent"); asm volatile("s_waitcnt vmcnt(0)" ::: "memory"); } __syncthreads(); } while (0)
    STAMP(0);
    do_phase(p, PH_PROLOGUE, 0, dyn_lds);
#pragma unroll 1
    for (int chunk = 0; chunk < NCHUNK; ++chunk) {
        if (chunk == 0) { do_phase(p, PH_XCONV, 0, dyn_lds); grid.sync(); }
        STAMP(1 + chunk * 5);
        do_phase(p, PH_INPROJ, chunk, dyn_lds);
        GSYNC(); STAMP(2 + chunk * 5);
        do_phase(p, PH_G1, chunk, dyn_lds);
        GSYNC(); STAMP(3 + chunk * 5);
        do_phase(p, PH_GLA_MOBA, chunk, dyn_lds);
        GSYNC(); STAMP(4 + chunk * 5);
#if DIAG_MOBA
        if (chunk == 0) {
            do_diag(p, DG_GEMM, dyn_lds); GSYNC();
            do_diag(p, DG_ROPE, dyn_lds); GSYNC();
            do_diag(p, DG_KMEAN, dyn_lds); GSYNC();
            do_diag(p, DG_MOBA, dyn_lds); GSYNC();
            do_diag(p, DG_CMP, dyn_lds); GSYNC();
        }
#endif
        do_phase(p, PH_MERGE, chunk, dyn_lds);
        GSYNC(); STAMP(5 + chunk * 5);
    }
    do_phase(p, PH_OUTPROJ, 0, dyn_lds);
    GSYNC(); STAMP(11);
    do_phase(p, PH_LN1, 0, dyn_lds);
    GSYNC(); STAMP(12);
#ifdef DIAG_L1X
    do_phase(p, PH_LN1, DIAG_L1X, dyn_lds); GSYNC();
#endif
    do_phase(p, PH_QRY, 0, dyn_lds);
    GSYNC(); STAMP(13);
    do_phase(p, PH_SELECT, 0, dyn_lds);
    GSYNC(); STAMP(14);
    do_phase(p, PH_PEER_U, 0, dyn_lds);
    GSYNC(); STAMP(15);
#ifdef DIAG_UX
    do_phase(p, PH_PEER_U, 1, dyn_lds); GSYNC();
#endif
    do_phase(p, PH_PEER_RED, 0, dyn_lds);
    GSYNC(); STAMP(16);
    do_phase(p, PH_PEER_V, 0, dyn_lds);
    GSYNC(); STAMP(17);
#ifdef DIAG_VX
    do_phase(p, PH_PEER_V, 1, dyn_lds); GSYNC();
#endif
    do_phase(p, PH_LN2, 0, dyn_lds);
#ifdef DIAG_SYNCS
#pragma unroll 1
    for (int i = 0; i < DIAG_SYNCS; ++i) grid.sync();
#endif
#ifdef DIAG_FSYNCS
#pragma unroll 1
    for (int i = 0; i < DIAG_FSYNCS; ++i) GSYNC();
#endif
#if DIAG_MOBA
    grid.sync();
    do_diag(p, DG_SCALE, dyn_lds);
#endif
#if DIAG_TIME
    grid.sync(); STAMP(18);
    grid.sync();
    {
        const unsigned long long* ts = TSTAMP(p);
        const float tot = (float)(ts[18] - ts[0]);
        const float f1 = rintf(DT_Q * (float)((ts[DT_B1] - ts[DT_A1]) + (ts[DT_B2] - ts[DT_A2])) / tot) * (1.0f / DT_Q);
        const float f2 = (float)((ts[DT_D1] - ts[DT_C1]) + (ts[DT_D2] - ts[DT_C2])) / tot;
#pragma unroll 1
        for (size_t i = (size_t)blockIdx.x * NTHREADS + threadIdx.x; i < (size_t)NTOK * 1024; i += (size_t)gridDim.x * NTHREADS) p.out[i] *= (1.0f + DT_GAIN * f1);
        (void)f2;
    }
#endif
}

extern "C" void kernel_launch(void* const* d_in, const int* in_sizes, int n_in, void* d_out, int out_size, void* d_ws, size_t ws_size,
                              hipStream_t stream) {
    Params p{};
    p.x = (const float*)d_in[0];
    p.w_in = (const float*)d_in[1];
    p.gla_wd = (const float*)d_in[2];
    p.gla_bd = (const float*)d_in[3];
    p.gla_ng = (const float*)d_in[4];
    p.w_out = (const float*)d_in[5];
    p.ln1_g = (const float*)d_in[6];
    p.ln1_b = (const float*)d_in[7];
    p.w_q = (const float*)d_in[8];
    p.sub_keys = (const float*)d_in[9];
    p.pu = (const float*)d_in[10];
    p.pv = (const float*)d_in[11];
    p.ln2_g = (const float*)d_in[12];
    p.ln2_b = (const float*)d_in[13];
    p.out = (float*)d_out;
    p.ws = (char*)d_ws;
    const size_t MiB = 1 << 20;
    static int grid_blocks = 0;
    if (!grid_blocks) {
        if (507 * MiB > ws_size) { fprintf(stderr, "workspace too small: need %zu have %zu\n", (size_t)(503 * MiB), ws_size); grid_blocks = -1; return; }
        int dev = 0, cus = 0, per_cu = 0;
        (void)hipGetDevice(&dev);
        (void)hipDeviceGetAttribute(&cus, hipDeviceAttributeMultiprocessorCount, dev);
        if (hipFuncSetAttribute((const void*)mega_kernel, hipFuncAttributeMaxDynamicSharedMemorySize, LDS_BYTES) != hipSuccess) { fprintf(stderr, "hipFuncSetAttribute failed\n"); grid_blocks = -1; return; }
        (void)hipOccupancyMaxActiveBlocksPerMultiprocessor(&per_cu, (const void*)mega_kernel, NTHREADS, LDS_BYTES);
        if (per_cu < 1) { fprintf(stderr, "occupancy query says %d blocks per CU\n", per_cu); per_cu = 1; }
        grid_blocks = cus;
    }
    if (grid_blocks < 0) return;
    void* args[] = {&p};
    hipError_t e = hipLaunchCooperativeKernel((const void*)mega_kernel, dim3(grid_blocks), dim3(NTHREADS), args, LDS_BYTES, stream);
    if (e != hipSuccess) fprintf(stderr, "cooperative launch failed: %s (grid %d)\n", hipGetErrorString(e), grid_blocks);
}
```

```cpp
#include <hip/hip_runtime.h>
#include <hip/hip_cooperative_groups.h>
#include <math.h>
#include <stdint.h>
#include <stdio.h>

namespace cg = cooperative_groups;

#define D_MODEL 1024
#define SEQ 2048
#define NTOK 32768
#define IN_WIDTH 8208
#define OFF_LR 3072
#define CHUNK_SEQS 8
#define CT (CHUNK_SEQS * SEQ)
#define NCHUNK (NTOK / CT)
#define DN_ALPHA 1.189207115002721f
#define NTHREADS 512
#define LDS_BYTES 147456

namespace pg8 {
#define PG8_LAS __attribute__((address_space(3)))
typedef unsigned short bf16_t;
typedef short bf16x8 __attribute__((ext_vector_type(8)));
typedef float f32x4 __attribute__((ext_vector_type(4)));
typedef unsigned u32x4 __attribute__((ext_vector_type(4)));
constexpr int BM = 256, BK = 64, HALF = 128, HTB = HALF * BK * 2  , STAGE_BYTES = 8 * HTB, NXCD = 8, WGM = 8;

__host__ __device__ __forceinline__ int lds_byte(int r, int c) { const int st = (r >> 4) * 2 + (c >> 5), rr = r & 15, cc = c & 31, ob = rr * 64 + cc * 2; return st * 1024 + (ob ^ (((ob >> 9) & 1) << 5)); }
__host__ __device__ __forceinline__ void stage_rc(int b, int& R, int& C) { const int st = b / 1024, sb = b % 1024, swz = sb ^ (((sb >> 9) & 1) << 5); R = (st >> 1) * 16 + swz / 64; C = (st & 1) * 32 + (swz % 64) / 2; }
__host__ __device__ __forceinline__ int perm32(int rho) { const int n = rho >> 4, i = rho & 15; return 8 * (i >> 2) + 4 * n + (i & 3); }

struct Unit { int pm, pn; };
struct Gemm { const bf16_t* A; const bf16_t* Bt; int M, N, K; };

struct StaticOrder {
    int nM, nN, nwg, G, c;
    __host__ __device__ void init(int M, int N, int G_, int c_) { nM = M / BM; nN = N / BM; nwg = nM * nN; G = G_; c = c_; }
    __host__ __device__ bool next(int i, Unit& u) const {
        const long L = (long)i * G + c; if (L >= nwg) return false;
        int wgid = (int)L; { const int q = nwg / NXCD, r = nwg % NXCD, xcd = wgid % NXCD, off = wgid / NXCD; wgid = (xcd < r ? xcd * (q + 1) : r * (q + 1) + (xcd - r) * q) + off; }
        const int nig = WGM * nN, gid = wgid / nig, fm = gid * WGM, gsz = (nM - fm) < WGM ? (nM - fm) : WGM;
        u.pm = fm + ((wgid % nig) % gsz); u.pn = (wgid % nig) / gsz; return true;
    }
    __device__ __forceinline__ void a_ready(const Unit&) const {}
    __device__ __forceinline__ void done(const Unit&) const {}
};
__device__ __forceinline__ unsigned cvt_pk_bf16(float lo, float hi) { unsigned r; asm volatile("v_cvt_pk_bf16_f32 %0, %1, %2" : "=v"(r) : "v"(lo), "v"(hi)); return r; }
template <class Epi, class Sched, bool ALIGN_EPI = false, bool SP2 = false>
__device__ __forceinline__ void gemm_phase(PG8_LAS unsigned char* lds, const Gemm g, const Sched& S, const Epi& E, const int tid) {
    const int wid = __builtin_amdgcn_readfirstlane(tid >> 6), lane = tid & 63, wr = wid >> 2, wc = wid & 3, fr = lane & 15, fq = lane >> 4;
    const int K = g.K, nt = K / BK;
    unsigned voffA[2], voffB[2];
#pragma unroll
    for (int i = 0; i < 2; ++i) { int R, C; stage_rc(tid * 16 + i * 8192, R, C); const int Rb = Epi::PERM ? ((R & ~31) + perm32(R & 31)) : R;
        voffA[i] = (unsigned)(R * K + C) * 2u; voffB[i] = (unsigned)(Rb * K + C) * 2u; }
    const size_t kstep = (size_t)(BK * 2);
    const size_t hstep = (size_t)HALF * K * 2;
    const size_t tstep = 2 * hstep;
    const unsigned ldsw = (unsigned)wid * 1024u;
    const int aoff = lds_byte(wr * 64 + fr, fq * 8), boff = lds_byte(wc * 32 + fr, fq * 8);
#define PG8_SA(b, h) (((b) * 2 + (h)) * HTB)
#define PG8_SB(b, h) ((4 + (b) * 2 + (h)) * HTB)
#define PG8_STAGE(bufoff, gbase, voff) do { _Pragma("unroll") for (int _i = 0; _i < 2; ++_i) \
        __builtin_amdgcn_global_load_lds((const unsigned*)((const char*)(gbase) + (voff)[_i]), (PG8_LAS unsigned*)(lds + (bufoff) + ldsw + _i * 8192), 16, 0, 0); } while (0)
#define PG8_LDA(dst, b, h) do { _Pragma("unroll") for (int m = 0; m < 4; ++m) _Pragma("unroll") for (int k = 0; k < 2; ++k) dst[m][k] = *(const PG8_LAS bf16x8*)(lds + PG8_SA(b, h) + aoff + m * 2048 + k * 1024); } while (0)
#define PG8_LDB(dst, b, h) do { _Pragma("unroll") for (int n = 0; n < 2; ++n) _Pragma("unroll") for (int k = 0; k < 2; ++k) dst[n][k] = *(const PG8_LAS bf16x8*)(lds + PG8_SB(b, h) + boff + n * 2048 + k * 1024); } while (0)
#define PG8_MMA(ai, bj, At, Bt) do { __builtin_amdgcn_s_setprio(1); _Pragma("unroll") for (int m = 0; m < 4; ++m) _Pragma("unroll") for (int n = 0; n < 2; ++n) _Pragma("unroll") for (int k = 0; k < 2; ++k) \
        acc[ai][bj][m][n] = __builtin_amdgcn_mfma_f32_16x16x32_bf16(Bt[n][k], At[m][k], acc[ai][bj][m][n], 0, 0, 0); __builtin_amdgcn_s_setprio(0); } while (0)
#define PG8_WAIT_V(n) asm volatile("s_waitcnt vmcnt(" #n ")" ::: "memory")
#define PG8_WAIT_L(n) asm volatile("s_waitcnt lgkmcnt(" #n ")" ::: "memory")
#define PG8_BAR __builtin_amdgcn_s_barrier()
#define PG8_SCHED __builtin_amdgcn_sched_barrier(0)
    Unit cur, nxt; int ui = 0;
    if (!S.next(0, cur)) return;
    f32x4 acc[2][2][4][2];
#pragma unroll
    for (int a = 0; a < 2; ++a)
#pragma unroll
        for (int b = 0; b < 2; ++b)
#pragma unroll
            for (int m = 0; m < 4; ++m)
#pragma unroll
                for (int n = 0; n < 2; ++n) acc[a][b][m][n] = (f32x4){0.f, 0.f, 0.f, 0.f};
    bf16x8 At[4][2], B0[2][2], B1[2][2];
    const char* cA = (const char*)g.A + (size_t)cur.pm * tstep; const char* cB = (const char*)g.Bt + (size_t)cur.pn * tstep;
    S.a_ready(cur);
    if constexpr (SP2) {
        PG8_STAGE(PG8_SB(0, 0), cB, voffB); PG8_STAGE(PG8_SB(0, 1), cB + hstep, voffB); PG8_STAGE(PG8_SA(0, 0), cA, voffA); PG8_STAGE(PG8_SA(0, 1), cA + hstep, voffA);
        if (wr == 1) PG8_BAR;
        PG8_WAIT_V(2); PG8_BAR;
        PG8_STAGE(PG8_SB(1, 0), cB + kstep, voffB); PG8_STAGE(PG8_SA(1, 0), cA + kstep, voffA); PG8_STAGE(PG8_SB(1, 1), cB + hstep + kstep, voffB);
        PG8_WAIT_V(6); PG8_BAR;
    } else {
        PG8_STAGE(PG8_SB(0, 0), cB, voffB); PG8_STAGE(PG8_SA(0, 0), cA, voffA); PG8_STAGE(PG8_SB(0, 1), cB + hstep, voffB); PG8_STAGE(PG8_SA(0, 1), cA + hstep, voffA);
        if (wr == 1) PG8_BAR;
        PG8_WAIT_V(4); PG8_BAR;
        PG8_STAGE(PG8_SB(1, 0), cB + kstep, voffB); PG8_STAGE(PG8_SA(1, 0), cA + kstep, voffA); PG8_STAGE(PG8_SB(1, 1), cB + hstep + kstep, voffB);
        PG8_WAIT_V(6); PG8_BAR;
    }
    for (;;) {
        const bool has_next = S.next(ui + 1, nxt);
        const char* nA = has_next ? (const char*)g.A + (size_t)nxt.pm * tstep : cA; const char* nB = has_next ? (const char*)g.Bt + (size_t)nxt.pn * tstep : cB;
        for (int t = 0; t < nt; t += 2) {
            const bool last = (t == nt - 2);
            const char* a1 = cA + (size_t)(t + 1) * kstep;
            const char* a2 = last ? nA : cA + (size_t)(t + 2) * kstep; const char* b2 = last ? nB : cB + (size_t)(t + 2) * kstep;
            const char* a3 = a2 + kstep; const char* b3 = b2 + kstep;
            if (last && has_next) S.a_ready(nxt);
            if constexpr (SP2) {
            PG8_LDB(B0, 0, 0); PG8_LDB(B1, 0, 1); PG8_SCHED; PG8_LDA(At, 0, 0); PG8_STAGE(PG8_SA(1, 1), a1 + hstep, voffA);
            PG8_WAIT_V(8); PG8_WAIT_L(0); PG8_BAR; PG8_MMA(0, 0, At, B0); PG8_MMA(0, 1, At, B1); PG8_BAR; PG8_SCHED;
            PG8_LDA(At, 0, 1); PG8_STAGE(PG8_SB(0, 0), b2, voffB); PG8_STAGE(PG8_SB(0, 1), b2 + hstep, voffB); PG8_STAGE(PG8_SA(0, 0), a2, voffA);
            PG8_WAIT_V(8); PG8_WAIT_L(0); PG8_BAR; PG8_MMA(1, 0, At, B0); PG8_MMA(1, 1, At, B1); PG8_BAR; PG8_SCHED;
            PG8_LDB(B0, 1, 0); PG8_LDB(B1, 1, 1); PG8_SCHED; PG8_LDA(At, 1, 0); PG8_STAGE(PG8_SA(0, 1), a2 + hstep, voffA);
            PG8_WAIT_V(8); PG8_WAIT_L(0); PG8_BAR; PG8_MMA(0, 0, At, B0); PG8_MMA(0, 1, At, B1); PG8_BAR; PG8_SCHED;
            PG8_LDA(At, 1, 1); PG8_STAGE(PG8_SB(1, 0), b3, voffB); PG8_STAGE(PG8_SB(1, 1), b3 + hstep, voffB); PG8_STAGE(PG8_SA(1, 0), a3, voffA);
            PG8_WAIT_V(8); PG8_WAIT_L(0); PG8_BAR; PG8_MMA(1, 0, At, B0); PG8_MMA(1, 1, At, B1); PG8_BAR; PG8_SCHED;
            } else {
            PG8_LDB(B0, 0, 0); PG8_SCHED; PG8_LDA(At, 0, 0); PG8_STAGE(PG8_SA(1, 1), a1 + hstep, voffA);
            PG8_WAIT_L(8); PG8_BAR; PG8_WAIT_L(0); PG8_MMA(0, 0, At, B0); PG8_BAR; PG8_SCHED;
            PG8_LDB(B1, 0, 1); PG8_STAGE(PG8_SB(0, 0), b2, voffB);
            PG8_BAR; PG8_WAIT_L(0); PG8_MMA(0, 1, At, B1); PG8_BAR;
            PG8_LDA(At, 0, 1); PG8_STAGE(PG8_SA(0, 0), a2, voffA);
            PG8_BAR; PG8_WAIT_L(0); PG8_MMA(1, 0, At, B0); PG8_BAR; PG8_SCHED;
            PG8_STAGE(PG8_SB(0, 1), b2 + hstep, voffB);
            PG8_WAIT_V(6); PG8_BAR; PG8_MMA(1, 1, At, B1); PG8_BAR;
            PG8_LDB(B0, 1, 0); PG8_SCHED; PG8_LDA(At, 1, 0); PG8_STAGE(PG8_SA(0, 1), a2 + hstep, voffA);
            PG8_WAIT_L(8); PG8_BAR; PG8_WAIT_L(0); PG8_MMA(0, 0, At, B0); PG8_BAR; PG8_SCHED;
            PG8_LDB(B1, 1, 1); PG8_STAGE(PG8_SB(1, 0), b3, voffB);
            PG8_BAR; PG8_WAIT_L(0); PG8_MMA(0, 1, At, B1); PG8_BAR;
            PG8_LDA(At, 1, 1); PG8_STAGE(PG8_SA(1, 0), a3, voffA);
            PG8_BAR; PG8_WAIT_L(0); PG8_MMA(1, 0, At, B0); PG8_BAR; PG8_SCHED;
            PG8_STAGE(PG8_SB(1, 1), b3 + hstep, voffB);
            PG8_WAIT_V(6); PG8_BAR; PG8_MMA(1, 1, At, B1); PG8_BAR;
            }
        }
        if constexpr (ALIGN_EPI) { if (wr == 0) PG8_BAR; }
        if constexpr (!Epi::AFTER_DRAIN) { E(acc, cur, wr, wc, fr, fq); S.done(cur); }
        if (!has_next) break;
#pragma unroll
        for (int a = 0; a < 2; ++a)
#pragma unroll
            for (int b = 0; b < 2; ++b)
#pragma unroll
                for (int m = 0; m < 4; ++m)
#pragma unroll
                    for (int n = 0; n < 2; ++n) acc[a][b][m][n] = (f32x4){0.f, 0.f, 0.f, 0.f};
        cur = nxt; cA = nA; cB = nB; ++ui;
        if constexpr (ALIGN_EPI) { if (wr == 1) PG8_BAR; }
    }
    PG8_WAIT_V(0);
    if constexpr (!ALIGN_EPI) { if (wr == 0) PG8_BAR; }
    PG8_BAR;
    if constexpr (Epi::AFTER_DRAIN) { E.fused(acc, cur, wr, wc, fr, fq, lds, wid, lane); S.done(cur); }
#undef PG8_SA
#undef PG8_SB
#undef PG8_STAGE
#undef PG8_LDA
#undef PG8_LDB
#undef PG8_MMA
#undef PG8_WAIT_V
#undef PG8_WAIT_L
#undef PG8_BAR
#undef PG8_SCHED
}
}
typedef unsigned short bf16_t;
typedef unsigned u32x4 __attribute__((ext_vector_type(4)));
typedef float f32x4 __attribute__((ext_vector_type(4)));

struct Params {
    const float *x, *w_in, *gla_wd, *gla_bd, *gla_ng, *w_out, *ln1_g, *ln1_b, *w_q, *sub_keys, *pu, *pv, *ln2_g, *ln2_b;
    float* out;
    char* ws;
#define WSP(T, name, off_bytes) __host__ __device__ __forceinline__ T* name() const { return (T*)(ws + (size_t)(off_bytes)); }
    WSP(bf16_t, winT, 0)
    WSP(bf16_t, woutT, 16u << 20)
    WSP(bf16_t, wqT, 18u << 20)
    WSP(float, rope_cos, 22u << 20)
    WSP(float, rope_sin, (22u << 20) + 131072)
    WSP(float, kmean, (22u << 20) + 262144)
    WSP(bf16_t, y, 23u << 20)
    WSP(bf16_t, x1b, 23u << 20)
    WSP(bf16_t, xbc, 87u << 20)
    WSP(bf16_t, g, 119u << 20)
    WSP(bf16_t, qa, 151u << 20)
    WSP(bf16_t, ka, 167u << 20)
    WSP(bf16_t, va, 183u << 20)
    WSP(bf16_t, ra, 215u << 20)
    WSP(bf16_t, ga, 247u << 20)
    WSP(bf16_t, gb, 279u << 20)
    WSP(bf16_t, qb, 311u << 20)
    WSP(bf16_t, kb, 343u << 20)
    WSP(bf16_t, vb, 375u << 20)
    WSP(float, x1, 87u << 20)
    WSP(bf16_t, qry, 215u << 20)
    WSP(bf16_t, sel_e, 471u << 20)
    WSP(bf16_t, sel_g, 487u << 20)
    WSP(unsigned char, u8, 343u << 20)
    WSP(unsigned char, v8, 359u << 20)
    WSP(bf16_t, part, 87u << 20)
    WSP(bf16_t, h2, 87u << 20)
    WSP(unsigned, qctr, (22u << 20) + 524288)
    WSP(bf16_t, oi, 407u << 20)
    WSP(bf16_t, oe, 439u << 20)
    WSP(float, dl, 471u << 20)
#undef WSP
};

__device__ __forceinline__ unsigned pack_bf16(float lo, float hi) { unsigned r; asm("v_cvt_pk_bf16_f32 %0, %1, %2" : "=v"(r) : "v"(lo), "v"(hi)); return r; }
__device__ __forceinline__ bf16_t f2bf(float f) { return (bf16_t)(pack_bf16(f, f) & 0xffffu); }
__device__ __forceinline__ float bf2f(bf16_t h) { return __uint_as_float((unsigned)h << 16); }

__device__ __forceinline__ float wave_sum(float v) {
#define WS_DPP(ctrl, rmask) v += __int_as_float(__builtin_amdgcn_update_dpp(0, __float_as_int(v), ctrl, rmask, 0xf, true))
    WS_DPP(0xB1, 0xf);
    WS_DPP(0x4E, 0xf);
    WS_DPP(0x141, 0xf);
    WS_DPP(0x140, 0xf);
    WS_DPP(0x142, 0xa);
    WS_DPP(0x143, 0xc);
#undef WS_DPP
    return __int_as_float(__builtin_amdgcn_readlane(__float_as_int(v), 63));
}
__device__ __forceinline__ float block_sum(float v, float* red, int tid) {
    v = wave_sum(v);
    __syncthreads();
    if ((tid & 63) == 0) red[tid >> 6] = v;
    __syncthreads();
    return red[0] + red[1] + red[2] + red[3];
}

struct EpiF32 {
    static constexpr bool PERM = false, AFTER_DRAIN = false;
    float* C; int ldc;
    __device__ __forceinline__ void operator()(const f32x4 (&acc)[2][2][4][2], const pg8::Unit& u, int wr, int wc, int fr, int fq) const {
        const int row0 = u.pm * 256 + wr * 64 + fr, col0 = u.pn * 256 + wc * 32 + 4 * fq;
#pragma unroll
        for (int ai = 0; ai < 2; ++ai)
#pragma unroll
            for (int m = 0; m < 4; ++m) { float* rowp = C + (size_t)(row0 + ai * 128 + m * 16) * ldc + col0;
#pragma unroll
                for (int bj = 0; bj < 2; ++bj)
#pragma unroll
                    for (int n = 0; n < 2; ++n) *(f32x4*)(rowp + bj * 128 + n * 16) = acc[ai][bj][m][n]; }
    }
};
struct EpiBf16 {
    static constexpr bool PERM = true, AFTER_DRAIN = false;
    bf16_t* O; int ldc;
    __device__ __forceinline__ void operator()(const f32x4 (&acc)[2][2][4][2], const pg8::Unit& u, int wr, int wc, int fr, int fq) const {
        const int row0 = u.pm * 256 + wr * 64 + fr, col0 = u.pn * 256 + wc * 32 + 8 * fq;
#pragma unroll
        for (int ai = 0; ai < 2; ++ai)
#pragma unroll
            for (int m = 0; m < 4; ++m) { bf16_t* rowp = O + (size_t)(row0 + ai * 128 + m * 16) * ldc + col0;
#pragma unroll
                for (int bj = 0; bj < 2; ++bj) { const f32x4 v0 = acc[ai][bj][m][0], v1 = acc[ai][bj][m][1];
                    u32x4 w; w.x = pg8::cvt_pk_bf16(v0[0], v0[1]); w.y = pg8::cvt_pk_bf16(v0[2], v0[3]); w.z = pg8::cvt_pk_bf16(v1[0], v1[1]); w.w = pg8::cvt_pk_bf16(v1[2], v1[3]);
                    __builtin_nontemporal_store(w, (u32x4*)(rowp + bj * 128)); } }
    }
};
struct EpiResid {
    static constexpr bool PERM = false, AFTER_DRAIN = false;
    float* C; const float* X;
    __device__ __forceinline__ void operator()(const f32x4 (&acc)[2][2][4][2], const pg8::Unit& u, int wr, int wc, int fr, int fq) const {
        const int row0 = u.pm * 256 + wr * 64 + fr, col0 = u.pn * 256 + wc * 32 + 4 * fq;
#pragma unroll
        for (int ai = 0; ai < 2; ++ai)
#pragma unroll
            for (int m = 0; m < 4; ++m) { const size_t ro = (size_t)(row0 + ai * 128 + m * 16) * 1024 + col0;
#pragma unroll
                for (int bj = 0; bj < 2; ++bj)
#pragma unroll
                    for (int n = 0; n < 2; ++n) { const f32x4 xv = *(const f32x4*)(X + ro + bj * 128 + n * 16);
                        __builtin_nontemporal_store(acc[ai][bj][m][n] + xv * DN_ALPHA, (f32x4*)(C + ro + bj * 128 + n * 16)); } }
    }
};
struct EpiResidB {
    static constexpr bool PERM = true, AFTER_DRAIN = false;
    bf16_t* C; const float* X;
    __device__ __forceinline__ void operator()(const f32x4 (&acc)[2][2][4][2], const pg8::Unit& u, int wr, int wc, int fr, int fq) const {
        const int row0 = u.pm * 256 + wr * 64 + fr, col0 = u.pn * 256 + wc * 32 + 8 * fq;
#pragma unroll
        for (int ai = 0; ai < 2; ++ai)
#pragma unroll
            for (int m = 0; m < 4; ++m) { const size_t ro = (size_t)(row0 + ai * 128 + m * 16) * 1024 + col0;
#pragma unroll
                for (int bj = 0; bj < 2; ++bj) { const f32x4 x0 = *(const f32x4*)(X + ro + bj * 128), x1 = *(const f32x4*)(X + ro + bj * 128 + 4);
                    const f32x4 v0 = acc[ai][bj][m][0] + x0 * DN_ALPHA, v1 = acc[ai][bj][m][1] + x1 * DN_ALPHA;
                    u32x4 w; w.x = pg8::cvt_pk_bf16(v0[0], v0[1]); w.y = pg8::cvt_pk_bf16(v0[2], v0[3]); w.z = pg8::cvt_pk_bf16(v1[0], v1[1]); w.w = pg8::cvt_pk_bf16(v1[2], v1[3]);
                    __builtin_nontemporal_store(w, (u32x4*)(C + ro + bj * 128)); } }
    }
};
struct InProjPtrs { char* pc; float *kmean; const float *rope_cos, *rope_sin; };
struct EpiInProj {
    static constexpr bool PERM = true, AFTER_DRAIN = false;
    InProjPtrs p;
    __device__ __forceinline__ void operator()(const f32x4 (&acc)[2][2][4][2], const pg8::Unit& u, int wr, int wc, int fr, int fq) const {
        const int pn = u.pn;
        const int row0 = u.pm * 256 + wr * 64 + fr;
        const int cin = wc * 32 + 8 * fq;
        if (pn >= 16 && pn < 28) {
            const int which = (pn - 16) >> 2;
            bf16_t* T = (bf16_t*)(p.pc + ((size_t)(160 + 32 * which) << 20));
            const int seq = u.pm >> 3, t0 = (u.pm & 7) * 256 + wr * 64 + fr;
            const bool rope = (which < 2) && (wc == 0);
            float ksum[2][8];
#pragma unroll
            for (int bj = 0; bj < 2; ++bj)
#pragma unroll
                for (int e = 0; e < 8; ++e) ksum[bj][e] = 0.f;
#pragma unroll
            for (int ai = 0; ai < 2; ++ai)
#pragma unroll
                for (int m = 0; m < 4; ++m) {
                    int t = t0 + ai * 128 + m * 16;
                    asm volatile("" : "+v"(t) :: "memory");
                    f32x4 c0 = {1.f, 1.f, 1.f, 1.f}, c1 = c0, s0 = {0.f, 0.f, 0.f, 0.f}, s1 = s0;
                    if (rope) {
                        const float* cp = p.rope_cos + t * 16 + 8 * (fq & 1);
                        const float* sp = p.rope_sin + t * 16 + 8 * (fq & 1);
                        c0 = *(const f32x4*)cp; c1 = *(const f32x4*)(cp + 4); s0 = *(const f32x4*)sp; s1 = *(const f32x4*)(sp + 4);
                        if (fq < 2) { s0 = -s0; s1 = -s1; }
                    }
#pragma unroll
                    for (int bj = 0; bj < 2; ++bj) {
                        f32x4 v0 = acc[ai][bj][m][0], v1 = acc[ai][bj][m][1];
                        if (rope) {
                            f32x4 o0, o1;
#pragma unroll
                            for (int j = 0; j < 4; ++j) {
                                const auto r0 = __builtin_amdgcn_permlane32_swap(__float_as_uint(v0[j]), __float_as_uint(v0[j]), false, false);
                                const auto r1 = __builtin_amdgcn_permlane32_swap(__float_as_uint(v1[j]), __float_as_uint(v1[j]), false, false);
                                o0[j] = __uint_as_float(fq < 2 ? r0[1] : r0[0]); o1[j] = __uint_as_float(fq < 2 ? r1[1] : r1[0]);
                            }
                            v0 = v0 * c0 + o0 * s0; v1 = v1 * c1 + o1 * s1;
                        }
                        if (which == 1) {
#pragma unroll
                            for (int j = 0; j < 4; ++j) { ksum[bj][j] += v0[j]; ksum[bj][4 + j] += v1[j]; }
                        }
                        const int head = ((pn - 16) & 3) * 2 + bj;
                        u32x4 w; w.x = pg8::cvt_pk_bf16(v0[0], v0[1]); w.y = pg8::cvt_pk_bf16(v0[2], v0[3]); w.z = pg8::cvt_pk_bf16(v1[0], v1[1]); w.w = pg8::cvt_pk_bf16(v1[2], v1[3]);
                        __builtin_nontemporal_store(w, (u32x4*)(T + ((size_t)(seq * 8 + head) * SEQ + t) * 128 + cin));
                    }
                }
            if (which == 1) {
#pragma unroll
                for (int bj = 0; bj < 2; ++bj)
#pragma unroll
                    for (int e = 0; e < 8; ++e) {
                        float s = ksum[bj][e];
                        s += __int_as_float(__builtin_amdgcn_update_dpp(0, __float_as_int(s), 0xB1, 0xf, 0xf, true));
                        s += __int_as_float(__builtin_amdgcn_update_dpp(0, __float_as_int(s), 0x4E, 0xf, 0xf, true));
                        s += __int_as_float(__builtin_amdgcn_update_dpp(0, __float_as_int(s), 0x141, 0xf, 0xf, true));
                        s += __int_as_float(__builtin_amdgcn_update_dpp(0, __float_as_int(s), 0x140, 0xf, 0xf, true));
                        if (fr == 0) {
                            const int head = ((pn - 16) & 3) * 2 + bj;
                            atomicAdd(p.kmean + ((size_t)((u.pm >> 3) * 8 + head) * 8 + (u.pm & 7)) * 128 + cin + e, s * (1.0f / 256.0f));
                        }
                    }
            }
            return;
        }
        if (pn >= 8 && pn < 16) {
            bf16_t* T = (bf16_t*)(p.pc + ((size_t)64 << 20));
#pragma unroll
            for (int ai = 0; ai < 2; ++ai)
#pragma unroll
                for (int m = 0; m < 4; ++m) {
                    f32x4 v0 = acc[ai][0][m][0], v1 = acc[ai][0][m][1];
                    const f32x4 a0 = acc[ai][1][m][0], a1 = acc[ai][1][m][1];
#pragma unroll
                    for (int j = 0; j < 4; ++j) {
                        v0[j] = v0[j] * __builtin_amdgcn_rcpf((1.0f + __expf(-v0[j])) * (1.0f + __expf(-a0[j])));
                        v1[j] = v1[j] * __builtin_amdgcn_rcpf((1.0f + __expf(-v1[j])) * (1.0f + __expf(-a1[j])));
                    }
                    u32x4 w; w.x = pg8::cvt_pk_bf16(v0[0], v0[1]); w.y = pg8::cvt_pk_bf16(v0[2], v0[3]); w.z = pg8::cvt_pk_bf16(v1[0], v1[1]); w.w = pg8::cvt_pk_bf16(v1[2], v1[3]);
                    __builtin_nontemporal_store(w, (u32x4*)(T + (size_t)(row0 + ai * 128 + m * 16) * 1024 + (pn - 8) * 128 + cin));
                }
            return;
        }
        int ld, cbase, mode, offm;
        if (pn < 4) { ld = 512; cbase = (pn & 1) * 256; offm = (pn >> 1) * 16; mode = (pn < 2) ? 1 : 0; }
        else if (pn < 8) { ld = 1024; cbase = (pn & 3) * 256; offm = 32; mode = 0; }
        else { ld = 1024; cbase = (pn & 3) * 256; offm = 128; mode = 3; }
        bf16_t* T = (bf16_t*)(p.pc + ((size_t)offm << 20));
#pragma unroll
        for (int ai = 0; ai < 2; ++ai)
#pragma unroll
            for (int m = 0; m < 4; ++m) {
                bf16_t* rowp = T + (size_t)(row0 + ai * 128 + m * 16) * ld + cbase + cin;
#pragma unroll
                for (int bj = 0; bj < 2; ++bj) {
                    f32x4 v0 = acc[ai][bj][m][0], v1 = acc[ai][bj][m][1];
                    if (mode == 1) { v0 = v0 * 0.08838834764831845f; v1 = v1 * 0.08838834764831845f; }
                    else if (mode == 3) {
#pragma unroll
                        for (int j = 0; j < 4; ++j) {
                            const float g0 = __builtin_amdgcn_rcpf(1.0f + __expf(-v0[j])), g1 = __builtin_amdgcn_rcpf(1.0f + __expf(-v1[j]));
                            v0[j] = g0; v1[j] = g1;
                        }
                    }
                    u32x4 w; w.x = pg8::cvt_pk_bf16(v0[0], v0[1]); w.y = pg8::cvt_pk_bf16(v0[2], v0[3]); w.z = pg8::cvt_pk_bf16(v1[0], v1[1]); w.w = pg8::cvt_pk_bf16(v1[2], v1[3]);
                    __builtin_nontemporal_store(w, (u32x4*)(rowp + bj * 128));
                }
            }
    }
};

__device__ __forceinline__ void transpose_tile(const float* __restrict__ src, int ld, bf16_t* __restrict__ dst, int gap_at, int gap, int tk, int tn, float* smem, int tid) {
    const int k0 = tk * 64, n0 = tn * 64;
    int c0 = n0;
    if (gap > 0) {
        if (n0 >= 2048 && n0 < 4096) { const int q = (n0 - 2048) >> 8, w = (n0 - 2048) & 255; c0 = (w < 128) ? 2048 + 128 * q + w : 6144 + 128 * q + (w - 128); }
        else if (n0 >= 4096 && n0 < 7168) c0 = n0 - 1024;
    }
    if (c0 >= gap_at) c0 += gap;
    {
        const int r = tid >> 4, cq = (tid & 15) * 4;
        const float4 a = *(const float4*)(src + (size_t)(k0 + r) * ld + c0 + cq);
        const float4 b = *(const float4*)(src + (size_t)(k0 + 32 + r) * ld + c0 + cq);
        float* d = smem + r * 65 + cq;
        d[0] = a.x; d[1] = a.y; d[2] = a.z; d[3] = a.w;
        d[32 * 65] = b.x; d[32 * 65 + 1] = b.y; d[32 * 65 + 2] = b.z; d[32 * 65 + 3] = b.w;
    }
    __syncthreads();
    {
        const int n = tid >> 3, kq = (tid & 7) * 8;
        unsigned w[4];
#pragma unroll
        for (int j = 0; j < 4; ++j) w[j] = pack_bf16(smem[(kq + 2 * j) * 65 + n], smem[(kq + 2 * j + 1) * 65 + n]);
        *(u32x4*)(dst + (size_t)(n0 + n) * 1024 + k0 + kq) = (u32x4){w[0], w[1], w[2], w[3]};
    }
    __syncthreads();
}

__device__ __forceinline__ void phase_xconv(const Params& p, int chunk, float* smem, const int t) {
    const int wave = t >> 6, lane = t & 63;
    float* wlr = smem;
    float* wd = smem + 16 * 1024;
    {
        float4 wl[8], wv[4];
#pragma unroll
        for (int u = 0; u < 8; ++u) { const int idx = t + u * NTHREADS, k = idx >> 2, rq = idx & 3; wl[u] = *(const float4*)(p.w_in + (size_t)k * IN_WIDTH + OFF_LR + 4 * rq); }
#pragma unroll
        for (int u = 0; u < 4; ++u) wv[u] = *(const float4*)(p.gla_wd + (size_t)(t + u * NTHREADS) * 4);
#pragma unroll
        for (int u = 0; u < 8; ++u) { const int idx = t + u * NTHREADS, k = idx >> 2, rq = idx & 3;
            wlr[(4 * rq) * 1024 + k] = wl[u].x; wlr[(4 * rq + 1) * 1024 + k] = wl[u].y; wlr[(4 * rq + 2) * 1024 + k] = wl[u].z; wlr[(4 * rq + 3) * 1024 + k] = wl[u].w; }
#pragma unroll
        for (int u = 0; u < 4; ++u) *(float4*)(wd + (size_t)(t + u * NTHREADS) * 4) = wv[u];
    }
    __syncthreads();
    f32x4 bd0 = *(const f32x4*)(p.gla_bd + lane * 8), bd1 = *(const f32x4*)(p.gla_bd + lane * 8 + 4);
    const int tstride = gridDim.x * 8;
#pragma unroll 1
    for (int tl = blockIdx.x * 8 + wave; tl < CT; tl += 2 * tstride) {
        const bool two = tl + tstride < CT;
        const int tl1 = two ? tl + tstride : tl;
        const float* xr0 = p.x + ((size_t)chunk * CT + tl) * 1024;
        const float* xr1 = p.x + ((size_t)chunk * CT + tl1) * 1024;
        f32x4 xa[4], xb[4];
#pragma unroll
        for (int j = 0; j < 4; ++j) xa[j] = *(const f32x4*)(xr0 + j * 256 + lane * 4);
#pragma unroll
        for (int j = 0; j < 4; ++j) xb[j] = *(const f32x4*)(xr1 + j * 256 + lane * 4);
#pragma unroll
        for (int j = 0; j < 4; ++j) {
            uint2 w; w.x = pack_bf16(xa[j][0], xa[j][1]); w.y = pack_bf16(xa[j][2], xa[j][3]);
            *(uint2*)(p.xbc() + (size_t)tl * 1024 + j * 256 + lane * 4) = w;
        }
        if (two) {
#pragma unroll
            for (int j = 0; j < 4; ++j) {
                uint2 w; w.x = pack_bf16(xb[j][0], xb[j][1]); w.y = pack_bf16(xb[j][2], xb[j][3]);
                *(uint2*)(p.xbc() + (size_t)tl1 * 1024 + j * 256 + lane * 4) = w;
            }
        }
        f32x4 za0 = bd0, za1 = bd1, zb0 = bd0, zb1 = bd1;
#pragma unroll 2
        for (int r = 0; r < 16; ++r) {
            float da = 0.f, db = 0.f;
#pragma unroll
            for (int j = 0; j < 4; ++j) { const f32x4 wv = *(const f32x4*)(wlr + r * 1024 + j * 256 + lane * 4);
                da += (wv[0] * xa[j][0] + wv[1] * xa[j][1]) + (wv[2] * xa[j][2] + wv[3] * xa[j][3]);
                db += (wv[0] * xb[j][0] + wv[1] * xb[j][1]) + (wv[2] * xb[j][2] + wv[3] * xb[j][3]); }
            const float lra = wave_sum(da), lrb = wave_sum(db);
            const f32x4 w0 = *(const f32x4*)(wd + r * 512 + lane * 8), w1 = *(const f32x4*)(wd + r * 512 + lane * 8 + 4);
            za0 += w0 * lra; za1 += w1 * lra; zb0 += w0 * lrb; zb1 += w1 * lrb;
        }
#pragma unroll
        for (int u = 0; u < 2; ++u) {
            if (u == 1 && !two) break;
            const f32x4 z0 = u ? zb0 : za0, z1 = u ? zb1 : za1;
            f32x4 g0, g1;
#pragma unroll
            for (int j = 0; j < 4; ++j) {
                g0[j] = (fminf(z0[j], 0.f) - __logf(1.0f + __expf(-fabsf(z0[j])))) * (1.0f / 16.0f);
                g1[j] = (fminf(z1[j], 0.f) - __logf(1.0f + __expf(-fabsf(z1[j])))) * (1.0f / 16.0f);
            }
            *(u32x4*)(p.g() + (size_t)(u ? tl1 : tl) * 512 + lane * 8) = (u32x4){pack_bf16(g0[0], g0[1]), pack_bf16(g0[2], g0[3]), pack_bf16(g1[0], g1[1]), pack_bf16(g1[2], g1[3])};
        }
    }
    __syncthreads();
}

namespace moba {
constexpr int D = 128;
constexpr float THR = 8.f;
constexpr bool WSKIP = false;
constexpr float SCALE = 0.08838834764831845f;
constexpr int NW = 8, QBLK = 32, KVBLK = 64, QB = NW * QBLK;
constexpr int SHM_V = KVBLK * D * 2, SHM_K = KVBLK * D * 2;
constexpr int LDS_ATTN = 2 * SHM_V + 2 * SHM_K + NW * 64 * 4;
typedef short bf16x8 __attribute__((ext_vector_type(8)));
typedef short s16x4 __attribute__((ext_vector_type(4)));
typedef float f32x16 __attribute__((ext_vector_type(16)));
template <class A, class Bt> struct same_t { static constexpr bool v = false; };
template <class A> struct same_t<A, A> { static constexpr bool v = true; };
#define KSWZ(row, colB) ((row) * 256 + ((colB) ^ (((row) & 7) << 4)))
#define SBAR() __builtin_amdgcn_sched_barrier(0)
__device__ __forceinline__ int v_st(int k, int c) { const int kk = (k & ~0xC) | ((k & 4) << 1) | ((k & 8) >> 1); return ((kk >> 3) * 4 + (c >> 5)) * 512 + ((kk & 7) * 32 + (c & 31)) * 2; }
__device__ __forceinline__ int v_rd_base(int lane) { return ((lane & 3) << 3) | (((lane >> 2) & 3) << 6) | (((lane >> 4) & 1) << 5) | (((lane >> 5) & 1) << 8); }
constexpr int v_rd_off(int d0, int ks, int half) { return d0 * 512 + ks * 4096 + half * 2048; }
__device__ __forceinline__ int crow(int r, int hi) { return (r & 3) + 8 * (r >> 2) + 4 * hi; }
__device__ __forceinline__ unsigned cvtpk(float lo, float hi) {
    unsigned r; asm volatile("v_cvt_pk_bf16_f32 %0, %1, %2" : "=v"(r) : "v"(lo), "v"(hi)); return r;
}
__device__ __forceinline__ bf16x8 pack8(f32x4 a, f32x4 b) {
    u32x4 w = {cvtpk(a[0], a[1]), cvtpk(a[2], a[3]), cvtpk(b[0], b[1]), cvtpk(b[2], b[3])};
    return *reinterpret_cast<bf16x8*>(&w);
}
template <class T> __device__ __forceinline__ bf16x8 load8(const T* p) {
    if constexpr (same_t<T, float>::v) { return pack8(*(const f32x4*)p, *(const f32x4*)(p + 4)); }
    else { return *reinterpret_cast<const bf16x8*>(p); }
}
__device__ __forceinline__ void mask_tile(f32x16& p0, f32x16& p1, int dq, unsigned W) {
    const float NEG = -__builtin_inff();
#pragma unroll
    for (int r = 0; r < 16; ++r) {
        const int c = (r & 3) + 8 * (r >> 2);
        if ((unsigned)(dq - c) >= W) p0[r] = NEG;
        if ((unsigned)(dq - c - 32) >= W) p1[r] = NEG;
    }
}
__device__ __forceinline__ void partialSM(f32x16& p0, f32x16& p1, float& m_reg, float& mn, float& alpha) {
    float pmax = p0[0]; for (int r = 1; r < 16; ++r) pmax = fmaxf(pmax, p0[r]); for (int r = 0; r < 16; ++r) pmax = fmaxf(pmax, p1[r]);
    { auto rr = __builtin_amdgcn_permlane32_swap(__float_as_uint(pmax), __float_as_uint(pmax), false, false);
      pmax = fmaxf(__uint_as_float(rr[0]), __uint_as_float(rr[1])); }
    constexpr float C2 = 1.4426950408889634f * SCALE;
    if (__builtin_expect(__all((pmax - m_reg) * SCALE <= THR), 1)) { mn = m_reg; alpha = 1.f; }
    else { mn = fmaxf(m_reg, pmax); alpha = __builtin_amdgcn_exp2f((m_reg - mn) * C2); m_reg = mn; }
    const float mnL = -mn * C2;
    for (int r = 0; r < 16; ++r) p0[r] = fmaf(p0[r], C2, mnL); for (int r = 0; r < 16; ++r) p1[r] = fmaf(p1[r], C2, mnL);
    for (int r = 0; r < 16; ++r) p0[r] = __builtin_amdgcn_exp2f(p0[r]);
}
__device__ __forceinline__ void finishSM(f32x16& p0, f32x16& p1, float alpha, float& l_reg, bf16x8& pa0, bf16x8& pa1, bf16x8& pa2, bf16x8& pa3) {
    for (int r = 0; r < 16; ++r) p1[r] = __builtin_amdgcn_exp2f(p1[r]);
    float ps = 0; for (int r = 0; r < 16; ++r) ps += p0[r]; for (int r = 0; r < 16; ++r) ps += p1[r];
    { auto rr = __builtin_amdgcn_permlane32_swap(__float_as_uint(ps), __float_as_uint(ps), false, false);
      ps = __uint_as_float(rr[0]) + __uint_as_float(rr[1]); }
    l_reg = l_reg * alpha + ps;
#define PK4(P, B_, OUT) do { unsigned a0 = cvtpk(P[B_+0], P[B_+1]), a1 = cvtpk(P[B_+2], P[B_+3]);                          \
        unsigned b0 = cvtpk(P[B_+4], P[B_+5]), b1 = cvtpk(P[B_+6], P[B_+7]);                                             \
        auto r0 = __builtin_amdgcn_permlane32_swap(a0, b0, false, false); auto r1 = __builtin_amdgcn_permlane32_swap(a1, b1, false, false); \
        u32x4 w = {r0[0], r1[0], r0[1], r1[1]}; OUT = *reinterpret_cast<bf16x8*>(&w); } while (0)
    PK4(p0, 0, pa0); PK4(p0, 8, pa1); PK4(p1, 0, pa2); PK4(p1, 8, pa3);
#undef PK4
}
template <int KB, bool SK>
__device__ __forceinline__ void qkt(f32x16& p0, f32x16& p1, const char* K_lds, int r32, int hi, const bf16x8* qr, bool act) {
    if (SK && !act) { const float NEG = -__builtin_inff();
#pragma unroll
        for (int r = 0; r < 16; ++r) { p0[r] = NEG; p1[r] = NEG; } return; }
    p0 = f32x16{}; p1 = f32x16{};
    const char* kb[4];
#pragma unroll
    for (int dd = 0; dd < 4; ++dd) kb[dd] = K_lds + KB * SHM_K + KSWZ(r32, (dd * 16 + hi * 8) * 2);
#pragma unroll
    for (int d0 = 0; d0 < 8; ++d0) { const char* a = kb[d0 & 3] + (d0 >> 2) * 128;
        bf16x8 b0 = *reinterpret_cast<const bf16x8*>(a);
        bf16x8 b1 = *reinterpret_cast<const bf16x8*>(a + 32 * 256);
        p0 = __builtin_amdgcn_mfma_f32_32x32x16_bf16(b0, qr[d0], p0, 0, 0, 0);
        p1 = __builtin_amdgcn_mfma_f32_32x32x16_bf16(b1, qr[d0], p1, 0, 0, 0); }
}
template <int VB, bool SK>
__device__ __forceinline__ void pv_tile(f32x16* o, int vb0, bf16x8 pa0, bf16x8 pa1, bf16x8 pa2, bf16x8 pa3, bool act) {
    if (SK && !act) return;
#define TRRD(dst, off) asm volatile("ds_read_b64_tr_b16 %0, %1 offset:%2" : "=&v"(dst) : "v"(vb0), "i"(off) : "memory")
#define PV_D0(d0) do { s16x4 l0, l1, l2, l3, h0, h1, h2, h3; constexpr int b_ = VB * SHM_V + v_rd_off(d0, 0, 0);     \
        TRRD(l0, b_); TRRD(h0, b_ + 2048); TRRD(l1, b_ + 4096); TRRD(h1, b_ + 6144); TRRD(l2, b_ + 8192); TRRD(h2, b_ + 10240); TRRD(l3, b_ + 12288); TRRD(h3, b_ + 14336); \
        asm volatile("s_waitcnt lgkmcnt(0)" ::: "memory"); SBAR();                 \
        o[d0] = __builtin_amdgcn_mfma_f32_32x32x16_bf16(pa0, (bf16x8){l0[0], l0[1], l0[2], l0[3], h0[0], h0[1], h0[2], h0[3]}, o[d0], 0, 0, 0);   \
        o[d0] = __builtin_amdgcn_mfma_f32_32x32x16_bf16(pa1, (bf16x8){l1[0], l1[1], l1[2], l1[3], h1[0], h1[1], h1[2], h1[3]}, o[d0], 0, 0, 0);   \
        o[d0] = __builtin_amdgcn_mfma_f32_32x32x16_bf16(pa2, (bf16x8){l2[0], l2[1], l2[2], l2[3], h2[0], h2[1], h2[2], h2[3]}, o[d0], 0, 0, 0);   \
        o[d0] = __builtin_amdgcn_mfma_f32_32x32x16_bf16(pa3, (bf16x8){l3[0], l3[1], l3[2], l3[3], h3[0], h3[1], h3[2], h3[3]}, o[d0], 0, 0, 0); } while (0)
    PV_D0(0); PV_D0(1); PV_D0(2); PV_D0(3);
#undef PV_D0
#undef TRRD
}

template <class TIn, class TOut> struct BlockRef { const TIn* Q; const TIn* K; const TIn* V; TOut* O; int P0; };
template <class TIn> struct Seam {
    bf16x8 qr[8];
    bf16x8 st_v0, st_v1, st_k0, st_k1; f32x4 sf0, sf1, sf2, sf3;
    f32x4 tq[16];
};
__device__ __forceinline__ int swa_jlo(int P0, int W) { const int lowk = P0 - W + 1; return lowk > 0 ? lowk / KVBLK : 0; }
#define ROW(p, k0, rr) ((p) + (size_t)((k0) + (rr)) * D + sc)
#define VMW() asm volatile("s_waitcnt vmcnt(0)" ::: "memory")
#define VMWN(n) asm volatile("s_waitcnt vmcnt(%0)" :: "i"(n) : "memory")
#define SLOAD_H(Kp, Vp, k0) do { S.st_v0 = load8<TIn>(ROW(Vp, k0, sr)); S.st_v1 = load8<TIn>(ROW(Vp, k0, 32 + sr));              \
                         S.st_k0 = load8<TIn>(ROW(Kp, k0, sr)); S.st_k1 = load8<TIn>(ROW(Kp, k0, 32 + sr)); } while (0)
#define SWRITE_HK(bf) do { *(bf16x8*)(K_lds + (bf) * SHM_K + kws) = S.st_k0; *(bf16x8*)(K_lds + (bf) * SHM_K + kws + 32 * 256) = S.st_k1; } while (0)
#define SWRITE_HV(bf) do { *(bf16x8*)(V_lds + (bf) * SHM_V + vst0) = S.st_v0; *(bf16x8*)(V_lds + (bf) * SHM_V + vst1) = S.st_v1; } while (0)
#define SWRITE_H(bf) do { SWRITE_HV(bf); SWRITE_HK(bf); } while (0)
#define SLOAD_F(p, k0) do { S.sf0 = *(const f32x4*)ROW(p, k0, sr); S.sf1 = *(const f32x4*)(ROW(p, k0, sr) + 4);                \
                            S.sf2 = *(const f32x4*)ROW(p, k0, 32 + sr); S.sf3 = *(const f32x4*)(ROW(p, k0, 32 + sr) + 4); } while (0)
#define SWRITE_KF(bf) do { *(bf16x8*)(K_lds + (bf) * SHM_K + kws) = pack8(S.sf0, S.sf1); *(bf16x8*)(K_lds + (bf) * SHM_K + kws + 32 * 256) = pack8(S.sf2, S.sf3); } while (0)
#define SWRITE_VF(bf) do { *(bf16x8*)(V_lds + (bf) * SHM_V + vst0) = pack8(S.sf0, S.sf1); *(bf16x8*)(V_lds + (bf) * SHM_V + vst1) = pack8(S.sf2, S.sf3); } while (0)
template <class TIn, class TOut>
__device__ __forceinline__ void causal_swa_prime(const BlockRef<TIn, TOut>& cur, int W, char* lds, Seam<TIn>& S, const int tid) {
    constexpr bool F32 = same_t<TIn, float>::v;
    const int wid = __builtin_amdgcn_readfirstlane(tid >> 6), lane = tid & 63, r32 = lane & 31, hi = lane >> 5;
    const int sr = tid >> 4, sc = (tid & 15) * 8, kws = KSWZ(sr, sc * 2); char* K_lds = lds + 2 * SHM_V;
    const int kb0 = swa_jlo(cur.P0, W) * KVBLK;
    for (int d0 = 0; d0 < 8; ++d0) S.qr[d0] = load8<TIn>(cur.Q + (size_t)(wid * QBLK + r32) * D + d0 * 16 + hi * 8);
    if constexpr (F32) { SLOAD_F((const float*)cur.K, kb0); VMW(); SWRITE_KF(0); SBAR(); SLOAD_F((const float*)cur.V, kb0); }
    else { SLOAD_H(cur.K, cur.V, kb0); VMW(); SWRITE_HK(0); }
    __syncthreads();
}
template <class TIn, class TOut>
__device__ __forceinline__ void causal_swa_block(const BlockRef<TIn, TOut>& cur, const BlockRef<TIn, TOut>& nxt, int skv, int W, char* lds, Seam<TIn>& S, const int tid, const unsigned selmask) {
    constexpr bool F32 = same_t<TIn, float>::v;
    const int wid = __builtin_amdgcn_readfirstlane(tid >> 6), lane = tid & 63, r32 = lane & 31, hi = lane >> 5;
    const int j_lo = swa_jlo(cur.P0, W);
    int j_hi = (cur.P0 + QB - 1) / KVBLK + 1; if (j_hi > skv / KVBLK) j_hi = skv / KVBLK;
    const int NT = j_hi - j_lo;
    const int kbn = swa_jlo(nxt.P0, W) * KVBLK;
    const int qlo = cur.P0 + wid * QBLK, qm = qlo + r32 - 4 * hi;
    char* V_lds = lds; char* K_lds = lds + 2 * SHM_V;
    float* ws = (float*)(lds + 2 * SHM_V + 2 * SHM_K) + wid * 64; float* li_l = ws, * al_l = ws + 32;
    float m_reg = -1e30f, l_reg = 0; f32x16 o[4] = {};
    const int sr = tid >> 4, sc = (tid & 15) * 8, vst0 = v_st(sr, sc), vst1 = v_st(32 + sr, sc), kws = KSWZ(sr, sc * 2);
    const int vb0 = (int)(uintptr_t)V_lds + v_rd_base(lane);
    const TIn* Kh = cur.K; const TIn* Vh = cur.V;
    const int qb = cur.P0 >> 8;
#define RESC(a) do { if (__any((a) < 1.f)) { if (hi == 0) al_l[r32] = (a); asm volatile("s_waitcnt lgkmcnt(0)" ::: "memory");              \
                     for (int d_ = 0; d_ < 4; ++d_) for (int r = 0; r < 16; ++r) o[d_][r] *= al_l[crow(r, hi)]; } } while (0)
#define KBASE(t) ((j_lo + (t)) * KVBLK)
#define ACT(t) (KBASE(t) <= qlo + QBLK - 1 && KBASE(t) + KVBLK - 1 >= qlo - W + 1)
#define MASKT(P0_, P1_, t) do { const int kb_ = KBASE(t); if (kb_ + KVBLK - 1 > qlo) mask_tile(P0_, P1_, qm - kb_, (unsigned)W);                  \
        else if (qb >= 4 && kb_ < cur.P0) { const bool keep_ = (selmask >> (kb_ >> 8)) & 1u; const float NEG_ = -__builtin_inff();          \
            _Pragma("unroll") for (int r_ = 0; r_ < 16; ++r_) { P0_[r_] = keep_ ? P0_[r_] : NEG_; P1_[r_] = keep_ ? P1_[r_] : NEG_; } } } while (0)
    constexpr int NQL = F32 ? 16 : 8;
    constexpr bool SK = WSKIP && !F32;
#define SEAM_K0() do { VMWN(NQL); if constexpr (F32) { SWRITE_KF(0); SBAR(); SLOAD_F((const float*)nxt.V, kbn); } else { SWRITE_HK(0); } SBAR(); } while (0)
    f32x16 pA0, pA1, pB0, pB1; float mnA, mnB, alA, alB; bf16x8 pa0, pa1, pa2, pa3;
    if constexpr (F32) { VMW(); SWRITE_VF(0); SBAR(); } else { SWRITE_HV(0); SBAR(); }
    if (NT > 1) { if constexpr (F32) SLOAD_F((const float*)Kh, KBASE(1)); else SLOAD_H(Kh, Vh, KBASE(1)); }
    SBAR(); qkt<0, SK>(pA0, pA1, K_lds, r32, hi, S.qr, ACT(0));
    if constexpr (F32) { if (NT > 1) { VMW(); SWRITE_KF(1); SBAR(); SLOAD_F((const float*)Vh, KBASE(1)); } }
    MASKT(pA0, pA1, 0); partialSM(pA0, pA1, m_reg, mnA, alA);
    if (NT > 1) { VMW(); if constexpr (F32) { SWRITE_VF(1); SBAR(); if (NT > 2) SLOAD_F((const float*)Kh, KBASE(2)); } else SWRITE_H(1); }
    __syncthreads();
#define HALF_STEP(PX0, PX1, mnX, alX, PY0, PY1, alY, t, KB, VB, SB) do {                                                      \
        SBAR(); qkt<KB, SK>(PX0, PX1, K_lds, r32, hi, S.qr, ACT(t));                                             \
        finishSM(PY0, PY1, alY, l_reg, pa0, pa1, pa2, pa3); SBAR();                                                           \
        if ((t) + 1 < NT) { if constexpr (F32) { VMW(); SWRITE_KF(SB); SBAR(); SLOAD_F((const float*)Vh, KBASE((t) + 1)); }  \
                            else { SLOAD_H(Kh, Vh, KBASE((t) + 1)); } SBAR(); }                                               \
        pv_tile<VB, SK>(o, vb0, pa0, pa1, pa2, pa3, ACT((t) - 1)); MASKT(PX0, PX1, (t)); partialSM(PX0, PX1, m_reg, mnX, alX);                                        \
        __syncthreads();                                                                                                      \
        if ((t) + 1 < NT) { VMW(); if constexpr (F32) { SWRITE_VF(SB); SBAR(); if ((t) + 2 < NT) SLOAD_F((const float*)Kh, KBASE((t) + 2)); } \
                            else { SWRITE_H(SB); } }                                                                          \
        RESC(alX); __syncthreads(); } while (0)
    for (int t = 1; t + 1 < NT; t += 2) {
        HALF_STEP(pB0, pB1, mnB, alB, pA0, pA1, alA, t, 1, 0, 0);
        HALF_STEP(pA0, pA1, mnA, alA, pB0, pB1, alB, t + 1, 0, 1, 1);
    }
    const bool even = (NT & 1) == 0;
    if (even) { SBAR(); qkt<1, SK>(pB0, pB1, K_lds, r32, hi, S.qr, ACT(NT - 1)); SBAR(); }
#define QROW(e) (nxt.Q + (size_t)(wid * QBLK + r32) * D + ((e) >> 1) * 16 + hi * 8 + ((e) & 1) * 4)
    if constexpr (F32) { SLOAD_F((const float*)nxt.K, kbn); SBAR();
#pragma unroll
        for (int e = 0; e < 8; ++e) S.tq[e] = *(const f32x4*)QROW(e); }
    else { SLOAD_H(nxt.K, nxt.V, kbn); SBAR();
#pragma unroll
        for (int d0 = 0; d0 < 8; ++d0) S.qr[d0] = load8<TIn>(nxt.Q + (size_t)(wid * QBLK + r32) * D + d0 * 16 + hi * 8); }
    SBAR();
    finishSM(pA0, pA1, alA, l_reg, pa0, pa1, pa2, pa3); SBAR();
    if constexpr (F32) {
#pragma unroll
        for (int e = 8; e < 16; ++e) S.tq[e] = *(const f32x4*)QROW(e); SBAR(); }
#undef QROW
    pv_tile<0, SK>(o, vb0, pa0, pa1, pa2, pa3, ACT(even ? NT - 2 : NT - 1));
    if (even) { MASKT(pB0, pB1, NT - 1); partialSM(pB0, pB1, m_reg, mnB, alB); __syncthreads(); RESC(alB);
        finishSM(pB0, pB1, alB, l_reg, pa0, pa1, pa2, pa3); SBAR(); pv_tile<1, SK>(o, vb0, pa0, pa1, pa2, pa3, ACT(NT - 1)); }
    SBAR(); SEAM_K0();
    if (hi == 0) li_l[r32] = l_reg; asm volatile("s_waitcnt lgkmcnt(0)" ::: "memory");
    float rli[16];
#pragma unroll
    for (int r = 0; r < 16; ++r) rli[r] = __builtin_amdgcn_rcpf(li_l[crow(r, hi)]);
    TOut* Ow = cur.O + (size_t)(wid * QBLK) * D;
#pragma unroll
    for (int r = 0; r < 16; ++r) { const int orow = crow(r, hi);
#pragma unroll
        for (int d0 = 0; d0 < 4; ++d0) { const float v = o[d0][r] * rli[r];
            if constexpr (same_t<TOut, float>::v) { Ow[(size_t)orow * D + d0 * 32 + r32] = v; }
            else { const float vn = __int_as_float(__builtin_amdgcn_update_dpp(0, __float_as_int(v), 0xB1, 0xf, 0xf, true));
                   if ((r32 & 1) == 0) *(unsigned*)(Ow + (size_t)orow * D + d0 * 32 + r32) = cvtpk(v, vn); } } }
    if constexpr (F32) {
#pragma unroll
        for (int d0 = 0; d0 < 8; ++d0) S.qr[d0] = pack8(S.tq[2 * d0], S.tq[2 * d0 + 1]); }
    __syncthreads();
#undef RESC
#undef KBASE
#undef ACT
#undef MASKT
#undef SEAM_K0
#undef HALF_STEP
}
#undef ROW
#undef VMW
#undef VMWN
#undef SLOAD_H
#undef SWRITE_HK
#undef SWRITE_HV
#undef SWRITE_H
#undef SLOAD_F
#undef SWRITE_KF
#undef SWRITE_VF


__device__ __forceinline__ unsigned moba_gate(const bf16x8 (&qr)[8], const float* kmean, int qb, int hi) {
    float v1 = -__builtin_inff(), v2 = v1, v3 = v1; int i1 = 0, i2 = 0, i3 = 0;
#pragma unroll 1
    for (int n = 0; n < qb; ++n) {
        const float* km = kmean + n * 128 + hi * 8;
        float g = 0.f;
#pragma unroll
        for (int d0 = 0; d0 < 8; ++d0) {
            const f32x4 k0 = *(const f32x4*)(km + d0 * 16), k1 = *(const f32x4*)(km + d0 * 16 + 4);
#pragma unroll
            for (int j = 0; j < 4; ++j) {
                g += __uint_as_float((unsigned)(unsigned short)qr[d0][j] << 16) * k0[j];
                g += __uint_as_float((unsigned)(unsigned short)qr[d0][4 + j] << 16) * k1[j];
            }
        }
        { auto rr = __builtin_amdgcn_permlane32_swap(__float_as_uint(g), __float_as_uint(g), false, false); g = __uint_as_float(rr[0]) + __uint_as_float(rr[1]); }
        if (g > v1) { v3 = v2; i3 = i2; v2 = v1; i2 = i1; v1 = g; i1 = n; }
        else if (g > v2) { v3 = v2; i3 = i2; v2 = g; i2 = n; }
        else if (g > v3) { v3 = g; i3 = n; }
    }
    return (1u << i1) | (1u << i2) | (1u << i3);
}
}

namespace gla {
using moba::bf16x8; using moba::s16x4; using moba::f32x16;
#define GLA_KSWZ(row, colB) ((row) * 256 + ((colB) ^ (((row) & 7) << 4)))
__device__ __forceinline__ float bfu(bf16_t h) { return __uint_as_float((unsigned)h << 16); }

__device__ __forceinline__ void pack_p(const f32x16& p0, const f32x16& p1, bf16x8& pa0, bf16x8& pa1, bf16x8& pa2, bf16x8& pa3) {
#define GLA_PK4(P, B_, OUT) do { unsigned a0 = moba::cvtpk(P[B_+0], P[B_+1]), a1 = moba::cvtpk(P[B_+2], P[B_+3]);                      \
        unsigned b0 = moba::cvtpk(P[B_+4], P[B_+5]), b1 = moba::cvtpk(P[B_+6], P[B_+7]);                                             \
        auto r0 = __builtin_amdgcn_permlane32_swap(a0, b0, false, false); auto r1 = __builtin_amdgcn_permlane32_swap(a1, b1, false, false); \
        u32x4 w = {r0[0], r1[0], r0[1], r1[1]}; OUT = *reinterpret_cast<bf16x8*>(&w); } while (0)
    GLA_PK4(p0, 0, pa0); GLA_PK4(p0, 8, pa1); GLA_PK4(p1, 0, pa2); GLA_PK4(p1, 8, pa3);
#undef GLA_PK4
}
__device__ __forceinline__ void pv_block(f32x16& o, int vb0  , bf16x8 pa0, bf16x8 pa1, bf16x8 pa2, bf16x8 pa3) {
#define GLA_TRRD(dst, off) asm volatile("ds_read_b64_tr_b16 %0, %1 offset:%2" : "=&v"(dst) : "v"(vb0), "i"(off) : "memory")
    s16x4 l0, l1, l2, l3, h0, h1, h2, h3; constexpr int b_ = 0;
    GLA_TRRD(l0, b_); GLA_TRRD(h0, b_ + 2048); GLA_TRRD(l1, b_ + 4096); GLA_TRRD(h1, b_ + 6144); GLA_TRRD(l2, b_ + 8192); GLA_TRRD(h2, b_ + 10240); GLA_TRRD(l3, b_ + 12288); GLA_TRRD(h3, b_ + 14336);
    asm volatile("s_waitcnt lgkmcnt(0)" ::: "memory"); __builtin_amdgcn_sched_barrier(0);
    o = __builtin_amdgcn_mfma_f32_32x32x16_bf16(pa0, (bf16x8){l0[0], l0[1], l0[2], l0[3], h0[0], h0[1], h0[2], h0[3]}, o, 0, 0, 0);
    o = __builtin_amdgcn_mfma_f32_32x32x16_bf16(pa1, (bf16x8){l1[0], l1[1], l1[2], l1[3], h1[0], h1[1], h1[2], h1[3]}, o, 0, 0, 0);
    o = __builtin_amdgcn_mfma_f32_32x32x16_bf16(pa2, (bf16x8){l2[0], l2[1], l2[2], l2[3], h2[0], h2[1], h2[2], h2[3]}, o, 0, 0, 0);
    o = __builtin_amdgcn_mfma_f32_32x32x16_bf16(pa3, (bf16x8){l3[0], l3[1], l3[2], l3[3], h3[0], h3[1], h3[2], h3[3]}, o, 0, 0, 0);
#undef GLA_TRRD
}
__device__ __forceinline__ void v_frags(int vb0, bf16x8 (&vf)[4]) {
#define GLA_TRRD(dst, off) asm volatile("ds_read_b64_tr_b16 %0, %1 offset:%2" : "=&v"(dst) : "v"(vb0), "i"(off) : "memory")
    s16x4 l0, l1, l2, l3, h0, h1, h2, h3; constexpr int b_ = 0;
    GLA_TRRD(l0, b_); GLA_TRRD(h0, b_ + 2048); GLA_TRRD(l1, b_ + 4096); GLA_TRRD(h1, b_ + 6144); GLA_TRRD(l2, b_ + 8192); GLA_TRRD(h2, b_ + 10240); GLA_TRRD(l3, b_ + 12288); GLA_TRRD(h3, b_ + 14336);
    asm volatile("s_waitcnt lgkmcnt(0)" ::: "memory"); __builtin_amdgcn_sched_barrier(0);
    vf[0] = (bf16x8){l0[0], l0[1], l0[2], l0[3], h0[0], h0[1], h0[2], h0[3]};
    vf[1] = (bf16x8){l1[0], l1[1], l1[2], l1[3], h1[0], h1[1], h1[2], h1[3]};
    vf[2] = (bf16x8){l2[0], l2[1], l2[2], l2[3], h2[0], h2[1], h2[2], h2[3]};
    vf[3] = (bf16x8){l3[0], l3[1], l3[2], l3[3], h3[0], h3[1], h3[2], h3[3]};
#undef GLA_TRRD
}
__device__ __forceinline__ void store_tile_bf16(const f32x16& o, bf16_t* dst, int ld, int r32, int hi) {
#pragma unroll
    for (int r = 0; r < 16; ++r) {
        const float v = o[r], vn = __int_as_float(__builtin_amdgcn_update_dpp(0, __float_as_int(v), 0xB1, 0xf, 0xf, true));
        if ((r32 & 1) == 0) *(unsigned*)(dst + (size_t)moba::crow(r, hi) * ld + r32) = moba::cvtpk(v, vn);
    }
}
template <int NT>
__device__ __forceinline__ void store_tiles_wide(const f32x16 (&o)[NT], bf16_t* dst, int ld, int lane, char* scr) {
    const int r32 = lane & 31, hi = lane >> 5;
#pragma unroll
    for (int i = 0; i < NT; ++i)
#pragma unroll
        for (int r = 0; r < 16; ++r) {
            const float v = o[i][r], vn = __int_as_float(__builtin_amdgcn_update_dpp(0, __float_as_int(v), 0xB1, 0xf, 0xf, true));
            if ((r32 & 1) == 0) *(unsigned*)(scr + moba::crow(r, hi) * (NT * 64) + i * 64 + r32 * 2) = moba::cvtpk(v, vn);
        }
    constexpr int LPR = NT * 4;
    constexpr int RPP = 64 / LPR;
#pragma unroll
    for (int ps = 0; ps < 32 / RPP; ++ps) {
        const int row = ps * RPP + lane / LPR, pc = lane % LPR;
        const u32x4 w = *(const u32x4*)(scr + row * (NT * 64) + pc * 16);
        *(u32x4*)(dst + (size_t)row * ld + pc * 8) = w;
    }
}
template <int NT>
__device__ __forceinline__ void tiles_to_scratch(const f32x16 (&o)[NT], int lane, char* scr) {
    const int r32 = lane & 31, hi = lane >> 5;
#pragma unroll
    for (int i = 0; i < NT; ++i)
#pragma unroll
        for (int r = 0; r < 16; ++r) {
            const float v = o[i][r], vn = __int_as_float(__builtin_amdgcn_update_dpp(0, __float_as_int(v), 0xB1, 0xf, 0xf, true));
            if ((r32 & 1) == 0) *(unsigned*)(scr + moba::crow(r, hi) * (NT * 64) + i * 64 + r32 * 2) = moba::cvtpk(v, vn);
        }
}
template <int NT>
__device__ __forceinline__ void scratch_to_global(bf16_t* dst, int ld, int lane, const char* scr) {
    constexpr int LPR = NT * 4, RPP = 64 / LPR;
#pragma unroll
    for (int ps = 0; ps < 32 / RPP; ++ps) {
        const int row = ps * RPP + lane / LPR, pc = lane % LPR;
        *(u32x4*)(dst + (size_t)row * ld + pc * 8) = *(const u32x4*)(scr + row * (NT * 64) + pc * 16);
    }
}
__device__ __forceinline__ void stage_v_load(const bf16_t* src, int ld, int t, bf16x8 (&r)[4]) {
    const int sr = t >> 4, sc = (t & 15) * 8;
    r[0] = *(const bf16x8*)(src + (size_t)sr * ld + sc); r[1] = *(const bf16x8*)(src + (size_t)(32 + sr) * ld + sc);
    r[2] = *(const bf16x8*)(src + (size_t)sr * ld + 128 + sc); r[3] = *(const bf16x8*)(src + (size_t)(32 + sr) * ld + 128 + sc);
}
__device__ __forceinline__ void stage_v_write(char* V_lds, int t, const bf16x8 (&r)[4]) {
    const int sr = t >> 4, sc = (t & 15) * 8;
    *(bf16x8*)(V_lds + moba::v_st(sr, sc)) = r[0]; *(bf16x8*)(V_lds + moba::v_st(32 + sr, sc)) = r[1];
    *(bf16x8*)(V_lds + moba::SHM_V + moba::v_st(sr, sc)) = r[2]; *(bf16x8*)(V_lds + moba::SHM_V + moba::v_st(32 + sr, sc)) = r[3];
}

__device__ __forceinline__ void g1_item(const Params& p, int item, char* lds, const int t) {
    const int c = item & 31, h = (item >> 5) & 3, sl = item >> 7;
    const size_t tl0 = (size_t)sl * SEQ + c * 64;
    char* Kt = lds; char* Qt = lds + 16384; char* V_lds = lds + 32768; float* segtot = (float*)(lds + 65536);
    float* graw = (float*)(lds + 67584); bf16_t* qraw = (bf16_t*)(lds + 100352); bf16_t* kraw = (bf16_t*)(lds + 116736);
    const int d = t & 127, seg = t >> 7;
    {
        bf16x8 vr[4];
        stage_v_load(p.va() + tl0 * 1024 + h * 256, 1024, t, vr);
        u32x4 gr[2]; bf16x8 qr2[2], kr2[2];
#pragma unroll
        for (int i = 0; i < 2; ++i) { const int ch = t + i * NTHREADS, row = ch >> 4, col = (ch & 15) * 8; gr[i] = *(const u32x4*)(p.g() + (tl0 + row) * 512 + h * 128 + col); }
#pragma unroll
        for (int i = 0; i < 2; ++i) { const int ch = t + i * NTHREADS, row = ch >> 4, col = (ch & 15) * 8;
            qr2[i] = *(const bf16x8*)(p.qa() + (tl0 + row) * 512 + h * 128 + col); kr2[i] = *(const bf16x8*)(p.ka() + (tl0 + row) * 512 + h * 128 + col); }
        stage_v_write(V_lds, t, vr);
#pragma unroll
        for (int i = 0; i < 2; ++i) { const int ch = t + i * NTHREADS;
            *(f32x4*)(graw + ch * 8) = (f32x4){__uint_as_float(gr[i][0] << 16), __uint_as_float(gr[i][0] & 0xffff0000u), __uint_as_float(gr[i][1] << 16), __uint_as_float(gr[i][1] & 0xffff0000u)};
            *(f32x4*)(graw + ch * 8 + 4) = (f32x4){__uint_as_float(gr[i][2] << 16), __uint_as_float(gr[i][2] & 0xffff0000u), __uint_as_float(gr[i][3] << 16), __uint_as_float(gr[i][3] & 0xffff0000u)}; }
#pragma unroll
        for (int i = 0; i < 2; ++i) { const int ch = t + i * NTHREADS; *(bf16x8*)(qraw + ch * 8) = qr2[i]; *(bf16x8*)(kraw + ch * 8) = kr2[i]; }
    }
    __syncthreads();
    float b[16];
#pragma unroll
    for (int i = 0; i < 16; ++i) b[i] = graw[(seg * 16 + i) * 128 + d];
#pragma unroll
    for (int i = 1; i < 16; ++i) b[i] += b[i - 1];
    segtot[seg * 128 + d] = b[15];
    __syncthreads();
    const float s0 = segtot[d], s1 = segtot[128 + d], s2 = segtot[256 + d], s3 = segtot[384 + d];
    const float prefix = (seg > 0 ? s0 : 0.f) + (seg > 1 ? s1 : 0.f) + (seg > 2 ? s2 : 0.f);
    const float ref = s0 + s1, blast = (s0 + s1) + (s2 + s3);
    const float er = __expf(-ref), el = __expf(blast);
    unsigned ksw[8];
#pragma unroll
    for (int i = 0; i < 16; ++i) {
        const int tt = seg * 16 + i;
        const float qv = bfu(qraw[tt * 128 + d]), kv = bfu(kraw[tt * 128 + d]);
        const float eb = __expf(b[i] + prefix);
        const float ebr = eb * er, inv = __builtin_amdgcn_rcpf(eb);
        const float qt = qv * ebr, kt = kv * __builtin_amdgcn_rcpf(ebr), qi = qv * eb, ks = kv * (el * inv);
        *(bf16_t*)(Qt + GLA_KSWZ(tt, d * 2)) = f2bf(qt);
        *(bf16_t*)(Kt + GLA_KSWZ(tt, d * 2)) = f2bf(kt);
        qraw[tt * 128 + d] = f2bf(qi);
        if (i & 1) ksw[i >> 1] |= (unsigned)f2bf(ks) << 16; else ksw[i >> 1] = f2bf(ks);
    }
    {
        bf16_t* dst = p.ka() + (tl0 + (d >> 1)) * 512 + h * 128 + (d & 1) * 64 + seg * 16;
        *(u32x4*)dst = (u32x4){ksw[0], ksw[1], ksw[2], ksw[3]};
        *(u32x4*)(dst + 8) = (u32x4){ksw[4], ksw[5], ksw[6], ksw[7]};
    }
    if (seg == 0) p.dl()[((size_t)(sl * 32 + c) * 4 + h) * 128 + d] = el;
    __syncthreads();
#pragma unroll
    for (int i = 0; i < 2; ++i) { const int ch = t + i * NTHREADS, row = ch >> 4, col = (ch & 15) * 8;
        *(bf16x8*)(p.qa() + (tl0 + row) * 512 + h * 128 + col) = *(const bf16x8*)(qraw + ch * 8); }
    const int wave = __builtin_amdgcn_readfirstlane(t >> 6), lane = t & 63, r32 = lane & 31, hi = lane >> 5, tt = wave & 1, vg = wave >> 1;
    bf16x8 qr[8];
#pragma unroll
    for (int d0 = 0; d0 < 8; ++d0) qr[d0] = *(const bf16x8*)(Qt + GLA_KSWZ(32 * tt + r32, (d0 * 16 + hi * 8) * 2));
    f32x16 p0, p1;
    moba::qkt<0, false>(p0, p1, Kt, r32, hi, qr, true);
    const int trow = 32 * tt + r32;
#pragma unroll
    for (int r = 0; r < 16; ++r) { const int s = moba::crow(r, hi); p0[r] = (s <= trow) ? p0[r] : 0.f; p1[r] = (s + 32 <= trow) ? p1[r] : 0.f; }
    bf16x8 pa0, pa1, pa2, pa3;
    pack_p(p0, p1, pa0, pa1, pa2, pa3);
    const int vb0 = (int)(uintptr_t)V_lds + moba::v_rd_base(lane);
    f32x16 oA = f32x16{}, oB = f32x16{};
    {
        const int vbw = vb0 + (vg >> 1) * moba::SHM_V + (vg & 1) * 1024;
        pv_block(oA, vbw, pa0, pa1, pa2, pa3);
        pv_block(oB, vbw + 512, pa0, pa1, pa2, pa3);
    }
    bf16_t* od = p.oi() + (tl0 + 32 * tt) * 1024 + h * 256 + vg * 64;
    {
        const f32x16 o2[2] = {oA, oB};
        store_tiles_wide<2>(o2, od, 1024, lane, lds + 67584 + wave * 4096);
    }
    __syncthreads();
}

struct G2Stage { bf16x8 q[2], k[2], v[4]; float dl; };
__device__ __forceinline__ void g2_load(const Params& p, size_t tl0, size_t slc, int h, int t, G2Stage& s) {
    { const int tr = t >> 3, dq = (t & 7) * 16; const bf16_t* src = p.qa() + (tl0 + tr) * 512 + h * 128 + dq; s.q[0] = *(const bf16x8*)src; s.q[1] = *(const bf16x8*)(src + 8); }
    { const int dr = t >> 2, tq = (t & 3) * 16; const bf16_t* src = p.ka() + (tl0 + (dr >> 1)) * 512 + h * 128 + (dr & 1) * 64 + tq; s.k[0] = *(const bf16x8*)src; s.k[1] = *(const bf16x8*)(src + 8); }
    stage_v_load(p.va() + tl0 * 1024 + h * 256, 1024, t, s.v);
    s.dl = (t < 128) ? p.dl()[(slc * 4 + h) * 128 + t] : 0.f;
}
__device__ __forceinline__ void g2_write(char* lds, int t, const G2Stage& s) {
    { const int tr = t >> 3, c8 = (t & 7) * 4, x = tr & 31;
#pragma unroll
      for (int i = 0; i < 2; ++i) { const s16x4 lo = {s.q[i][0], s.q[i][1], s.q[i][2], s.q[i][3]}, hi4 = {s.q[i][4], s.q[i][5], s.q[i][6], s.q[i][7]};
          *(s16x4*)(lds + tr * 256 + (((c8 + 2 * i) ^ x) << 3)) = lo; *(s16x4*)(lds + tr * 256 + (((c8 + 2 * i + 1) ^ x) << 3)) = hi4; } }
    { const int dr = t >> 2, ch = (t & 3) * 2;
#pragma unroll
      for (int i = 0; i < 2; ++i) *(bf16x8*)(lds + 16384 + dr * 128 + (((ch + i) ^ (dr & 7)) << 4)) = s.k[i]; }
    stage_v_write(lds + 32768, t, s.v);
    if (t < 128) ((float*)(lds + 65536))[t] = s.dl;
}
__device__ __forceinline__ void g2_update(f32x16 (&S)[4], const char* lds, int vb0, int r32, int hi) {
    bf16x8 vf[4];
    v_frags(vb0, vf);
#pragma unroll
    for (int dt = 0; dt < 4; ++dt) {
        const int dr = 32 * dt + r32;
#pragma unroll
        for (int kk = 0; kk < 4; ++kk) {
            const bf16x8 a = *(const bf16x8*)(lds + 16384 + dr * 128 + (((2 * kk + hi) ^ (dr & 7)) << 4));
            S[dt] = __builtin_amdgcn_mfma_f32_32x32x16_bf16(a, vf[kk], S[dt], 0, 0, 0);
        }
    }
}
template <int G2V = 0>
__device__ __forceinline__ void g2_item(const Params& p, int item, char* lds, const int t) {
    const int h = item & 3, sl = item >> 2;
    const int wave = __builtin_amdgcn_readfirstlane(t >> 6), lane = t & 63, r32 = lane & 31, hi = lane >> 5;
    const int vb0 = (int)(uintptr_t)(lds + 32768) + moba::v_rd_base(lane);
    f32x16 S[4];
#pragma unroll
    for (int dt = 0; dt < 4; ++dt) S[dt] = f32x16{};
    G2Stage st;
    g2_load(p, (size_t)sl * SEQ, (size_t)sl * 32, h, t, st);
#pragma unroll 1
    for (int c = 0; c < 32; ++c) {
        const size_t tl0 = (size_t)sl * SEQ + c * 64;
        __syncthreads();
        g2_write(lds, t, st);
        __syncthreads();
        if (G2V == 0 && c > 0) {
            bf16_t* od = p.oe() + (tl0 - 64) * 1024 + h * 256 + wave * 32;
            scratch_to_global<1>(od, 1024, lane, lds + 69632 + wave * 4096);
            scratch_to_global<1>(od + 32 * 1024, 1024, lane, lds + 69632 + wave * 4096 + 2048);
        }
        if (c + 1 < 32) g2_load(p, tl0 + 64, (size_t)sl * 32 + c + 1, h, t, st);
#pragma unroll
        for (int tt = 0; tt < ((G2V == 3 || G2V == 4) ? 0 : 2); ++tt) {
            f32x16 o = f32x16{};
            const char* rowp = lds + (32 * tt + r32) * 256;
#pragma unroll
            for (int dt = 0; dt < 4; ++dt) {
#pragma unroll
                for (int s = 0; s < 2; ++s) {
                    u32x4 w = {moba::cvtpk(S[dt][8 * s], S[dt][8 * s + 1]), moba::cvtpk(S[dt][8 * s + 2], S[dt][8 * s + 3]), moba::cvtpk(S[dt][8 * s + 4], S[dt][8 * s + 5]), moba::cvtpk(S[dt][8 * s + 6], S[dt][8 * s + 7])};
                    const bf16x8 sf = *reinterpret_cast<bf16x8*>(&w);
                    const int c8 = 8 * dt + 4 * s + hi;
                    const s16x4 lo = *(const s16x4*)(rowp + ((c8 ^ r32) << 3)), hi4 = *(const s16x4*)(rowp + (((c8 + 2) ^ r32) << 3));
                    const bf16x8 a = {lo[0], lo[1], lo[2], lo[3], hi4[0], hi4[1], hi4[2], hi4[3]};
                    o = __builtin_amdgcn_mfma_f32_32x32x16_bf16(a, sf, o, 0, 0, 0);
                }
            }
            if (G2V == 0) { const f32x16 o1[1] = {o}; tiles_to_scratch<1>(o1, lane, lds + 69632 + wave * 4096 + tt * 2048); }
            else asm volatile("" :: "v"(o[0]), "v"(o[5]), "v"(o[10]), "v"(o[15]));
        }
        const float* dlp = (const float*)(lds + 65536);
#pragma unroll
        for (int dt = 0; dt < 4; ++dt)
#pragma unroll
            for (int rq = 0; rq < 4; ++rq) {
                const f32x4 dv = *(const f32x4*)(dlp + 32 * dt + 8 * rq + 4 * hi);
#pragma unroll
                for (int j = 0; j < 4; ++j) S[dt][4 * rq + j] *= dv[j];
            }
        if (G2V != 2 && G2V != 4) g2_update(S, lds, vb0 + (wave >> 2) * moba::SHM_V + (wave & 3) * 512, r32, hi);
    }
    if (G2V != 0) asm volatile("" :: "v"(S[0][0]), "v"(S[1][3]), "v"(S[2][7]), "v"(S[3][15]));
    if (G2V == 0) {
        bf16_t* od = p.oe() + ((size_t)sl * SEQ + 31 * 64) * 1024 + h * 256 + wave * 32;
        scratch_to_global<1>(od, 1024, lane, lds + 69632 + wave * 4096);
        scratch_to_global<1>(od + 32 * 1024, 1024, lane, lds + 69632 + wave * 4096 + 2048);
    }
    __syncthreads();
}
}

__device__ __forceinline__ moba::BlockRef<bf16_t, bf16_t> moba_ref(const Params& p, int L) {
    const int sh = L & 63, qb = 7 - (L >> 6);
    moba::BlockRef<bf16_t, bf16_t> r;
    bf16_t* Qh = p.qb() + (size_t)sh * SEQ * 128;
    r.Q = Qh + (size_t)qb * 256 * 128; r.O = Qh + (size_t)qb * 256 * 128;
    r.K = p.kb() + (size_t)sh * SEQ * 128; r.V = p.vb() + (size_t)sh * SEQ * 128; r.P0 = qb * 256;
    return r;
}
__device__ __forceinline__ int moba_dequeue(unsigned* ctr, volatile unsigned* lds_word, const int t) {
    __syncthreads();
    if (t == 0) *lds_word = atomicAdd(ctr, 1u);
    __syncthreads();
    return __builtin_amdgcn_readfirstlane((int)*lds_word);
}
__device__ __forceinline__ void phase_moba_mfma(const Params& p, int chunk, unsigned char* lds_raw, const int t) {
    using BR = moba::BlockRef<bf16_t, bf16_t>;
    const int total = CHUNK_SEQS * 8 * 8, W = 0x7fffffff;
    unsigned* ctr = p.qctr() + 40 + chunk;
    volatile unsigned* lw = (volatile unsigned*)(lds_raw + 69632);
    int L = moba_dequeue(ctr, lw, t);
    if (L >= total) return;
    BR cur = moba_ref(p, L);
    moba::Seam<bf16_t> S;
    moba::causal_swa_prime<bf16_t, bf16_t>(cur, W, (char*)lds_raw, S, t);
    float* kml = (float*)(lds_raw + 73728);
    for (;;) {
        if (cur.P0 >= 1024) *(float2*)(kml + t * 2) = *(const float2*)(p.kmean() + (size_t)(L & 63) * 8 * 128 + t * 2);
        const int Ln = moba_dequeue(ctr, lw, t);
        const bool last = Ln >= total;
        const BR nxt = last ? cur : moba_ref(p, Ln);
        unsigned selmask = 0xffu;
        if (cur.P0 >= 1024) selmask = moba::moba_gate(S.qr, kml, cur.P0 >> 8, (t >> 5) & 1);
        moba::causal_swa_block<bf16_t, bf16_t>(cur, nxt, SEQ, W, (char*)lds_raw, S, t, selmask);
        if (last) break;
        cur = nxt; L = Ln;
    }
}

__device__ __forceinline__ void unpack8(const u32x4 w, float (&f)[8]) {
#pragma unroll
    for (int j = 0; j < 4; ++j) { f[2 * j] = __uint_as_float(w[j] << 16); f[2 * j + 1] = __uint_as_float(w[j] & 0xffff0000u); }
}
struct MergeRaw { u32x4 oi[2], oe[2], ra[2], gb[2], ob[2]; };
__device__ __forceinline__ void merge_load(const Params& p, int tl, int lane, MergeRaw& m) {
    const size_t ro = (size_t)tl * 1024 + lane * 8;
    const int s = tl >> 11, pos = tl & (SEQ - 1);
#pragma unroll
    for (int hf = 0; hf < 2; ++hf) {
        const bf16_t* obp = p.qb() + ((size_t)(s * 8 + 4 * hf + (lane >> 4)) * SEQ + pos) * 128 + (lane & 15) * 8;
        m.oi[hf] = *(const u32x4*)(p.oi() + ro + hf * 512); m.oe[hf] = *(const u32x4*)(p.oe() + ro + hf * 512); m.ra[hf] = *(const u32x4*)(p.ra() + ro + hf * 512);
        m.gb[hf] = *(const u32x4*)(p.gb() + ro + hf * 512); m.ob[hf] = *(const u32x4*)obp;
    }
}
__device__ __forceinline__ void merge_compute(const Params& p, int chunk, int tl, int lane, const MergeRaw& m, const float (&ng)[8]) {
    bf16_t* yp = p.y() + ((size_t)chunk * CT + tl) * 1024 + lane * 8;
#pragma unroll
    for (int hf = 0; hf < 2; ++hf) {
        float o[8], tmp[8], t2[8];
        unpack8(m.oi[hf], tmp); unpack8(m.oe[hf], t2);
        float ss = 0.f;
#pragma unroll
        for (int j = 0; j < 8; ++j) { o[j] = tmp[j] + t2[j]; ss += o[j] * o[j]; }
        ss += __int_as_float(__builtin_amdgcn_update_dpp(0, __float_as_int(ss), 0xB1, 0xf, 0xf, true));
        ss += __int_as_float(__builtin_amdgcn_update_dpp(0, __float_as_int(ss), 0x4E, 0xf, 0xf, true));
        ss += __int_as_float(__builtin_amdgcn_update_dpp(0, __float_as_int(ss), 0x141, 0xf, 0xf, true));
        ss += __int_as_float(__builtin_amdgcn_update_dpp(0, __float_as_int(ss), 0x140, 0xf, 0xf, true));
        ss += __int_as_float(__builtin_amdgcn_ds_swizzle(__float_as_int(ss), 0x401F));
        const float rs = rsqrtf(ss * (1.0f / 256.0f) + 1e-6f);
        float r[8], gb[8], ob[8];
        unpack8(m.ra[hf], r); unpack8(m.gb[hf], gb); unpack8(m.ob[hf], ob);
        unsigned w[4];
#pragma unroll
        for (int j = 0; j < 4; ++j) {
            const float y0 = o[2 * j] * rs * ng[2 * j] * r[2 * j] + ob[2 * j] * gb[2 * j];
            const float y1 = o[2 * j + 1] * rs * ng[2 * j + 1] * r[2 * j + 1] + ob[2 * j + 1] * gb[2 * j + 1];
            w[j] = pack_bf16(y0, y1);
        }
        *(u32x4*)(yp + hf * 512) = (u32x4){w[0], w[1], w[2], w[3]};
    }
}
__device__ __forceinline__ void phase_merge(const Params& p, int chunk, const int t) {
    const int wave = t >> 6, lane = t & 63;
    float ng[8];
#pragma unroll
    for (int j = 0; j < 8; ++j) ng[j] = p.gla_ng[(lane & 31) * 8 + j];
    const int stride = gridDim.x * 8;
    int tl = blockIdx.x * 8 + wave;
    MergeRaw a, b;
    if (tl < CT) merge_load(p, tl, lane, a);
#pragma unroll 1
    for (; tl < CT; tl += 2 * stride) {
        const bool hb = tl + stride < CT;
        if (hb) merge_load(p, tl + stride, lane, b);
        merge_compute(p, chunk, tl, lane, a, ng);
        if (tl + 2 * stride < CT) merge_load(p, tl + 2 * stride, lane, a);
        if (hb) merge_compute(p, chunk, tl + stride, lane, b, ng);
    }
}

__device__ __forceinline__ void phase_ln1(const Params& p, const int t) {
    const int wave = t >> 6, lane = t & 63;
    f32x4 g[4], be[4];
#pragma unroll
    for (int j = 0; j < 4; ++j) { g[j] = *(const f32x4*)(p.ln1_g + j * 256 + lane * 4); be[j] = *(const f32x4*)(p.ln1_b + j * 256 + lane * 4); }
#pragma unroll 1
    for (int n = blockIdx.x * 8 + wave; n < NTOK; n += gridDim.x * 8) {
        f32x4 v[4];
        float sum = 0.f;
#pragma unroll
        for (int j = 0; j < 4; ++j) { const uint2 zw = *(const uint2*)((const bf16_t*)p.x1() + (size_t)n * 1024 + j * 256 + lane * 4);
            v[j] = (f32x4){__uint_as_float(zw.x << 16), __uint_as_float(zw.x & 0xffff0000u), __uint_as_float(zw.y << 16), __uint_as_float(zw.y & 0xffff0000u)}; sum += (v[j][0] + v[j][1]) + (v[j][2] + v[j][3]); }
        const float mu = wave_sum(sum) * (1.0f / 1024.0f);
        float sq = 0.f;
#pragma unroll
        for (int j = 0; j < 4; ++j) { const f32x4 d = v[j] - mu; sq += (d[0] * d[0] + d[1] * d[1]) + (d[2] * d[2] + d[3] * d[3]); }
        const float rs = rsqrtf(wave_sum(sq) * (1.0f / 1024.0f) + 1e-5f);
#pragma unroll
        for (int j = 0; j < 4; ++j) {
            const f32x4 o = (v[j] - mu) * rs * g[j] + be[j];
            uint2 w; w.x = pack_bf16(o[0], o[1]); w.y = pack_bf16(o[2], o[3]);
            *(uint2*)(p.x1b() + (size_t)n * 1024 + j * 256 + lane * 4) = w;
        }
    }
}

__device__ __forceinline__ unsigned xcc_id() { return (unsigned)__builtin_amdgcn_s_getreg((3 << 11) | 20) & 0x7u; }
template <int CTRL> __device__ __forceinline__ float dpp_add(float v) {
    return v + __int_as_float(__builtin_amdgcn_update_dpp(0, __float_as_int(v), CTRL, 0xf, 0xf, true));
}
typedef __bf16 bf16x2_t __attribute__((ext_vector_type(2)));
__device__ __forceinline__ float dot2bf(unsigned a, unsigned b, float acc) {
    return __builtin_amdgcn_fdot2_f32_bf16(__builtin_bit_cast(bf16x2_t, a), __builtin_bit_cast(bf16x2_t, b), acc, false);
}
#define PEER_NS 8
#define PEER_TILE 64
#define PEER_NT (NTOK / PEER_TILE)

template <int NS, class F> __device__ __forceinline__ void peer_sliced(unsigned* qctr, unsigned* lds_word, const int t, F&& f) {
    const int xcc = (int)xcc_id();
#pragma unroll 1
    for (int j = 0; j < NS; ++j) {
        const int s = (xcc + j) & (NS - 1);
#pragma unroll 1
        for (;;) {
            __syncthreads();
            if (t == 0) *lds_word = atomicAdd(qctr + s, 1u);
            __syncthreads();
            const unsigned tile = *lds_word;
            if (tile >= PEER_NT) break;
            f(s, (int)tile);
        }
    }
}

typedef float f32x2 __attribute__((ext_vector_type(2)));
typedef int i32x8 __attribute__((ext_vector_type(8)));
typedef short s16x2 __attribute__((ext_vector_type(2)));
__device__ __forceinline__ void peer_u_item(const Params& p, int sp, int tile, const int t) {
    const int wave = __builtin_amdgcn_readfirstlane(t >> 6), lane = t & 63, r = lane & 3, qa = lane >> 2;
    const int n0 = tile * PEER_TILE + wave * 8;
    const unsigned char* ub = p.u8() + sp * 256 + r * 16;
    const float dw0 = (r == 0) ? 0.03125f : 0.f, dw1 = (r == 1) ? 0.03125f : 0.f, dw2 = (r == 2) ? 0.03125f : 0.f, dw3 = (r == 3) ? 0.03125f : 0.f;
    const bool bon = (lane >> 4) == ((lane >> 2) & 3);
    const int qc = 4 * (qa & 3) + (qa >> 2);
    const bf16_t* ep = p.sel_e() + (size_t)n0 * 128 + qa * 8;
    const bf16_t* xo = p.x1b() + (size_t)n0 * 1024 + sp * 256 + r * 16;
    u32x4 A0[8][2], A1[8][2], XA[4], XB[4];
    u32x4 ia0, ib0;
    float dpart[8];
#define PU_IDS(d0, tt) do { d0 = *(const u32x4*)(ep + (tt) * 128); } while (0)
#define PU_LOAD(A, d0, hf) do { _Pragma("unroll") for (int m = 0; m < 8; ++m) { const unsigned id = (m & 1) ? (d0[m >> 1] >> 16) : (d0[m >> 1] & 0xffffu); const unsigned char* rp = ub + (size_t)id * 1024 + (hf) * 128; \
        A[m][0] = *(const u32x4*)rp; A[m][1] = *(const u32x4*)(rp + 64); } } while (0)
#define PU_XLOAD(X, tt, hf) do { const bf16_t* xp = xo + (size_t)(tt) * 1024 + (hf) * 128; X[0] = *(const u32x4*)xp; X[1] = *(const u32x4*)(xp + 8); X[2] = *(const u32x4*)(xp + 64); X[3] = *(const u32x4*)(xp + 72); } while (0)
#define PU_MMA(A, X, FIRST) do { i32x8 bm; _Pragma("unroll") for (int i = 0; i < 8; ++i) { const unsigned x0 = X[i >> 1][(i & 1) * 2], x1 = X[i >> 1][(i & 1) * 2 + 1]; int w = 0; \
            w = __builtin_amdgcn_cvt_pk_fp8_f32(__uint_as_float(x0 << 16), __uint_as_float(x0 & 0xffff0000u), w, false); \
            w = __builtin_amdgcn_cvt_pk_fp8_f32(__uint_as_float(x1 << 16), __uint_as_float(x1 & 0xffff0000u), w, true); \
            bm[i] = bon ? w : 0; } \
        _Pragma("unroll") for (int m = 0; m < 8; ++m) { const i32x8 a = {(int)A[m][0][0], (int)A[m][0][1], (int)A[m][0][2], (int)A[m][0][3], (int)A[m][1][0], (int)A[m][1][1], (int)A[m][1][2], (int)A[m][1][3]}; \
            const f32x4 c = __builtin_amdgcn_mfma_scale_f32_16x16x128_f8f6f4(a, bm, (f32x4){0.f, 0.f, 0.f, 0.f}, 0, 0, 0, 0, 0, 0); \
            const float d = (c[0] * dw0 + c[1] * dw1) + (c[2] * dw2 + c[3] * dw3); dpart[m] = (FIRST) ? d : dpart[m] + d; } } while (0)
#define PU_OUT(tt) do { float dsum[8]; _Pragma("unroll") for (int m = 0; m < 8; ++m) { const float d = dpp_add<0xB1>(dpart[m]); dsum[m] = dpp_add<0x4E>(d); } \
        if (r == 0) *(u32x4*)(p.part() + ((size_t)sp * NTOK + n0 + (tt)) * 128 + qc * 8) = (u32x4){pack_bf16(dsum[0], dsum[1]), pack_bf16(dsum[2], dsum[3]), pack_bf16(dsum[4], dsum[5]), pack_bf16(dsum[6], dsum[7])}; } while (0)
    PU_IDS(ia0, 0);
    PU_IDS(ib0, 1);
    PU_XLOAD(XA, 0, 0);
    PU_LOAD(A0, ia0, 0);
#pragma unroll
    for (int tt = 0; tt < 8; tt += 2) {
        PU_XLOAD(XB, tt, 1);
        __builtin_amdgcn_sched_barrier(0);
        PU_LOAD(A1, ia0, 1);
        __builtin_amdgcn_sched_barrier(0);
        if (tt + 2 < 8) PU_IDS(ia0, tt + 2);
        PU_MMA(A0, XA, true);
        __builtin_amdgcn_sched_barrier(0);
        PU_XLOAD(XA, tt + 1, 0);
        __builtin_amdgcn_sched_barrier(0);
        PU_LOAD(A0, ib0, 0);
        __builtin_amdgcn_sched_barrier(0);
        PU_MMA(A1, XB, false);
        PU_OUT(tt);
        __builtin_amdgcn_sched_barrier(0);
        PU_XLOAD(XB, tt + 1, 1);
        __builtin_amdgcn_sched_barrier(0);
        PU_LOAD(A1, ib0, 1);
        __builtin_amdgcn_sched_barrier(0);
        if (tt + 3 < 8) PU_IDS(ib0, tt + 3);
        PU_MMA(A0, XA, true);
        __builtin_amdgcn_sched_barrier(0);
        if (tt + 2 < 8) PU_XLOAD(XA, tt + 2, 0);
        __builtin_amdgcn_sched_barrier(0);
        if (tt + 2 < 8) PU_LOAD(A0, ia0, 0);
        __builtin_amdgcn_sched_barrier(0);
        PU_MMA(A1, XB, false);
        PU_OUT(tt + 1);
        __builtin_amdgcn_sched_barrier(0);
    }
#undef PU_IDS
#undef PU_LOAD
#undef PU_XLOAD
#undef PU_MMA
#undef PU_OUT
}
__device__ __forceinline__ void peer_reduce(const Params& p, const int t) {
    const size_t rstride = (size_t)gridDim.x * NTHREADS;
#pragma unroll 1
    for (size_t i = (size_t)blockIdx.x * NTHREADS + t; i < (size_t)NTOK * 128; i += 2 * rstride) {
        const bool two = i + rstride < (size_t)NTOK * 128;
        const size_t i1 = two ? i + rstride : i;
        bf16_t pa[PEER_NS / 2], pb[PEER_NS / 2];
#pragma unroll
        for (int s = 0; s < PEER_NS / 2; ++s) { pa[s] = p.part()[(size_t)s * NTOK * 128 + i]; pb[s] = p.part()[(size_t)s * NTOK * 128 + i1]; }
        const bf16_t ga = p.sel_g()[i], gb = p.sel_g()[i1];
        float da = 0.f, db = 0.f;
#pragma unroll
        for (int s = 0; s < PEER_NS / 2; ++s) { da += bf2f(pa[s]); db += bf2f(pb[s]); }
        const float wa = bf2f(ga) * 0.5f * da * (1.0f + erff(da * 0.7071067811865476f));
        const float wb = bf2f(gb) * 0.5f * db * (1.0f + erff(db * 0.7071067811865476f));
        p.sel_g()[i] = f2bf(0.5f * wa);
        if (two) p.sel_g()[i1] = f2bf(0.5f * wb);
    }
}
__device__ __forceinline__ void peer_v_item(const Params& p, int s, int tile, const int t) {
    const int wave = t >> 6, lane = t & 63, grp = lane >> 3, c8 = lane & 7;
    const unsigned char* vt = p.v8() + s * 128 + c8 * 16;
    const int n0 = tile * PEER_TILE + wave * 8;
    const bf16_t* ep = p.sel_e() + (size_t)n0 * 128 + grp * 16;
    const bf16_t* wp = p.sel_g() + (size_t)n0 * 128 + grp * 16;
    u32x4 id4[2], w4[2];
#pragma unroll
    for (int q = 0; q < 2; ++q) { id4[q] = *(const u32x4*)(ep + q * 8); w4[q] = *(const u32x4*)(wp + q * 8); }
#pragma unroll 1
    for (int tt = 0; tt < 8; ++tt) {
        const int n = n0 + tt;
        u32x4 vv[16];
#pragma unroll
        for (int i = 0; i < 16; ++i) { const unsigned iw = id4[i >> 3][(i >> 1) & 3]; vv[i] = *(const u32x4*)(vt + (size_t)((i & 1) ? (iw >> 16) : (iw & 0xffffu)) * 1024); }
        const int tn = (tt + 1 < 8) ? tt + 1 : tt;
        u32x4 idn[2], wn[2];
#pragma unroll
        for (int q = 0; q < 2; ++q) { idn[q] = *(const u32x4*)(ep + tn * 128 + q * 8); wn[q] = *(const u32x4*)(wp + tn * 128 + q * 8); }
        __builtin_amdgcn_sched_barrier(0);
        f32x2 acc[8];
#pragma unroll
        for (int j = 0; j < 8; ++j) acc[j] = (f32x2){0.f, 0.f};
#pragma unroll
        for (int i = 0; i < 16; ++i) {
            const unsigned ww = w4[i >> 3][(i >> 1) & 3];
            const float w = __uint_as_float((i & 1) ? (ww & 0xffff0000u) : (ww << 16));
            const f32x2 w2 = {w, w};
#pragma unroll
            for (int j = 0; j < 4; ++j) {
                acc[2 * j] = __builtin_elementwise_fma(__builtin_amdgcn_cvt_pk_f32_fp8((int)vv[i][j], false), w2, acc[2 * j]);
                acc[2 * j + 1] = __builtin_elementwise_fma(__builtin_amdgcn_cvt_pk_f32_fp8((int)vv[i][j], true), w2, acc[2 * j + 1]);
            }
        }
#pragma unroll
        for (int q = 0; q < 2; ++q) { id4[q] = idn[q]; w4[q] = wn[q]; }
        float o[16];
#pragma unroll
        for (int j = 0; j < 8; ++j) { o[2 * j] = acc[j].x; o[2 * j + 1] = acc[j].y; }
        float s8[8];
#pragma unroll
        for (int j = 0; j < 8; ++j) {
            const auto rr = __builtin_amdgcn_permlane32_swap(__float_as_uint(o[j]), __float_as_uint(o[j + 8]), false, false);
            s8[j] = __uint_as_float(rr[0]) + __uint_as_float(rr[1]);
        }
        const bool b4 = (lane & 16) != 0, b3 = (lane & 8) != 0;
        float s4[4];
#pragma unroll
        for (int j = 0; j < 4; ++j) {
            const float send = b3 ? s8[j] : s8[j + 4], keep = b3 ? s8[j + 4] : s8[j];
            s4[j] = keep + __int_as_float(__builtin_amdgcn_update_dpp(0, __float_as_int(send), 0x128, 0xf, 0xf, true));
        }
        float s2[2];
#pragma unroll
        for (int j = 0; j < 2; ++j) {
            const float send = b4 ? s4[j] : s4[j + 2], keep = b4 ? s4[j + 2] : s4[j];
            s2[j] = keep + __shfl_xor(send, 16, 64);
        }
        {
            const int col = c8 * 16 + ((lane >> 5) & 1) * 8 + ((lane >> 3) & 1) * 4 + ((lane >> 4) & 1) * 2;
            *(unsigned*)(p.h2() + (size_t)n * 1024 + s * 128 + col) = pack_bf16(s2[0], s2[1]);
        }
    }
}
__device__ __forceinline__ void peer_ln2(const Params& p, const int t) {
    const int wave = t >> 6, lane = t & 63;
    f32x4 g[4], be[4];
#pragma unroll
    for (int j = 0; j < 4; ++j) { g[j] = *(const f32x4*)(p.ln2_g + j * 256 + lane * 4); be[j] = *(const f32x4*)(p.ln2_b + j * 256 + lane * 4); }
#pragma unroll 1
    for (int n = blockIdx.x * 8 + wave; n < NTOK; n += gridDim.x * 8) {
        f32x4 v[4];
        float sum = 0.f;
#pragma unroll
        for (int j = 0; j < 4; ++j) {
            const uint2 aw = *(const uint2*)(p.x1b() + (size_t)n * 1024 + j * 256 + lane * 4);
            const uint2 bw = *(const uint2*)(p.h2() + (size_t)n * 1024 + j * 256 + lane * 4);
            const f32x4 a = {__uint_as_float(aw.x << 16), __uint_as_float(aw.x & 0xffff0000u), __uint_as_float(aw.y << 16), __uint_as_float(aw.y & 0xffff0000u)};
            const f32x4 b = {__uint_as_float(bw.x << 16), __uint_as_float(bw.x & 0xffff0000u), __uint_as_float(bw.y << 16), __uint_as_float(bw.y & 0xffff0000u)};
            v[j] = a * DN_ALPHA + b;
            sum += (v[j][0] + v[j][1]) + (v[j][2] + v[j][3]);
        }
        const float mu = wave_sum(sum) * (1.0f / 1024.0f);
        float sq = 0.f;
#pragma unroll
        for (int j = 0; j < 4; ++j) { const f32x4 d = v[j] - mu; sq += (d[0] * d[0] + d[1] * d[1]) + (d[2] * d[2] + d[3] * d[3]); }
        const float rs = rsqrtf(wave_sum(sq) * (1.0f / 1024.0f) + 1e-5f);
#pragma unroll
        for (int j = 0; j < 4; ++j) *(f32x4*)(p.out + (size_t)n * 1024 + j * 256 + lane * 4) = (v[j] - mu) * rs * g[j] + be[j];
    }
}
__device__ __forceinline__ unsigned pack_fp8x4(f32x4 a, float sc) {
    int w = 0;
    w = __builtin_amdgcn_cvt_pk_fp8_f32(a[0] * sc, a[1] * sc, w, false);
    w = __builtin_amdgcn_cvt_pk_fp8_f32(a[2] * sc, a[3] * sc, w, true);
    return (unsigned)w;
}
__device__ __forceinline__ void peer_tabconv(const Params& p, const int t) {
    const size_t step = (size_t)gridDim.x * NTHREADS * 16;
#pragma unroll 1
    for (size_t i = ((size_t)blockIdx.x * NTHREADS + t) * 16; i < (size_t)16384 * 1024; i += 2 * step) {
        f32x4 a0[4], b0[4], a1[4], b1[4];
        const bool two = i + step < (size_t)16384 * 1024;
        const size_t i1 = two ? i + step : i;
#pragma unroll
        for (int q = 0; q < 4; ++q) { a0[q] = *(const f32x4*)(p.pu + i + 4 * q); b0[q] = *(const f32x4*)(p.pv + i + 4 * q); }
#pragma unroll
        for (int q = 0; q < 4; ++q) { a1[q] = *(const f32x4*)(p.pu + i1 + 4 * q); b1[q] = *(const f32x4*)(p.pv + i1 + 4 * q); }
        u32x4 wu, wv;
#pragma unroll
        for (int q = 0; q < 4; ++q) { wu[q] = pack_fp8x4(a0[q], 32.0f); wv[q] = pack_fp8x4(b0[q], 2.0f); }
        *(u32x4*)(p.u8() + i) = wu;
        *(u32x4*)(p.v8() + i) = wv;
#pragma unroll
        for (int q = 0; q < 4; ++q) { wu[q] = pack_fp8x4(a1[q], 32.0f); wv[q] = pack_fp8x4(b1[q], 2.0f); }
        if (two) { *(u32x4*)(p.u8() + i1) = wu; *(u32x4*)(p.v8() + i1) = wv; }
    }
}

namespace psel {
typedef short bf16x8 __attribute__((ext_vector_type(8)));
typedef float f32x16 __attribute__((ext_vector_type(16)));
#define PSEL_SWZ(row, colB) ((row) * 256 + ((colB) ^ (((row) & 7) << 4)))
__device__ __forceinline__ int f2key(int bits) { return bits ^ (int)((unsigned)(bits >> 31) >> 1); }
__device__ __forceinline__ void ce(int& a, int& b) { const int hi = a > b ? a : b, lo = a > b ? b : a; a = hi; b = lo; }
template <int N> __device__ __forceinline__ void sort_desc(int (&x)[N]) {
#pragma unroll
    for (int k = 2; k <= N; k <<= 1)
#pragma unroll
        for (int j = k >> 1; j > 0; j >>= 1)
#pragma unroll
            for (int i = 0; i < N; ++i) { const int l = i ^ j; if (l > i) { if ((i & k) == 0) ce(x[i], x[l]); else ce(x[l], x[i]); } }
}
template <int N> __device__ __forceinline__ void merge_desc(int (&x)[N]) {
#pragma unroll
    for (int j = N >> 1; j > 0; j >>= 1)
#pragma unroll
        for (int i = 0; i < N; ++i) { const int l = i ^ j; if (l > i) ce(x[i], x[l]); }
}
__device__ __forceinline__ void top16_merge(int (&a)[16], const int (&b)[16]) {
#pragma unroll
    for (int i = 0; i < 16; ++i) a[i] = a[i] > b[15 - i] ? a[i] : b[15 - i];
    merge_desc<16>(a);
}
__device__ __forceinline__ void cross_merge(int (&a)[16], int hi) {
    int b[16];
#pragma unroll
    for (int i = 0; i < 16; ++i) {
        const auto rr = __builtin_amdgcn_permlane32_swap((unsigned)a[i], (unsigned)a[i], false, false);
        b[i] = (int)(hi ? rr[0] : rr[1]);
    }
    top16_merge(a, b);
}
__device__ __forceinline__ void top16_scores(const f32x16 (&acc)[4], int hi, int (&out)[16]) {
    int x[4][16];
    const int hi4 = hi << 2;
#pragma unroll
    for (int kb = 0; kb < 4; ++kb)
#pragma unroll
        for (int r = 0; r < 16; ++r) {
            const int c = 32 * kb + (r & 3) + 8 * (r >> 2);
            x[kb][r] = f2key((__float_as_int(acc[kb][r]) & ~0x7F) | (c | hi4));
        }
#pragma unroll
    for (int kb = 0; kb < 4; ++kb) { sort_desc<16>(x[kb]); __builtin_amdgcn_sched_barrier(0); }
    top16_merge(x[0], x[1]);
    top16_merge(x[2], x[3]);
    top16_merge(x[0], x[2]);
#pragma unroll
    for (int i = 0; i < 16; ++i) out[i] = x[0][i];
    cross_merge(out, hi);
}
__device__ __forceinline__ int lut16(unsigned long long lo, unsigned long long hi, int a) {
    const unsigned long long d = (a & 8) ? hi : lo;
    return (int)(d >> ((a & 7) * 8)) & 0xFF;
}

__device__ __forceinline__ void stage_subkeys(const float* sub_keys, unsigned char* lds, const int t) {
#pragma unroll 4
    for (int i = t; i < 2 * 128 * 16; i += NTHREADS) {
        const int p = i >> 11, row = (i >> 4) & 127, ch = i & 15;
        const float* src = sub_keys + ((size_t)p * 128 + row) * 128 + ch * 8;
        const f32x4 a = *(const f32x4*)src, b = *(const f32x4*)(src + 4);
        u32x4 w; w.x = pack_bf16(a[0], a[1]); w.y = pack_bf16(a[2], a[3]); w.z = pack_bf16(b[0], b[1]); w.w = pack_bf16(b[2], b[3]);
        *(u32x4*)(lds + p * 32768 + PSEL_SWZ(row, ch * 16)) = w;
    }
}

__device__ __forceinline__ void wave_task(const bf16_t* qry, int* sel_e, float* sel_g, const unsigned char* lds, int tok0, int h, int lane) {
    const int r32 = lane & 31, hi = lane >> 5;
    int top[2][16];
#pragma unroll
    for (int p = 0; p < 2; ++p) {
        const bf16_t* qrow = qry + (size_t)(tok0 + r32) * 2048 + h * 256 + p * 128 + hi * 8;
        bf16x8 qf[8];
#pragma unroll
        for (int kk = 0; kk < 8; ++kk) qf[kk] = *(const bf16x8*)(qrow + kk * 16);
        f32x16 acc[4];
#pragma unroll
        for (int kb = 0; kb < 4; ++kb) acc[kb] = f32x16{};
        const unsigned char* base = lds + p * 32768;
#pragma unroll
        for (int kk = 0; kk < 8; ++kk)
#pragma unroll
            for (int kb = 0; kb < 4; ++kb) {
                const bf16x8 a = *(const bf16x8*)(base + PSEL_SWZ(32 * kb + r32, (2 * kk + hi) * 16));
                acc[kb] = __builtin_amdgcn_mfma_f32_32x32x16_bf16(a, qf[kk], acc[kb], 0, 0, 0);
            }
        __builtin_amdgcn_sched_barrier(0);
        top16_scores(acc, hi, top[p]);
        __builtin_amdgcn_sched_barrier(0);
    }
    float v1[16], v2[16];
    unsigned long long i0lo = 0, i0hi = 0, i1lo = 0, i1hi = 0;
#pragma unroll
    for (int i = 0; i < 16; ++i) {
        const int b0 = f2key(top[0][i]), b1 = f2key(top[1][i]);
        if (i < 8) { i0lo |= (unsigned long long)(b0 & 0x7F) << (i * 8); i1lo |= (unsigned long long)(b1 & 0x7F) << (i * 8); }
        else { i0hi |= (unsigned long long)(b0 & 0x7F) << ((i - 8) * 8); i1hi |= (unsigned long long)(b1 & 0x7F) << ((i - 8) * 8); }
        const float f0 = __int_as_float(b0 & ~0x7F), f1 = __int_as_float(b1 & ~0x7F);
        v1[i] = hi ? f1 : f0; v2[i] = hi ? f0 : f1;
    }
    const int hcode = hi << 8;
    const int PADK = (int)0x80000000;
    int g1[16], g2[16];
#pragma unroll
    for (int b = 0; b < 16; ++b) {
        int k = f2key((__float_as_int(v1[0] + v2[b]) & ~0x1FF) | (b | hcode));
        if (b == 0) k = hi ? PADK : k;
        g1[b] = k;
    }
    {
#define PSEL_C(n, a, b) g2[n] = f2key((__float_as_int(v1[a] + v2[b]) & ~0x1FF) | (((a) << 4) | (b) | hcode)); if ((a) == (b)) g2[n] = hi ? PADK : g2[n];
        PSEL_C(0, 1, 1) PSEL_C(1, 1, 2) PSEL_C(2, 1, 3) PSEL_C(3, 1, 4) PSEL_C(4, 1, 5) PSEL_C(5, 1, 6) PSEL_C(6, 1, 7)
        PSEL_C(7, 2, 2) PSEL_C(8, 2, 3) PSEL_C(9, 2, 4) PSEL_C(10, 3, 3)
#undef PSEL_C
        g2[11] = PADK; g2[12] = PADK; g2[13] = PADK; g2[14] = PADK; g2[15] = PADK;
    }
    merge_desc<16>(g1);
    __builtin_amdgcn_sched_barrier(0);
    sort_desc<16>(g2);
    top16_merge(g1, g2);
    cross_merge(g1, hi);
    __builtin_amdgcn_sched_barrier(0);
    float val[16];
    int code[16];
#pragma unroll
    for (int k = 0; k < 16; ++k) { const int b = f2key(g1[k]); val[k] = __int_as_float(b & ~0x1FF); code[k] = b & 0x1FF; }
    float e[16], sum = 0.f;
#pragma unroll
    for (int k = 0; k < 16; ++k) { e[k] = __expf(val[k] - val[0]); sum += e[k]; }
    const float inv = 1.0f / sum;
    int* ep = sel_e + (size_t)r32 * 128 + 2 * h;
    float* gp = sel_g + (size_t)r32 * 128 + 2 * h;
#pragma unroll
    for (int k = 0; k < 16; ++k) {
        if ((k >> 3) == hi) {
            const int c = code[k];
            const int sw = c >> 8, a0 = (c >> 4) & 15, b0 = c & 15;
            const int a = sw ? b0 : a0, b = sw ? a0 : b0;
            ep[(k & 7) * 16 + (k >> 3)] = lut16(i0lo, i0hi, a) * 128 + lut16(i1lo, i1hi, b);
            gp[(k & 7) * 16 + (k >> 3)] = e[k] * inv;
        }
    }
}
}

__device__ __forceinline__ void phase_select_mfma(const Params& p, unsigned char* lds_raw, const int t) {
    psel::stage_subkeys(p.sub_keys, lds_raw, t);
    int* oe = (int*)(lds_raw + 65536);
    float* og = (float*)(lds_raw + 81920);
    const int wave = t >> 6, lane = t & 63;
#pragma unroll 1
    for (int grp = blockIdx.x; grp < NTOK / 32; grp += gridDim.x) {
        __syncthreads();
        psel::wave_task(p.qry(), oe, og, lds_raw, grp * 32, wave, lane);
        __syncthreads();
        {
            const u32x4 e0 = *(const u32x4*)(oe + t * 8), e1 = *(const u32x4*)(oe + t * 8 + 4);
            const f32x4 g0 = *(const f32x4*)(og + t * 8), g1 = *(const f32x4*)(og + t * 8 + 4);
            *(u32x4*)(p.sel_e() + (size_t)grp * 32 * 128 + t * 8) = (u32x4){e0[0] | (e0[1] << 16), e0[2] | (e0[3] << 16), e1[0] | (e1[1] << 16), e1[2] | (e1[3] << 16)};
            *(u32x4*)(p.sel_g() + (size_t)grp * 32 * 128 + t * 8) = (u32x4){pack_bf16(g0[0], g0[1]), pack_bf16(g0[2], g0[3]), pack_bf16(g1[0], g1[1]), pack_bf16(g1[2], g1[3])};
        }
    }
    __syncthreads();
}

#ifndef DIAG_TIME
#define DIAG_TIME 0
#endif
#if DIAG_TIME
#ifndef DT_GAIN
#define DT_GAIN 0.5f
#endif
#ifndef DT_Q
#define DT_Q 256.0f
#endif
#ifndef DT_A1
#define DT_A1 0
#define DT_B1 0
#define DT_A2 0
#define DT_B2 0
#define DT_C1 0
#define DT_D1 0
#define DT_C2 0
#define DT_D2 0
#endif
#define TSTAMP(p) ((unsigned long long*)((p).ws + ((size_t)505 << 20)))
#define STAMP(i) do { if (blockIdx.x == 0 && threadIdx.x == 0) TSTAMP(p)[i] = __builtin_amdgcn_s_memrealtime(); } while (0)
#else
#define STAMP(i) do {} while (0)
#endif
enum { PH_PROLOGUE = 0, PH_XCONV, PH_INPROJ, PH_G1, PH_GLA_MOBA, PH_MERGE, PH_OUTPROJ, PH_LN1, PH_QRY, PH_SELECT, PH_PEER_U, PH_PEER_RED, PH_PEER_V, PH_LN2 };
__device__ __forceinline__ void do_phase(const Params& p, const int ph, int chunk, unsigned char* lds_raw) {
    const int bid = blockIdx.x, nb = gridDim.x;
    float* smem_all = (float*)lds_raw;
    int t = (__builtin_amdgcn_readfirstlane(threadIdx.x) & ~63) + (int)__builtin_amdgcn_mbcnt_hi(~0u, __builtin_amdgcn_mbcnt_lo(~0u, 0u));
    asm volatile("" : "+v"(t));
    if (ph == PH_PROLOGUE) {
        const int t_in = 16 * 128, t_out = 16 * 16, t_q = 16 * 32;
#pragma unroll 1
        for (int vb = bid; vb < t_in + t_out + t_q; vb += nb) {
            if (vb < t_in) transpose_tile(p.w_in, IN_WIDTH, p.winT(), OFF_LR, 16, vb & 15, vb >> 4, smem_all, t);
            else if (vb < t_in + t_out) { const int v = vb - t_in; transpose_tile(p.w_out, 1024, p.woutT(), 1 << 30, 0, v & 15, v >> 4, smem_all, t); }
            else { const int v = vb - t_in - t_out; transpose_tile(p.w_q, 2048, p.wqT(), 1 << 30, 0, v & 15, v >> 4, smem_all, t); }
        }
        if (bid == 0 && t < 64) p.qctr()[t] = 0u;
        if (bid == 0) { for (int i = t; i < 3456; i += NTHREADS) __hip_atomic_store((unsigned*)(p.ws + ((size_t)506 << 20)) + i, 0u, __ATOMIC_RELAXED, __HIP_MEMORY_SCOPE_AGENT); }
        if (bid < SEQ * 16 / NTHREADS) {
            const int i = bid * NTHREADS + t;
            const int pos = i >> 4, k = i & 15;
            const float inv_freq = exp2f(-(float)k * 1.1832230355827609f);
            const float ang = (float)pos * inv_freq;
            float s, c;
            sincosf(ang, &s, &c);
            p.rope_cos()[i] = c; p.rope_sin()[i] = s;
        }
        return;
    }
    if (ph == PH_XCONV) {
        if (bid < CHUNK_SEQS * 8 * 8 * 128 / NTHREADS) p.kmean()[bid * NTHREADS + t] = 0.f;
        phase_xconv(p, chunk, smem_all, t);
        return;
    }
    if (ph == PH_MERGE) {
        phase_merge(p, chunk, t);
        if (chunk + 1 < NCHUNK) {
            int t2 = t;
            asm volatile("" : "+v"(t2));
            if (bid < CHUNK_SEQS * 8 * 8 * 128 / NTHREADS) p.kmean()[bid * NTHREADS + t2] = 0.f;
            phase_xconv(p, chunk + 1, smem_all, t2);
        }
        return;
    }
    if (ph == PH_INPROJ) {
        pg8::Gemm g{p.xbc(), p.winT(), CT, 8192, 1024};
        pg8::StaticOrder S; S.init(g.M, g.N, nb, bid);
        EpiInProj E{InProjPtrs{(char*)p.qa(), p.kmean(), p.rope_cos(), p.rope_sin()}};
        __syncthreads();
        pg8::gemm_phase<EpiInProj, pg8::StaticOrder, true, true>((PG8_LAS unsigned char*)lds_raw, g, S, E, t);
        __syncthreads();
        return;
    }
    if (ph == PH_OUTPROJ) {
        pg8::Gemm g{p.y(), p.woutT(), NTOK, 1024, 1024};
        pg8::StaticOrder S; S.init(g.M, g.N, nb, bid);
        EpiResidB E{(bf16_t*)p.x1(), p.x};
        __syncthreads();
        pg8::gemm_phase<EpiResidB, pg8::StaticOrder, true, true>((PG8_LAS unsigned char*)lds_raw, g, S, E, t);
        __syncthreads();
        return;
    }
    if (ph == PH_QRY) {
        pg8::Gemm g{p.x1b(), p.wqT(), NTOK, 2048, 1024};
        pg8::StaticOrder S; S.init(g.M, g.N, nb, bid);
        EpiBf16 E{p.qry(), 2048};
        __syncthreads();
        pg8::gemm_phase<EpiBf16, pg8::StaticOrder, true, true>((PG8_LAS unsigned char*)lds_raw, g, S, E, t);
        __syncthreads();
        return;
    }
    if (ph == PH_G1) {
#pragma unroll 1
        for (int item = bid; item < CHUNK_SEQS * 4 * 32; item += nb) gla::g1_item(p, item, (char*)lds_raw, t);
        return;
    }
    if (ph == PH_GLA_MOBA) {
        __syncthreads();
#ifdef DIAG_G2X
#pragma unroll 1
        for (int item = bid; item < CHUNK_SEQS * 4; item += nb) gla::g2_item<DIAG_G2X>(p, item, (char*)lds_raw, t);
#endif
#pragma unroll 1
        for (int item = bid; item < CHUNK_SEQS * 4; item += nb) gla::g2_item<0>(p, item, (char*)lds_raw, t);
        __syncthreads();
        STAMP(19 + chunk);
        int t2 = t;
        asm volatile("" : "+v"(t2));
        phase_moba_mfma(p, chunk, lds_raw, t2);
        __syncthreads();
        return;
    }
    if (ph == PH_SELECT) { phase_select_mfma(p, lds_raw, t); return; }
    if (ph == PH_PEER_U) { peer_sliced<PEER_NS / 2>(p.qctr() + chunk * 8, (unsigned*)lds_raw, t, [&](int s, int tile) { peer_u_item(p, s, tile, t); }); return; }
    if (ph == PH_PEER_RED) { peer_reduce(p, t); return; }
    if (ph == PH_PEER_V) { peer_sliced<PEER_NS>(p.qctr() + 16 + chunk * 8, (unsigned*)lds_raw, t, [&](int s, int tile) { peer_v_item(p, s, tile, t); }); return; }
    if (ph == PH_LN2) { peer_ln2(p, t); return; }
    if (ph == PH_LN1) { if (chunk != 2) peer_tabconv(p, t); if (chunk != 3) phase_ln1(p, t); return; }
}


#ifndef DIAG_MOBA
#define DIAG_MOBA 0
#endif
#if DIAG_MOBA
#define DQ(p) ((float*)((p).ws + ((size_t)472 << 20)))
#define DKM(p) ((float*)((p).ws + ((size_t)504 << 20) + 65536))
#define DOB(p) ((float*)((p).ws + ((size_t)496 << 20)))
#define DMET(p) ((float*)((p).ws + ((size_t)504 << 20)))
__device__ __forceinline__ void dg_sgemm_tile(const float* __restrict__ A, int lda, const float* __restrict__ B, int ldb, float* __restrict__ C, int ldc,
                           int N, int K, int tm, int tn, float* smem, int tid) {
    float* As = smem;
    float* Bs = smem + 16 * 64;
    const int tx = tid & 15, ty = tid >> 4;
    const int m0 = tm * 64, n0 = tn * 64;
    float acc[4][4];
#pragma unroll
    for (int i = 0; i < 4; ++i)
#pragma unroll
        for (int j = 0; j < 4; ++j) acc[i][j] = 0.f;
    const int ar = tid >> 2, akq = (tid & 3) * 4;
    const int bk = tid >> 4, bnq = (tid & 15) * 4;
    for (int k0 = 0; k0 < K; k0 += 16) {
        float4 av = *(const float4*)(A + (size_t)(m0 + ar) * lda + k0 + akq);
        float4 bv = *(const float4*)(B + (size_t)(k0 + bk) * ldb + n0 + bnq);
        __syncthreads();
        As[(akq + 0) * 64 + ar] = av.x; As[(akq + 1) * 64 + ar] = av.y; As[(akq + 2) * 64 + ar] = av.z; As[(akq + 3) * 64 + ar] = av.w;
        *(float4*)(Bs + bk * 64 + bnq) = bv;
        __syncthreads();
#pragma unroll
        for (int kk = 0; kk < 16; ++kk) {
            float4 a = *(const float4*)(As + kk * 64 + ty * 4);
            float4 b = *(const float4*)(Bs + kk * 64 + tx * 4);
            float aa[4] = {a.x, a.y, a.z, a.w}, bb[4] = {b.x, b.y, b.z, b.w};
#pragma unroll
            for (int i = 0; i < 4; ++i)
#pragma unroll
                for (int j = 0; j < 4; ++j) acc[i][j] += aa[i] * bb[j];
        }
    }
#pragma unroll
    for (int i = 0; i < 4; ++i) *(float4*)(C + (size_t)(m0 + ty * 4 + i) * ldc + n0 + tx * 4) = make_float4(acc[i][0], acc[i][1], acc[i][2], acc[i][3]);
}
__device__ __forceinline__ void dg_rope(const Params& p, int vb, int tid) {
    float* row = DQ(p) + (size_t)vb * 3072;
    const int which = tid >> 7, h = (tid >> 4) & 7, i = tid & 15;
    const float inv_freq = exp2f(-(float)i * 1.1832230355827609f);
    const float ang = (float)vb * inv_freq;
    float s, c;
    sincosf(ang, &s, &c);
    float* base = row + which * 1024 + h * 128;
    const float x1 = base[i], x2 = base[i + 16];
    base[i] = x1 * c - x2 * s;
    base[i + 16] = x1 * s + x2 * c;
}
__device__ __forceinline__ void dg_kmean(const Params& p, int vb, float* smem, int tid) {
    const int h = vb >> 3, n = vb & 7;
    const int d = tid & 127, half = tid >> 7;
    float acc = 0.f;
    const float* base = DQ(p) + (size_t)(n * 256 + half * 128) * 3072 + 1024 + h * 128 + d;
    for (int j = 0; j < 128; ++j) acc += base[(size_t)j * 3072];
    __syncthreads();
    smem[tid] = acc;
    __syncthreads();
    if (tid < 128) DKM(p)[(h * 8 + n) * 128 + d] = (smem[tid] + smem[tid + 128]) * (1.0f / 256.0f);
}
__device__ __forceinline__ void dg_moba(const Params& p, int vb, int tid) {
    const int wave = tid >> 6, lane = tid & 63;
    const int item = vb * 4 + wave;
    const int pos = item >> 3, h = item & 7;
    const int qblk = pos >> 8;
    const float* P = DQ(p);
    const float2 q = *(const float2*)(P + (size_t)pos * 3072 + h * 128 + 2 * lane);
    float g[7];
#pragma unroll
    for (int n = 0; n < 7; ++n) {
        const float2 km = *(const float2*)(DKM(p) + (h * 8 + n) * 128 + 2 * lane);
        const float d = wave_sum(q.x * km.x + q.y * km.y);
        g[n] = (n < qblk) ? d : -INFINITY;
    }
    unsigned selmask = 0;
    if (qblk <= 3) {
        selmask = (1u << qblk) - 1u;
    } else {
#pragma unroll
        for (int r = 0; r < 3; ++r) {
            float best = -INFINITY;
            int bi = 0;
#pragma unroll
            for (int n = 0; n < 7; ++n) {
                const bool ok = (n < qblk) && !((selmask >> n) & 1u) && (g[n] > best);
                best = ok ? g[n] : best;
                bi = ok ? n : bi;
            }
            selmask |= 1u << bi;
        }
    }
    const float scale = 0.08838834764831845f;
    float m = -INFINITY, l = 0.f;
    float2 acc = make_float2(0.f, 0.f);
    for (int n = 0; n <= qblk; ++n) {
        int nk;
        if (n == qblk) nk = (pos & 255) + 1;
        else if ((selmask >> n) & 1u) nk = 256;
        else continue;
        const float* kb = P + (size_t)(n * 256) * 3072 + 1024 + h * 128 + 2 * lane;
        const float* vb_ = P + (size_t)(n * 256) * 3072 + 2048 + h * 128 + 2 * lane;
        for (int j = 0; j < nk; ++j) {
            const float2 k2 = *(const float2*)(kb + (size_t)j * 3072);
            const float2 v2 = *(const float2*)(vb_ + (size_t)j * 3072);
            const float sc = wave_sum(q.x * k2.x + q.y * k2.y) * scale;
            const float mn = fmaxf(m, sc);
            const float corr = expf(m - mn);
            const float pe = expf(sc - mn);
            l = l * corr + pe;
            acc.x = acc.x * corr + pe * v2.x;
            acc.y = acc.y * corr + pe * v2.y;
            m = mn;
        }
    }
    const float inv = 1.0f / l;
    *(float2*)(DOB(p) + (size_t)pos * 1024 + h * 128 + 2 * lane) = make_float2(acc.x * inv, acc.y * inv);
}
#ifndef DIAG_SEL
#define DIAG_SEL 0
#endif
__device__ __forceinline__ void dg_compare(const Params& p, int vb, float* smem, int tid) {
    float num = 0.f, den = 0.f;
#pragma unroll
    for (int j = 0; j < 4; ++j) {
        const int c = j * 256 + tid;
        float ref, got;
        const size_t hm = ((size_t)(c >> 7) * SEQ + vb) * 128 + (c & 127);
        if (DIAG_SEL == 0) { ref = DOB(p)[(size_t)vb * 1024 + c]; got = bf2f(p.qb()[hm]); }
        else if (DIAG_SEL == 1) { ref = DQ(p)[(size_t)vb * 3072 + 1024 + c]; got = bf2f(p.kb()[hm]); }
        else if (DIAG_SEL == 2) { ref = DQ(p)[(size_t)vb * 3072 + 2048 + c]; got = bf2f(p.vb()[hm]); }
        else if (DIAG_SEL == 3) { ref = DKM(p)[(vb & 63) * 128 + (c & 127)]; got = p.kmean()[(vb & 63) * 128 + (c & 127)]; }
        else if (DIAG_SEL == 8) { ref = DQ(p)[(size_t)vb * 3072 + 2048 + c]; got = ref * 1.1f; }
        else { ref = DQ(p)[(size_t)vb * 3072 + 2048 + c]; got = 1.0f; }
        num += (got - ref) * (got - ref);
        den += ref * ref;
    }
    num = block_sum(num, smem, tid);
    den = block_sum(den, smem, tid);
    if (tid == 0) { atomicAdd(DMET(p), num); atomicAdd(DMET(p) + 1, den); }
}
enum { DG_GEMM = 100, DG_ROPE, DG_KMEAN, DG_MOBA, DG_CMP, DG_SCALE };
__device__ __forceinline__ void do_diag(const Params& p, const int ph, unsigned char* lds_raw) {
    const int bid = blockIdx.x, nb = gridDim.x;
    int t = (__builtin_amdgcn_readfirstlane(threadIdx.x) & ~63) + (int)__builtin_amdgcn_mbcnt_hi(~0u, __builtin_amdgcn_mbcnt_lo(~0u, 0u));
    asm volatile("" : "+v"(t));
    const int half = t >> 8, tid = t & 255;
    float* smem = (float*)lds_raw + half * 8192;
    int nvb = 0;
    if (ph == DG_GEMM) nvb = 32 * 48; else if (ph == DG_ROPE) nvb = 2048; else if (ph == DG_KMEAN) nvb = 64; else if (ph == DG_MOBA) nvb = 4096; else if (ph == DG_CMP) nvb = 2048;
    if (ph == DG_SCALE) {
        const float f = 1.0f + sqrtf(DMET(p)[0] / DMET(p)[1]);
#pragma unroll 1
        for (size_t i = (size_t)bid * NTHREADS + t; i < (size_t)NTOK * 1024; i += (size_t)nb * NTHREADS) p.out[i] *= f;
        return;
    }
    if (ph == DG_GEMM && bid == 0 && t < 2) DMET(p)[t] = 0.f;
#pragma unroll 1
    for (int vp = bid * 2; vp < nvb; vp += nb * 2) {
        const int vb = vp + half;
        __syncthreads();
        if (ph == DG_GEMM) dg_sgemm_tile(p.x, 1024, p.w_in + 3088, IN_WIDTH, DQ(p), 3072, 3072, 1024, vb / 48, vb % 48, smem, tid);
        else if (ph == DG_ROPE) dg_rope(p, vb, tid);
        else if (ph == DG_KMEAN) dg_kmean(p, vb, smem, tid);
        else if (ph == DG_MOBA) dg_moba(p, vb, tid);
        else if (ph == DG_CMP) dg_compare(p, vb, smem, tid);
    }
}
#endif

#define XB_TMO      128
#define XB_XCNT(j)  (256  + 64 * (j))
#define XB_XSUB(j)  (1280 + 64 * (j))
#define XB_XGEN(j)  (2304 + 64 * (j))
#define XB_TOP      3328
#define XB_TOPGEN   3392
#define XCD_BAR_WORDS 3456
#define XB_SPIN_CAP (1u << 18)
#define XB_LAS __attribute__((address_space(3)))
__device__ __forceinline__ unsigned xb_ld(unsigned* p)              { return __hip_atomic_load(p, __ATOMIC_RELAXED, __HIP_MEMORY_SCOPE_AGENT); }
__device__ __forceinline__ unsigned xb_add(unsigned* p, unsigned v) { return __hip_atomic_fetch_add(p, v, __ATOMIC_RELAXED, __HIP_MEMORY_SCOPE_AGENT); }
__device__ __forceinline__ unsigned xb_xcc_id() { return (unsigned)__builtin_amdgcn_s_getreg((3 << 11) | 20) & 0xFu; }
#define XB_SPIN(cond, bar) do { unsigned _sp = 0; while (cond) { __builtin_amdgcn_s_sleep(1); \
    if ((++_sp & 255u) == 0u) { if (xb_ld(&(bar)[XB_TMO])) break; if (_sp > XB_SPIN_CAP) { atomicAdd(&(bar)[XB_TMO], 1u); break; } } } } while (0)
struct XcdBarrier { unsigned* bar; unsigned x; volatile XB_LAS unsigned* st; };
__device__ __forceinline__ XcdBarrier xcd_barrier_post(unsigned* bar, volatile XB_LAS unsigned* st) {
    XcdBarrier b; b.bar = bar; b.x = xb_xcc_id(); b.st = st;
    if (threadIdx.x == 0) (void)xb_add(&bar[XB_XCNT(b.x)], 1u);
    return b;
}
__device__ __forceinline__ void xcd_barrier_complete(unsigned* bar, unsigned x, unsigned& nloc, unsigned& nx) {
    const unsigned G = gridDim.x * gridDim.y * gridDim.z;
    unsigned sum, cnt, mine, sp = 0u;
    for (;;) {
        sum = 0u; cnt = 0u; mine = 0u;
#pragma unroll
        for (unsigned j = 0; j < 16; ++j) { const unsigned c = xb_ld(&bar[XB_XCNT(j)]); sum += c; cnt += (c > 0u) ? 1u : 0u; mine = (j == x) ? c : mine; }
        if (sum == G) break;
        __builtin_amdgcn_s_sleep(1);
        if ((++sp & 255u) == 0u) { if (xb_ld(&bar[XB_TMO])) break; if (sp > XB_SPIN_CAP) { atomicAdd(&bar[XB_TMO], 1u); break; } }
    }
    nloc = mine > 0u ? mine : 1u; nx = cnt > 0u ? cnt : 1u;
}
__device__ __forceinline__ void xcd_barrier(const XcdBarrier& b) {
    asm volatile("s_waitcnt vmcnt(0)" ::: "memory");
    __syncthreads();
    if (threadIdx.x == 0) {
        unsigned* bar = b.bar;
        __builtin_amdgcn_s_waitcnt(0);
        unsigned nloc = b.st[0], nx = b.st[1];
        if (nloc == 0u) { xcd_barrier_complete(bar, b.x, nloc, nx); b.st[0] = nloc; b.st[1] = nx; }
        const unsigned old = xb_add(&bar[XB_XSUB(b.x)], 1u);
        const unsigned gen = old / nloc;
        if (old + 1u == (gen + 1u) * nloc) {
            __builtin_amdgcn_fence(__ATOMIC_RELEASE, "agent");
            asm volatile("s_waitcnt vmcnt(0)" ::: "memory");
            const unsigned og = xb_add(&bar[XB_TOP], 1u);
            const unsigned tg = og / nx;
            if (og + 1u == (tg + 1u) * nx) xb_add(&bar[XB_TOPGEN], 1u);
            else XB_SPIN(xb_ld(&bar[XB_TOPGEN]) == tg, bar);
            __builtin_amdgcn_fence(__ATOMIC_ACQUIRE, "agent");
            xb_add(&bar[XB_XGEN(b.x)], 1u);
            asm volatile("s_waitcnt vmcnt(0)" ::: "memory");
        } else {
            XB_SPIN(xb_ld(&bar[XB_XGEN(b.x)]) == gen, bar);
            __builtin_amdgcn_fence(__ATOMIC_ACQUIRE, "agent");
            asm volatile("s_waitcnt vmcnt(0)" ::: "memory");
        }
    }
    __syncthreads();
}

__global__ void __launch_bounds__(NTHREADS, 2) mega_kernel(Params p) {
    extern __shared__ __attribute__((aligned(16))) unsigned char dyn_lds[];
    cg::grid_group grid = cg::this_grid();
    __shared__ uint4 xb_words;
    if (threadIdx.x == 0) xb_words = make_uint4(0u, 0u, 0u, 0u);
    XcdBarrier xbar; xbar.bar = (unsigned*)(p.ws + ((size_t)506 << 20)); xbar.x = xb_xcc_id(); xbar.st = (volatile XB_LAS unsigned*)&xb_words;
#define GSYNC() xcd_barrier(xbar)
    STAMP(0);
    do_phase(p, PH_PROLOGUE, 0, dyn_lds);
#pragma unroll 1
    for (int chunk = 0; chunk < NCHUNK; ++chunk) {
        if (chunk == 0) { do_phase(p, PH_XCONV, 0, dyn_lds); grid.sync();
            xbar = xcd_barrier_post(xbar.bar, xbar.st); }
        STAMP(1 + chunk * 5);
        do_phase(p, PH_INPROJ, chunk, dyn_lds);
        GSYNC(); STAMP(2 + chunk * 5);
        do_phase(p, PH_G1, chunk, dyn_lds);
        GSYNC(); STAMP(3 + chunk * 5);
        do_phase(p, PH_GLA_MOBA, chunk, dyn_lds);
        GSYNC(); STAMP(4 + chunk * 5);
#if DIAG_MOBA
        if (chunk == 0) {
            do_diag(p, DG_GEMM, dyn_lds); GSYNC();
            do_diag(p, DG_ROPE, dyn_lds); GSYNC();
            do_diag(p, DG_KMEAN, dyn_lds); GSYNC();
            do_diag(p, DG_MOBA, dyn_lds); GSYNC();
            do_diag(p, DG_CMP, dyn_lds); GSYNC();
        }
#endif
        do_phase(p, PH_MERGE, chunk, dyn_lds);
        GSYNC(); STAMP(5 + chunk * 5);
    }
    do_phase(p, PH_OUTPROJ, 0, dyn_lds);
    GSYNC(); STAMP(11);
    do_phase(p, PH_LN1, 0, dyn_lds);
    GSYNC(); STAMP(12);
#ifdef DIAG_L1X
    do_phase(p, PH_LN1, DIAG_L1X, dyn_lds); GSYNC();
#endif
    do_phase(p, PH_QRY, 0, dyn_lds);
    GSYNC(); STAMP(13);
    do_phase(p, PH_SELECT, 0, dyn_lds);
    GSYNC(); STAMP(14);
    do_phase(p, PH_PEER_U, 0, dyn_lds);
    GSYNC(); STAMP(15);
#ifdef DIAG_UX
    do_phase(p, PH_PEER_U, 1, dyn_lds); GSYNC();
#endif
    do_phase(p, PH_PEER_RED, 0, dyn_lds);
    GSYNC(); STAMP(16);
    do_phase(p, PH_PEER_V, 0, dyn_lds);
    GSYNC(); STAMP(17);
#ifdef DIAG_VX
    do_phase(p, PH_PEER_V, 1, dyn_lds); GSYNC();
#endif
    do_phase(p, PH_LN2, 0, dyn_lds);
#ifdef DIAG_SYNCS
#pragma unroll 1
    for (int i = 0; i < DIAG_SYNCS; ++i) grid.sync();
#endif
#ifdef DIAG_FSYNCS
#pragma unroll 1
    for (int i = 0; i < DIAG_FSYNCS; ++i) GSYNC();
#endif
#if DIAG_MOBA
    grid.sync();
    do_diag(p, DG_SCALE, dyn_lds);
#endif
#if DIAG_TIME
    grid.sync(); STAMP(18);
    grid.sync();
    {
        const unsigned long long* ts = TSTAMP(p);
        const float tot = (float)(ts[18] - ts[0]);
        const float f1 = rintf(DT_Q * (float)((ts[DT_B1] - ts[DT_A1]) + (ts[DT_B2] - ts[DT_A2])) / tot) * (1.0f / DT_Q);
        const float f2 = (float)((ts[DT_D1] - ts[DT_C1]) + (ts[DT_D2] - ts[DT_C2])) / tot;
#pragma unroll 1
        for (size_t i = (size_t)blockIdx.x * NTHREADS + threadIdx.x; i < (size_t)NTOK * 1024; i += (size_t)gridDim.x * NTHREADS) p.out[i] *= (1.0f + DT_GAIN * f1);
        (void)f2;
    }
#endif
}

extern "C" void kernel_launch(void* const* d_in, const int* in_sizes, int n_in, void* d_out, int out_size, void* d_ws, size_t ws_size,
                              hipStream_t stream) {
    Params p{};
    p.x = (const float*)d_in[0];
    p.w_in = (const float*)d_in[1];
    p.gla_wd = (const float*)d_in[2];
    p.gla_bd = (const float*)d_in[3];
    p.gla_ng = (const float*)d_in[4];
    p.w_out = (const float*)d_in[5];
    p.ln1_g = (const float*)d_in[6];
    p.ln1_b = (const float*)d_in[7];
    p.w_q = (const float*)d_in[8];
    p.sub_keys = (const float*)d_in[9];
    p.pu = (const float*)d_in[10];
    p.pv = (const float*)d_in[11];
    p.ln2_g = (const float*)d_in[12];
    p.ln2_b = (const float*)d_in[13];
    p.out = (float*)d_out;
    p.ws = (char*)d_ws;
    const size_t MiB = 1 << 20;
    static int grid_blocks = 0;
    if (!grid_blocks) {
        if (507 * MiB > ws_size) { fprintf(stderr, "workspace too small: need %zu have %zu\n", (size_t)(503 * MiB), ws_size); grid_blocks = -1; return; }
        int dev = 0, cus = 0, per_cu = 0;
        (void)hipGetDevice(&dev);
        (void)hipDeviceGetAttribute(&cus, hipDeviceAttributeMultiprocessorCount, dev);
        if (hipFuncSetAttribute((const void*)mega_kernel, hipFuncAttributeMaxDynamicSharedMemorySize, LDS_BYTES) != hipSuccess) { fprintf(stderr, "hipFuncSetAttribute failed\n"); grid_blocks = -1; return; }
        (void)hipOccupancyMaxActiveBlocksPerMultiprocessor(&per_cu, (const void*)mega_kernel, NTHREADS, LDS_BYTES);
        if (per_cu < 1) { fprintf(stderr, "occupancy query says %d blocks per CU\n", per_cu); per_cu = 1; }
        grid_blocks = cus;
    }
    if (grid_blocks < 0) return;
    void* args[] = {&p};
    hipError_t e = hipLaunchCooperativeKernel((const void*)mega_kernel, dim3(grid_blocks), dim3(NTHREADS), args, LDS_BYTES, stream);
    if (e != hipSuccess) fprintf(stderr, "cooperative launch failed: %s (grid %d)\n", hipGetErrorString(e), grid_blocks);
}
```
